# Optimizing an MI355X kernel written in HIP

```python
import jax, jax.numpy as jnp
from jax import lax
import numpy as np

D_MODEL = 4096
BATCH = 4
SEQ = 2048
DEPTH = 1
DEC_BATCH = 128
DEC_SEQ = 4
PAST_LEN = 16384
PAGE_SIZE = 128

R_WIDTH = D_MODEL // 2
R_HEAD = 64
R_HEADS = R_WIDTH // R_HEAD
R_DECAY_LORA = 64
R_AAA_LORA = 64
R_GATE_LORA = 256
R_COLS = 3 * R_WIDTH + R_DECAY_LORA + R_AAA_LORA + R_GATE_LORA
RWKV_GN_EPS = 64e-5
G_WIDTH = D_MODEL // 2
G_HEAD = 128
G_HEADS = G_WIDTH // G_HEAD
G_CONV = 4
G_CHUNK = 64
G_CONV_COLS = 3 * G_WIDTH
G_COLS = G_CONV_COLS + G_WIDTH + 2 * G_HEADS
MERGE_COLS = 2 * D_MODEL
IN_COLS = R_COLS + G_COLS + MERGE_COLS
D_FF = 4 * D_MODEL
NORM_EPS = 1e-6

kernel_name = "rwkv7_gdn_parallel_gated_adaln_decoder_step"

R_SPLITS = (R_WIDTH, 2 * R_WIDTH, 3 * R_WIDTH, 3 * R_WIDTH + R_DECAY_LORA,
            3 * R_WIDTH + R_DECAY_LORA + R_AAA_LORA)
G_SPLITS = (G_CONV_COLS, G_CONV_COLS + G_WIDTH, G_CONV_COLS + G_WIDTH + G_HEADS)


def rms_norm(x, w, eps=NORM_EPS):
    xf = x.astype(jnp.float32)
    y = xf * lax.rsqrt(jnp.mean(xf * xf, axis=-1, keepdims=True) + eps)
    return (y * w.astype(jnp.float32)).astype(x.dtype)


def l2_normalize(x, eps=1e-6):
    xf = x.astype(jnp.float32)
    return xf * lax.rsqrt(jnp.sum(xf * xf, axis=-1, keepdims=True) + eps)


def adaln_params(c, w_ada, b_ada):
    m = jax.nn.silu(c) @ w_ada + b_ada
    return [t[:, None, :] for t in jnp.split(m, 6, axis=-1)]


def rwkv7_recurrence(r, w, k, v, kk, a, S0):
    def step(S, inp):
        r_t, w_t, k_t, v_t, kk_t, a_t = inp
        sa = jnp.einsum('bhvk,bhk->bhv', S, -kk_t)
        S = (S * w_t[:, :, None, :] + sa[..., None] * (kk_t * a_t)[:, :, None, :]
             + v_t[..., None] * k_t[:, :, None, :])
        return S, jnp.einsum('bhvk,bhk->bhv', S, r_t)
    xs = tuple(jnp.moveaxis(t, 1, 0) for t in (r, w, k, v, kk, a))
    S, o = lax.scan(step, S0.astype(jnp.float32), xs)
    return jnp.moveaxis(o, 0, 1), S


def rwkv7_branch(pr, shift_prev, S0, lw):
    B, T, _ = pr.shape
    f32 = jnp.float32
    prev = jnp.concatenate([shift_prev[:, None, :].astype(pr.dtype), pr[:, :-1]], axis=1)
    xs = pr + (prev - pr) * lw['r_mu']
    r, k, v, dw, da, dg = jnp.split(xs, R_SPLITS, axis=-1)
    log_w = -jax.nn.softplus(-(lw['r_w0'] + jnp.tanh(dw) @ lw['r_w_w2']).astype(f32)) - 0.5
    w = jnp.exp(-jnp.exp(log_w))
    a = jax.nn.sigmoid((lw['r_a0'] + da @ lw['r_w_a2']).astype(f32))
    g = (jax.nn.sigmoid(dg) @ lw['r_w_g2']).astype(f32)
    heads = lambda t: t.astype(f32).reshape(B, T, R_HEADS, R_HEAD)
    r, k, v, w, a = heads(r), heads(k), heads(v), heads(w), heads(a)
    kk = l2_normalize(k * lw['r_k_k'].reshape(R_HEADS, R_HEAD))
    k = k * (1.0 + (a - 1.0) * lw['r_k_a'].reshape(R_HEADS, R_HEAD))
    o, S = rwkv7_recurrence(r, w, k, v, kk, a, S0)
    mu = jnp.mean(o, axis=-1, keepdims=True)
    var = jnp.mean(jnp.square(o - mu), axis=-1, keepdims=True)
    o = ((o - mu) * lax.rsqrt(var + RWKV_GN_EPS)).reshape(B, T, R_WIDTH)
    o = o * lw['r_lnx_w'] + lw['r_lnx_b']
    bonus = jnp.sum(r * k * lw['r_r_k'], axis=-1, keepdims=True) * v
    o = (o + bonus.reshape(B, T, R_WIDTH)) * g
    return o.astype(pr.dtype), S, pr[:, -1]


def gated_delta_chunked(q, k, v, log_alpha, beta, S0):
    B, T, H, Dk = q.shape
    Dv = v.shape[-1]
    C = min(G_CHUNK, T)
    n = -(-T // C)
    pad = n * C - T

    def prep(t):
        t = jnp.pad(t, [(0, 0), (0, pad)] + [(0, 0)] * (t.ndim - 2))
        t = t.reshape((B, n, C) + t.shape[2:])
        return jnp.moveaxis(jnp.moveaxis(t, 3, 2), 1, 0)

    q, k, v, la, bt = prep(q), prep(k), prep(v), prep(log_alpha), prep(beta)
    g = jnp.cumsum(la, axis=-1)
    idx = jnp.arange(C)
    causal = idx[:, None] >= idx[None, :]
    strict = idx[:, None] > idx[None, :]
    decay = jnp.exp(jnp.where(causal, g[..., :, None] - g[..., None, :], -jnp.inf))
    kb = k * bt[..., None]
    L = jnp.where(strict, jnp.einsum('nbhcd,nbhsd->nbhcs', kb, k) * decay, 0.0)
    eye = jnp.eye(C, dtype=jnp.float32)
    Tm = lax.linalg.triangular_solve(eye + L, jnp.broadcast_to(eye, L.shape), left_side=True,
                                     lower=True, unit_diagonal=True)
    u = Tm @ (v * bt[..., None])
    wk = Tm @ (kb * jnp.exp(g)[..., None])
    attn = jnp.where(causal, jnp.einsum('nbhcd,nbhsd->nbhcs', q, k) * decay, 0.0)
    q_g = q * jnp.exp(g)[..., None]
    g_last = g[..., -1:]
    k_tail = k * jnp.exp(g_last - g)[..., None]
    chunk_decay = jnp.exp(g_last)[..., None]

    def step(S, inp):
        u_i, w_i, qg_i, at_i, kt_i, cd_i = inp
        v_new = u_i - w_i @ S
        o_i = qg_i @ S + at_i @ v_new
        S = S * cd_i + jnp.swapaxes(kt_i, -1, -2) @ v_new
        return S, o_i

    S, o = lax.scan(step, S0.astype(jnp.float32), (u, wk, q_g, attn, k_tail, chunk_decay))
    o = jnp.moveaxis(jnp.moveaxis(o, 0, 1), 2, 3).reshape(B, n * C, H, Dv)[:, :T]
    return o, S


def gdn_branch(pg, conv_prev, S0, lw):
    B, T, _ = pg.shape
    f32 = jnp.float32
    qkv, z, b_raw, a_raw = jnp.split(pg, G_SPLITS, axis=-1)
    full = jnp.concatenate([conv_prev.astype(qkv.dtype), qkv], axis=1)
    cw = lw['g_conv_w']
    conv = full[:, 0:T] * cw[0]
    for i in range(1, G_CONV):
        conv = conv + full[:, i:i + T] * cw[i]
    q, k, v = jnp.split(jax.nn.silu(conv), 3, axis=-1)
    heads = lambda t: t.reshape(B, T, G_HEADS, G_HEAD)
    q = l2_normalize(heads(q)) * (G_HEAD ** -0.5)
    k = l2_normalize(heads(k))
    v = heads(v).astype(f32)
    beta = jax.nn.sigmoid(b_raw.astype(f32))
    log_alpha = -jnp.exp(lw['g_a_log'].astype(f32)) * jax.nn.softplus(a_raw.astype(f32) + lw['g_dt_bias'])
    o, S = gated_delta_chunked(q, k, v, log_alpha, beta, S0)
    o = o * lax.rsqrt(jnp.mean(o * o, axis=-1, keepdims=True) + NORM_EPS) * lw['g_norm_w']
    o = o * jax.nn.silu(heads(z).astype(f32))
    return o.reshape(B, T, G_WIDTH).astype(pg.dtype), S, full[:, -(G_CONV - 1):]


def trunk_layer(x, c, wkv0, shift0, gdn0, conv0, lw):
    sh1, sc1, gt1, sh2, sc2, gt2 = adaln_params(c, lw['w_ada'], lw['b_ada'])
    h = rms_norm(x, lw['norm1_w']) * (1.0 + sc1) + sh1
    p = h @ lw['w_in']
    pr, pg, pm = jnp.split(p, (R_COLS, R_COLS + G_COLS), axis=-1)
    ya, wkv, shift = rwkv7_branch(pr, shift0, wkv0, lw)
    yb, gdn, conv = gdn_branch(pg, conv0, gdn0, lw)
    gate_a, gate_b = jnp.split(jax.nn.sigmoid(pm), 2, axis=-1)
    merged = gate_a * (ya @ lw['w_out_a']) + gate_b * (yb @ lw['w_out_b'])
    x = x + gt1 * (merged @ lw['w_out'])
    h2 = rms_norm(x, lw['norm2_w']) * (1.0 + sc2) + sh2
    x = x + gt2 * (jnp.square(jax.nn.relu(h2 @ lw['w_up'])) @ lw['w_down'])
    return x, (wkv, shift, gdn, conv)


def run_group(x, c, wkv0, shift0, gdn0, conv0, layers, final_norm_w):
    new = []
    for l in range(DEPTH):
        x, st = trunk_layer(x, c, wkv0[l], shift0[l], gdn0[l], conv0[l], layers[l])
        new.append(st)
    y = rms_norm(x, final_norm_w)
    return y, [jnp.stack([s[i] for s in new]) for i in range(4)]


def setup_inputs(seed: int = 0) -> dict:
    key = jax.random.key(seed)
    ks = list(jax.random.split(key, 48))
    f32 = jnp.float32
    nrm = lambda shape, s=1.0: s * jax.random.normal(ks.pop(), shape, f32)
    uni = lambda shape, lo, hi: jax.random.uniform(ks.pop(), shape, f32, lo, hi)
    L = DEPTH
    inp = {}
    inp['x_prompt'] = nrm((BATCH, SEQ, D_MODEL))
    inp['x_sample'] = nrm((DEC_BATCH, DEC_SEQ, D_MODEL))
    inp['state_rwkv_wkv'] = nrm((L, DEC_BATCH, R_HEADS, R_HEAD, R_HEAD), 0.5)
    inp['state_rwkv_shift'] = nrm((L, DEC_BATCH, R_COLS))
    inp['state_gdn'] = nrm((L, DEC_BATCH, G_HEADS, G_HEAD, G_HEAD), 0.5)
    inp['state_gdn_conv'] = nrm((L, DEC_BATCH, G_CONV - 1, G_CONV_COLS))
    inp['c_prompt'] = nrm((BATCH, D_MODEL))
    inp['c_sample'] = nrm((DEC_BATCH, D_MODEL))
    inp['norm1_w'] = 1.0 + nrm((L, D_MODEL), 0.01)
    inp['norm2_w'] = 1.0 + nrm((L, D_MODEL), 0.01)
    inp['w_ada'] = nrm((L, D_MODEL, 6 * D_MODEL), D_MODEL ** -0.5)
    inp['b_ada'] = nrm((L, 6 * D_MODEL), 0.01)
    inp['w_in'] = nrm((L, D_MODEL, IN_COLS), D_MODEL ** -0.5)
    inp['r_mu'] = uni((L, R_COLS), 0.0, 1.0)
    inp['r_w0'] = uni((L, R_WIDTH), -4.0, 1.0)
    inp['r_w_w2'] = nrm((L, R_DECAY_LORA, R_WIDTH), R_DECAY_LORA ** -0.5)
    inp['r_a0'] = nrm((L, R_WIDTH), 0.1)
    inp['r_w_a2'] = nrm((L, R_AAA_LORA, R_WIDTH), R_AAA_LORA ** -0.5)
    inp['r_w_g2'] = nrm((L, R_GATE_LORA, R_WIDTH), R_GATE_LORA ** -0.5)
    inp['r_k_k'] = 0.85 + nrm((L, R_WIDTH), 0.1)
    inp['r_k_a'] = 1.0 + nrm((L, R_WIDTH), 0.1)
    inp['r_r_k'] = nrm((L, R_HEADS, R_HEAD), 0.1)
    inp['r_lnx_w'] = 1.0 + nrm((L, R_WIDTH), 0.01)
    inp['r_lnx_b'] = nrm((L, R_WIDTH), 0.01)
    inp['g_conv_w'] = nrm((L, G_CONV, G_CONV_COLS), G_CONV ** -0.5)
    inp['g_a_log'] = jnp.log(uni((L, G_HEADS), 1.0, 16.0))
    inp['g_dt_bias'] = jnp.log(jnp.expm1(uni((L, G_HEADS), 0.001, 0.1)))
    inp['g_norm_w'] = 1.0 + nrm((L, G_HEAD), 0.01)
    inp['w_out_a'] = nrm((L, R_WIDTH, D_MODEL), R_WIDTH ** -0.5)
    inp['w_out_b'] = nrm((L, G_WIDTH, D_MODEL), G_WIDTH ** -0.5)
    inp['w_out'] = nrm((L, D_MODEL, D_MODEL), D_MODEL ** -0.5)
    inp['w_up'] = nrm((L, D_MODEL, D_FF), D_MODEL ** -0.5)
    inp['w_down'] = nrm((L, D_FF, D_MODEL), D_FF ** -0.5)
    inp['final_norm_w'] = 1.0 + nrm((D_MODEL,), 0.01)
    return inp


def reference(x_prompt, x_sample, state_rwkv_wkv, state_rwkv_shift, state_gdn, state_gdn_conv,
              c_prompt, c_sample, norm1_w, norm2_w, w_ada, b_ada, w_in, r_mu, r_w0, r_w_w2, r_a0,
              r_w_a2, r_w_g2, r_k_k, r_k_a, r_r_k, r_lnx_w, r_lnx_b, g_conv_w, g_a_log, g_dt_bias,
              g_norm_w, w_out_a, w_out_b, w_out, w_up, w_down, final_norm_w):
    layers = [dict(norm1_w=norm1_w[l], norm2_w=norm2_w[l], w_ada=w_ada[l], b_ada=b_ada[l],
                   w_in=w_in[l], r_mu=r_mu[l], r_w0=r_w0[l], r_w_w2=r_w_w2[l], r_a0=r_a0[l],
                   r_w_a2=r_w_a2[l], r_w_g2=r_w_g2[l], r_k_k=r_k_k[l], r_k_a=r_k_a[l],
                   r_r_k=r_r_k[l], r_lnx_w=r_lnx_w[l], r_lnx_b=r_lnx_b[l], g_conv_w=g_conv_w[l],
                   g_a_log=g_a_log[l], g_dt_bias=g_dt_bias[l], g_norm_w=g_norm_w[l],
                   w_out_a=w_out_a[l], w_out_b=w_out_b[l], w_out=w_out[l], w_up=w_up[l],
                   w_down=w_down[l]) for l in range(DEPTH)]
    bp = x_prompt.shape[0]
    y_prompt, (p_wkv, p_shift, p_gdn, p_conv) = run_group(
        x_prompt, c_prompt,
        jnp.zeros((DEPTH, bp, R_HEADS, R_HEAD, R_HEAD), jnp.float32),
        jnp.zeros((DEPTH, bp, R_COLS), x_prompt.dtype),
        jnp.zeros((DEPTH, bp, G_HEADS, G_HEAD, G_HEAD), jnp.float32),
        jnp.zeros((DEPTH, bp, G_CONV - 1, G_CONV_COLS), x_prompt.dtype),
        layers, final_norm_w)
    y_sample, (s_wkv, s_shift, s_gdn, s_conv) = run_group(
        x_sample, c_sample, state_rwkv_wkv, state_rwkv_shift, state_gdn, state_gdn_conv,
        layers, final_norm_w)
    return (y_prompt, y_sample, p_wkv, p_shift, p_gdn, p_conv, s_wkv, s_shift, s_gdn, s_conv)
```

```cpp
#include <hip/hip_runtime.h>
#include <cstdio>
#include <cstdint>

#ifndef MK_PER_PHASE
#define MK_PER_PHASE 1
#endif

#define GAS __attribute__((address_space(1)))
#define LAS __attribute__((address_space(3)))
typedef unsigned short bf16_t;
typedef short bf16x8 __attribute__((ext_vector_type(8)));
typedef float f32x4 __attribute__((ext_vector_type(4)));
typedef float f32x2 __attribute__((ext_vector_type(2)));
typedef unsigned u32x4 __attribute__((ext_vector_type(4)));
typedef unsigned u32x2 __attribute__((ext_vector_type(2)));

constexpr int D = 4096, NPROMPT = 8192, NSAMP = 512, MTOK = NPROMPT + NSAMP;
constexpr int TP = 2048, TS = 4, BP = 4, BS = 128, NSEQ = BP + BS;
constexpr int RW = 2048, RH = 64, RHEADS = 32, RCOLS = 6528;
constexpr int GW = 2048, GH = 128, GHEADS = 16, GCONV = 6144;
constexpr int INCOLS = 22944, LDP = 23040;
constexpr int PC_G = 6528, PC_Z = 6528 + 6144, PC_BETA = 14720, PC_ALPHA = 14736, PC_GA = 14848, PC_GB = 14848 + 4096;
constexpr int DFF = 16384, NMOD = 6 * D;
constexpr int LORA_K = 384, LORA_N = 6144;
constexpr int RREC = 384, GREC = 400;
constexpr size_t O_Y = 0, O_PWKV = 35651584, O_PSHIFT = 36175872, O_PGDN = 36201984, O_PCONV = 37250560, O_SWKV = 37324288, O_SSHIFT = 54101504, O_SGDN = 54937088, O_SCONV = 88491520, O_END = 90850816;

constexpr size_t MiB = 1u << 20;
constexpr size_t WS_CTL = 0, CTL_ZERO_BYTES = 1 * MiB;
constexpr size_t WS_WOAB = 2 * MiB, WS_WOUT = 34 * MiB, WS_WUP = 66 * MiB, WS_WDOWN = 194 * MiB, WS_MOD = 322 * MiB, WS_WLORA = 346 * MiB, WS_ALORA = 351 * MiB;
constexpr size_t WS_H = 358 * MiB, WS_P = 426 * MiB, WS_X = 809 * MiB;
constexpr size_t WS_WADA = WS_X, WS_AADA = WS_X + 192 * MiB, WS_WIN = WS_X + 194 * MiB;
constexpr size_t WS_LWAG = WS_X, WS_RSCAN = WS_X + 204 * MiB, WS_GSCAN = WS_X + 612 * MiB, WS_OA = WS_X + 825 * MiB, WS_OB = WS_H;
constexpr size_t WS_YAB = WS_GSCAN, WS_MERGED = WS_GSCAN + 68 * MiB, WS_X1 = WS_X, WS_U = WS_RSCAN, WS_X2 = WS_RSCAN + 272 * MiB;
constexpr size_t WS_END = 1728 * MiB;
static_assert(WS_OA + (size_t)MTOK * 2048 * 4 <= WS_END && WS_GSCAN + (size_t)MTOK * 16 * GREC * 4 <= WS_OA && WS_RSCAN + (size_t)MTOK * 32 * RREC * 4 <= WS_GSCAN && WS_LWAG + (size_t)MTOK * LORA_N * 4 <= WS_RSCAN, "ws map A");
static_assert(WS_WIN + (size_t)LDP * D * 2 <= WS_END && WS_P + (size_t)MTOK * LDP * 2 <= WS_X && WS_H + (size_t)MTOK * D * 2 <= WS_P && WS_X2 + (size_t)MTOK * D * 4 <= WS_GSCAN && WS_U + (size_t)MTOK * DFF * 2 <= WS_X2, "ws map B");

constexpr int RING_BYTES = 131072, MISC_OFF = RING_BYTES + 320, LDS_BYTES = 147456;
constexpr int NWAVES = 8, NTHREADS = 512;

__device__ __forceinline__ unsigned f2bf(float f) { unsigned u = __builtin_bit_cast(unsigned, f); return (u + 0x7fffu + ((u >> 16) & 1u)) >> 16; }
__device__ __forceinline__ float bf2f(unsigned short b) { return __builtin_bit_cast(float, ((unsigned)b) << 16); }
__device__ __forceinline__ unsigned pk2(float lo, float hi) { return f2bf(lo) | (f2bf(hi) << 16); }
__device__ __forceinline__ float bflo(unsigned w) { return __builtin_bit_cast(float, w << 16); }
__device__ __forceinline__ float bfhi(unsigned w) { return __builtin_bit_cast(float, w & 0xffff0000u); }
__device__ __forceinline__ float wave_sum(float v) {
#pragma unroll
    for (int o = 1; o < 64; o <<= 1) v += __shfl_xor(v, o);
    return v;
}
template <int CTRL> __device__ __forceinline__ float dppf(float x) { return __builtin_bit_cast(float, __builtin_amdgcn_mov_dpp(__builtin_bit_cast(int, x), CTRL, 0xf, 0xf, true)); }
__device__ __forceinline__ float row16_sum(float x) { x += dppf<0x128>(x); x += dppf<0x124>(x); x += dppf<0x122>(x); x += dppf<0x121>(x); return x; }
__device__ __forceinline__ float sigmoidf_(float x) { return 1.0f / (1.0f + __expf(-x)); }
__device__ __forceinline__ float fsig(float x) { return __builtin_amdgcn_rcpf(1.0f + __builtin_amdgcn_exp2f(x * -1.4426950408889634f)); }
__device__ __forceinline__ float softplusf_(float y) { return fmaxf(y, 0.f) + log1pf(__expf(-fabsf(y))); }
__device__ __forceinline__ int seq_of_row(int m) { return m < NPROMPT ? (m >> 11) : 4 + ((m - NPROMPT) >> 2); }

namespace pg8 {
constexpr int BM = 256, BK = 64, HALF = 128, HTB = HALF * BK * 2, STAGE_BYTES = 8 * HTB, NXCD = 8, WGM = 8;
__host__ __device__ __forceinline__ int lds_byte(int r, int c) { const int st = (r >> 4) * 2 + (c >> 5), rr = r & 15, cc = c & 31, ob = rr * 64 + cc * 2; return st * 1024 + (ob ^ (((ob >> 9) & 1) << 5)); }
__host__ __device__ __forceinline__ void stage_rc(int b, int& R, int& C) { const int st = b / 1024, sb = b % 1024, swz = sb ^ (((sb >> 9) & 1) << 5); R = (st >> 1) * 16 + swz / 64; C = (st & 1) * 32 + (swz % 64) / 2; }
__host__ __device__ __forceinline__ int perm32(int rho) { const int n = rho >> 4, i = rho & 15; return 8 * (i >> 2) + 4 * n + (i & 3); }

struct Unit { int pm, pn, koff, nt, fin; };
struct Gemm { const bf16_t* A; const bf16_t* Bt; int lda, ldb; };

template <int SPLIT> struct TileOrder {
    int nM, nN, nwg, G, c, nt;
    __device__ void init(int nM_, int nN_, int G_, int c_, int nt_) { nM = nM_; nN = nN_; nwg = nM * nN; G = G_; c = c_; nt = nt_; }
    __device__ bool next(int i, Unit& u) const {
        const int ti = i / SPLIT, hf = i % SPLIT;
        const long L = (long)ti * G + c; if (L >= nwg) return false;
        int wgid = (int)L; { const int q = nwg / NXCD, r = nwg % NXCD, xcd = wgid % NXCD, off = wgid / NXCD; wgid = (xcd < r ? xcd * (q + 1) : r * (q + 1) + (xcd - r) * q) + off; }
        const int nig = WGM * nN, gid = wgid / nig, fm = gid * WGM, gsz = (nM - fm) < WGM ? (nM - fm) : WGM;
        u.pm = fm + ((wgid % nig) % gsz); u.pn = (wgid % nig) / gsz; u.nt = nt; u.koff = hf * nt * BK * 2; u.fin = 1; return true;
    }
};

__device__ __forceinline__ unsigned cvt_pk_bf16(float lo, float hi) { unsigned r; asm volatile("v_cvt_pk_bf16_f32 %0, %1, %2" : "=v"(r) : "v"(lo), "v"(hi)); return r; }

#define ACC_T f32x4 (&acc)[2][2][4][2]
#define FOR_AIM _Pragma("unroll") for (int ai = 0; ai < 2; ++ai) _Pragma("unroll") for (int m = 0; m < 4; ++m)
#define FOR_BJN _Pragma("unroll") for (int bj = 0; bj < 2; ++bj) _Pragma("unroll") for (int n = 0; n < 2; ++n)

struct EpiF32Bias {
    static constexpr bool PERM = false, HAS_MID = false;
    float* C; int ldc; const float* bias;
    __device__ __forceinline__ void mid(ACC_T, const Unit&, int, int, int, int) const {}
    __device__ __forceinline__ void operator()(ACC_T, const Unit& u, int wr, int wc, int fr, int fq) const {
        const int row0 = u.pm * BM + wr * 64 + fr, col0 = u.pn * BM + wc * 32 + 4 * fq;
        f32x4 bv[2][2];
        FOR_BJN bv[bj][n] = *(const f32x4*)(bias + col0 + bj * HALF + n * 16);
        FOR_AIM { float* rowp = C + (size_t)(row0 + ai * HALF + m * 16) * ldc + col0;
            FOR_BJN *(f32x4*)(rowp + bj * HALF + n * 16) = acc[ai][bj][m][n] + bv[bj][n]; }
    }
};
template <int ACT  > struct EpiBf16 {
    static constexpr bool PERM = true, HAS_MID = false;
    bf16_t* O; int ldc;
    __device__ __forceinline__ void mid(ACC_T, const Unit&, int, int, int, int) const {}
    __device__ __forceinline__ void operator()(ACC_T, const Unit& u, int wr, int wc, int fr, int fq) const {
        const int row0 = u.pm * BM + wr * 64 + fr, col0 = u.pn * BM + wc * 32 + 8 * fq;
        FOR_AIM { bf16_t* rowp = O + (size_t)(row0 + ai * HALF + m * 16) * ldc + col0;
#pragma unroll
            for (int bj = 0; bj < 2; ++bj) { f32x4 v0 = acc[ai][bj][m][0], v1 = acc[ai][bj][m][1];
                if (ACT == 1) {
#pragma unroll
                    for (int j = 0; j < 4; ++j) { const float a = fmaxf(v0[j], 0.f), b = fmaxf(v1[j], 0.f); v0[j] = a * a; v1[j] = b * b; } }
                u32x4 w; w.x = cvt_pk_bf16(v0[0], v0[1]); w.y = cvt_pk_bf16(v0[2], v0[3]); w.z = cvt_pk_bf16(v1[0], v1[1]); w.w = cvt_pk_bf16(v1[2], v1[3]);
                *(u32x4*)(rowp + bj * HALF) = w; } }
    }
};
struct EpiLora {
    static constexpr bool PERM = false, HAS_MID = false;
    float* C; const float* w0; const float* a0;
    __device__ __forceinline__ void mid(ACC_T, const Unit&, int, int, int, int) const {}
    __device__ __forceinline__ void operator()(ACC_T, const Unit& u, int wr, int wc, int fr, int fq) const {
        const int row0 = u.pm * BM + wr * 64 + fr, col0 = u.pn * BM + wc * 32 + 4 * fq, seg = u.pn >> 3, cs0 = col0 - seg * 2048;
        f32x4 bv[2][2];
        FOR_BJN bv[bj][n] = seg == 0 ? *(const f32x4*)(w0 + cs0 + bj * HALF + n * 16) : seg == 1 ? *(const f32x4*)(a0 + cs0 + bj * HALF + n * 16) : (f32x4){0.f, 0.f, 0.f, 0.f};
        FOR_AIM { float* rowp = C + (size_t)(row0 + ai * HALF + m * 16) * LORA_N + col0;
            FOR_BJN { f32x4 v = acc[ai][bj][m][n] + bv[bj][n];
                if (seg == 0) {
#pragma unroll
                    for (int j = 0; j < 4; ++j) { const float lw = -softplusf_(-v[j]) - 0.5f; v[j] = __expf(-__expf(lw)); } }
                else if (seg == 1) {
#pragma unroll
                    for (int j = 0; j < 4; ++j) v[j] = sigmoidf_(v[j]); }
                *(f32x4*)(rowp + bj * HALF + n * 16) = v; } }
    }
};
struct EpiMerge {
    static constexpr bool PERM = true, HAS_MID = false;
    bf16_t* O; const bf16_t* P; float* T;
    __device__ __forceinline__ void mid(ACC_T, const Unit&, int, int, int, int) const {}
    __device__ __forceinline__ void operator()(ACC_T, const Unit& u, int wr, int wc, int fr, int fq) const {
        const int row0 = u.pm * BM + wr * 64 + fr, col0 = u.pn * BM + wc * 32 + 8 * fq; const bool second = u.koff != 0;
        FOR_AIM { const int row = row0 + ai * HALF + m * 16; bf16_t* rowp = O + (size_t)row * D + col0; float* trow = T + (size_t)row * D + col0; const bf16_t* grow = P + (size_t)row * LDP + (second ? PC_GB : PC_GA) + col0;
#pragma unroll
            for (int bj = 0; bj < 2; ++bj) { const u32x4 gw = *(const u32x4*)(grow + bj * HALF);
                f32x4 v0 = acc[ai][bj][m][0], v1 = acc[ai][bj][m][1];
                v0[0] *= fsig(bflo(gw.x)); v0[1] *= fsig(bfhi(gw.x)); v0[2] *= fsig(bflo(gw.y)); v0[3] *= fsig(bfhi(gw.y));
                v1[0] *= fsig(bflo(gw.z)); v1[1] *= fsig(bfhi(gw.z)); v1[2] *= fsig(bflo(gw.w)); v1[3] *= fsig(bfhi(gw.w));
                if (!second) { *(f32x4*)(trow + bj * HALF) = v0; *(f32x4*)(trow + bj * HALF + 4) = v1; }
                else { v0 += *(const f32x4*)(trow + bj * HALF); v1 += *(const f32x4*)(trow + bj * HALF + 4);
                    u32x4 w; w.x = cvt_pk_bf16(v0[0], v0[1]); w.y = cvt_pk_bf16(v0[2], v0[3]); w.z = cvt_pk_bf16(v1[0], v1[1]); w.w = cvt_pk_bf16(v1[2], v1[3]);
                    *(u32x4*)(rowp + bj * HALF) = w; } }
            asm volatile("" ::: "memory"); }
    }
};
struct EpiResGate {
    static constexpr bool PERM = false, HAS_MID = false;
    const float* bp; const float* bs; const float* gate; float* out;
    __device__ __forceinline__ void mid(ACC_T, const Unit&, int, int, int, int) const {}
    __device__ __forceinline__ void operator()(ACC_T, const Unit& u, int wr, int wc, int fr, int fq) const {
        const int row0 = u.pm * BM + wr * 64 + fr, col0 = u.pn * BM + wc * 32 + 4 * fq;
        FOR_AIM { const int row = row0 + ai * HALF + m * 16; const int s = seq_of_row(row);
            const float* brow = (row < NPROMPT ? bp + (size_t)row * D : bs + (size_t)(row - NPROMPT) * D) + col0; const float* grow = gate + (size_t)s * NMOD + col0; float* orow = out + (size_t)row * D + col0;
            FOR_BJN { const f32x4 bsv = *(const f32x4*)(brow + bj * HALF + n * 16), gv = *(const f32x4*)(grow + bj * HALF + n * 16);
                *(f32x4*)(orow + bj * HALF + n * 16) = bsv + gv * acc[ai][bj][m][n]; } }
    }
};

template <class Epi, class Sched>
__device__ __forceinline__ void gemm_phase(LAS unsigned char* lds, const Gemm g, const Sched& S, const Epi& E) {
    const int tid = threadIdx.x, wid = __builtin_amdgcn_readfirstlane(tid >> 6), lane = tid & 63, wr = wid >> 2, wc = wid & 3, fr = lane & 15, fq = lane >> 4;
    unsigned voffA[2], voffB[2];
#pragma unroll
    for (int i = 0; i < 2; ++i) { int R, C; stage_rc(tid * 16 + i * 8192, R, C); const int Rb = Epi::PERM ? ((R & ~31) + perm32(R & 31)) : R;
        voffA[i] = (unsigned)(R * g.lda + C) * 2u; voffB[i] = (unsigned)(Rb * g.ldb + C) * 2u; }
    const size_t kstep = (size_t)(BK * 2);
    const size_t hstepA = (size_t)HALF * g.lda * 2, hstepB = (size_t)HALF * g.ldb * 2, tstepA = 2 * hstepA, tstepB = 2 * hstepB;
    const unsigned ldsw = (unsigned)wid * 1024u;
    const int aoff = lds_byte(wr * 64 + fr, fq * 8), boff = lds_byte(wc * 32 + fr, fq * 8);
#define PG8_SA(b, h) (((b) * 2 + (h)) * HTB)
#define PG8_SB(b, h) ((4 + (b) * 2 + (h)) * HTB)
#define PG8_STAGE(bufoff, gbase, voff) do { _Pragma("unroll") for (int _i = 0; _i < 2; ++_i) \
        __builtin_amdgcn_global_load_lds((const unsigned*)((const char*)(gbase) + (voff)[_i]), (LAS unsigned*)(lds + (bufoff) + ldsw + _i * 8192), 16, 0, 0); } while (0)
#define PG8_LDA(dst, b, h) do { _Pragma("unroll") for (int m = 0; m < 4; ++m) _Pragma("unroll") for (int k = 0; k < 2; ++k) dst[m][k] = *(const LAS bf16x8*)(lds + PG8_SA(b, h) + aoff + m * 2048 + k * 1024); } while (0)
#define PG8_LDB(dst, b, h) do { _Pragma("unroll") for (int n = 0; n < 2; ++n) _Pragma("unroll") for (int k = 0; k < 2; ++k) dst[n][k] = *(const LAS bf16x8*)(lds + PG8_SB(b, h) + boff + n * 2048 + k * 1024); } while (0)
#define PG8_MMA(ai, bj, At, Bt) do { __builtin_amdgcn_s_setprio(1); _Pragma("unroll") for (int m = 0; m < 4; ++m) _Pragma("unroll") for (int n = 0; n < 2; ++n) _Pragma("unroll") for (int k = 0; k < 2; ++k) \
        acc[ai][bj][m][n] = __builtin_amdgcn_mfma_f32_16x16x32_bf16(Bt[n][k], At[m][k], acc[ai][bj][m][n], 0, 0, 0); __builtin_amdgcn_s_setprio(0); } while (0)
#define PG8_WAIT_V(n) asm volatile("s_waitcnt vmcnt(" #n ")" ::: "memory")
#define PG8_WAIT_L(n) asm volatile("s_waitcnt lgkmcnt(" #n ")" ::: "memory")
#define PG8_BAR __builtin_amdgcn_s_barrier()
#define PG8_SCHED __builtin_amdgcn_sched_barrier(0)
    Unit cur, nxt; int ui = 0;
    if (!S.next(0, cur)) return;
    f32x4 acc[2][2][4][2];
#pragma unroll
    for (int a = 0; a < 2; ++a)
#pragma unroll
        for (int b = 0; b < 2; ++b)
#pragma unroll
            for (int m = 0; m < 4; ++m)
#pragma unroll
                for (int n = 0; n < 2; ++n) acc[a][b][m][n] = (f32x4){0.f, 0.f, 0.f, 0.f};
    bf16x8 At[4][2], B0[2][2], B1[2][2];
    const char* cA = (const char*)g.A + (size_t)cur.pm * tstepA + cur.koff; const char* cB = (const char*)g.Bt + (size_t)cur.pn * tstepB + cur.koff;
    PG8_STAGE(PG8_SB(0, 0), cB, voffB); PG8_STAGE(PG8_SB(0, 1), cB + hstepB, voffB); PG8_STAGE(PG8_SA(0, 0), cA, voffA); PG8_STAGE(PG8_SA(0, 1), cA + hstepA, voffA);
    if (wr == 1) PG8_BAR;
    PG8_WAIT_V(2); PG8_BAR;
    PG8_STAGE(PG8_SB(1, 0), cB + kstep, voffB); PG8_STAGE(PG8_SA(1, 0), cA + kstep, voffA); PG8_STAGE(PG8_SB(1, 1), cB + hstepB + kstep, voffB);
    PG8_WAIT_V(6); PG8_BAR;
    for (;;) {
        const bool has_next = S.next(ui + 1, nxt);
        const char* nA = has_next ? (const char*)g.A + (size_t)nxt.pm * tstepA + nxt.koff : cA; const char* nB = has_next ? (const char*)g.Bt + (size_t)nxt.pn * tstepB + nxt.koff : cB;
        const int nt = cur.nt;
        for (int t = 0; t < nt; t += 2) {
            const bool last = (t == nt - 2);
            const char* a1 = cA + (size_t)(t + 1) * kstep;
            const char* a2 = last ? nA : cA + (size_t)(t + 2) * kstep; const char* b2 = last ? nB : cB + (size_t)(t + 2) * kstep;
            const char* a3 = a2 + kstep; const char* b3 = b2 + kstep;
            PG8_LDB(B0, 0, 0); PG8_LDB(B1, 0, 1); PG8_SCHED; PG8_LDA(At, 0, 0); PG8_STAGE(PG8_SA(1, 1), a1 + hstepA, voffA);
            PG8_WAIT_V(8); PG8_WAIT_L(0); PG8_BAR; PG8_MMA(0, 0, At, B0); PG8_MMA(0, 1, At, B1); PG8_BAR; PG8_SCHED;
            PG8_LDA(At, 0, 1); PG8_STAGE(PG8_SB(0, 0), b2, voffB); PG8_STAGE(PG8_SB(0, 1), b2 + hstepB, voffB); PG8_STAGE(PG8_SA(0, 0), a2, voffA);
            PG8_WAIT_V(8); PG8_WAIT_L(0); PG8_BAR; PG8_MMA(1, 0, At, B0); PG8_MMA(1, 1, At, B1); PG8_BAR; PG8_SCHED;
            PG8_LDB(B0, 1, 0); PG8_LDB(B1, 1, 1); PG8_SCHED; PG8_LDA(At, 1, 0); PG8_STAGE(PG8_SA(0, 1), a2 + hstepA, voffA);
            PG8_WAIT_V(8); PG8_WAIT_L(0); PG8_BAR; PG8_MMA(0, 0, At, B0); PG8_MMA(0, 1, At, B1); PG8_BAR; PG8_SCHED;
            PG8_LDA(At, 1, 1); PG8_STAGE(PG8_SB(1, 0), b3, voffB); PG8_STAGE(PG8_SB(1, 1), b3 + hstepB, voffB); PG8_STAGE(PG8_SA(1, 0), a3, voffA);
            PG8_WAIT_V(8); PG8_WAIT_L(0); PG8_BAR; PG8_MMA(1, 0, At, B0); PG8_MMA(1, 1, At, B1); PG8_BAR; PG8_SCHED;
        }
        if (wr == 0) PG8_BAR;
        if (cur.fin) {
            E(acc, cur, wr, wc, fr, fq);
            if (has_next) {
#pragma unroll
                for (int a = 0; a < 2; ++a)
#pragma unroll
                    for (int b = 0; b < 2; ++b)
#pragma unroll
                        for (int m = 0; m < 4; ++m)
#pragma unroll
                            for (int n = 0; n < 2; ++n) acc[a][b][m][n] = (f32x4){0.f, 0.f, 0.f, 0.f};
            }
        } else { if constexpr (Epi::HAS_MID) E.mid(acc, cur, wr, wc, fr, fq); }
        if (!has_next) break;
        cur = nxt; cA = nA; cB = nB; ++ui;
        if (wr == 1) PG8_BAR;
    }
    PG8_WAIT_V(0);
    PG8_BAR;
#undef PG8_SA
#undef PG8_SB
#undef PG8_STAGE
#undef PG8_LDA
#undef PG8_LDB
#undef PG8_MMA
#undef PG8_WAIT_V
#undef PG8_WAIT_L
#undef PG8_BAR
#undef PG8_SCHED
}
}

#define XB_TMO      128
#define XB_XCNT(j)  (256  + 64 * (j))
#define XB_XSUB(j)  (1280 + 64 * (j))
#define XB_XGEN(j)  (2304 + 64 * (j))
#define XB_TOP      3328
#define XB_TOPGEN   3392
#define XCD_BAR_WORDS 3456
#define XB_SPIN_CAP (1u << 18)
__device__ __forceinline__ unsigned xb_ld(unsigned* p)              { return __hip_atomic_load(p, __ATOMIC_RELAXED, __HIP_MEMORY_SCOPE_AGENT); }
__device__ __forceinline__ unsigned xb_add(unsigned* p, unsigned v) { return __hip_atomic_fetch_add(p, v, __ATOMIC_RELAXED, __HIP_MEMORY_SCOPE_AGENT); }
__device__ __forceinline__ unsigned xb_xcc_id() { return (unsigned)__builtin_amdgcn_s_getreg((3 << 11) | 20) & 0xFu; }
#define XB_SPIN(cond, bar) do { unsigned _sp = 0; while (cond) { __builtin_amdgcn_s_sleep(1); \
    if ((++_sp & 255u) == 0u) { if (xb_ld(&(bar)[XB_TMO])) break; if (_sp > XB_SPIN_CAP) { atomicAdd(&(bar)[XB_TMO], 1u); break; } } } } while (0)
struct XcdBarrier { unsigned* bar; unsigned x; volatile LAS unsigned* st; };
__device__ __forceinline__ XcdBarrier xcd_barrier_post(unsigned* bar, volatile LAS unsigned* st) {
    XcdBarrier b; b.bar = bar; b.x = xb_xcc_id(); b.st = st;
    if (threadIdx.x == 0) (void)xb_add(&bar[XB_XCNT(b.x)], 1u);
    return b;
}
__device__ __forceinline__ void xcd_barrier_complete(unsigned* bar, unsigned x, unsigned& nloc, unsigned& nx) {
    const unsigned G = gridDim.x * gridDim.y * gridDim.z;
    unsigned sum, cnt, mine, sp = 0u;
    for (;;) {
        sum = 0u; cnt = 0u; mine = 0u;
#pragma unroll
        for (unsigned j = 0; j < 16; ++j) { const unsigned c = xb_ld(&bar[XB_XCNT(j)]); sum += c; cnt += (c > 0u) ? 1u : 0u; mine = (j == x) ? c : mine; }
        if (sum == G) break;
        __builtin_amdgcn_s_sleep(1);
        if ((++sp & 255u) == 0u) { if (xb_ld(&bar[XB_TMO])) break; if (sp > XB_SPIN_CAP) { atomicAdd(&bar[XB_TMO], 1u); break; } }
    }
    nloc = mine > 0u ? mine : 1u; nx = cnt > 0u ? cnt : 1u;
}
__device__ __forceinline__ void xcd_barrier(const XcdBarrier& b) {
    asm volatile("s_waitcnt vmcnt(0)" ::: "memory");
    __syncthreads();
    if (threadIdx.x == 0) {
        unsigned* bar = b.bar;
        __builtin_amdgcn_s_waitcnt(0);
        unsigned nloc = b.st[0], nx = b.st[1];
        if (nloc == 0u) { xcd_barrier_complete(bar, b.x, nloc, nx); b.st[0] = nloc; b.st[1] = nx; }
        const unsigned old = xb_add(&bar[XB_XSUB(b.x)], 1u);
        const unsigned gen = old / nloc;
        if (old + 1u == (gen + 1u) * nloc) {
            __builtin_amdgcn_fence(__ATOMIC_RELEASE, "agent");
            asm volatile("s_waitcnt vmcnt(0)" ::: "memory");
            const unsigned og = xb_add(&bar[XB_TOP], 1u);
            const unsigned tg = og / nx;
            if (og + 1u == (tg + 1u) * nx) xb_add(&bar[XB_TOPGEN], 1u);
            else XB_SPIN(xb_ld(&bar[XB_TOPGEN]) == tg, bar);
            __builtin_amdgcn_fence(__ATOMIC_ACQUIRE, "agent");
            xb_add(&bar[XB_XGEN(b.x)], 1u);
            asm volatile("s_waitcnt vmcnt(0)" ::: "memory");
        } else {
            XB_SPIN(xb_ld(&bar[XB_XGEN(b.x)]) == gen, bar);
            __builtin_amdgcn_fence(__ATOMIC_ACQUIRE, "agent");
            asm volatile("s_waitcnt vmcnt(0)" ::: "memory");
        }
    }
    __syncthreads();
}

constexpr int CW_BAR = 4096;
struct Args { const float* in[34]; float* out; unsigned char* ws; int ph_lo, ph_hi; };
enum { I_XP = 0, I_XS, I_SWKV, I_SSHIFT, I_SGDN, I_SCONV, I_CP, I_CS, I_N1W, I_N2W, I_WADA, I_BADA, I_WIN, I_RMU, I_RW0, I_RWW2, I_RA0, I_RWA2, I_RWG2, I_RKK, I_RKA, I_RRK, I_LNXW, I_LNXB, I_CONVW, I_ALOG, I_DTB, I_GNW, I_WOA, I_WOB, I_WOUT, I_WUP, I_WDOWN, I_FNW };
constexpr int NPHASE = 15;

__device__ __forceinline__ void transpose_item(const float* W, int N, int k0, int n0, bf16_t* WT, size_t dst_row0, int dst_ld, int dst_k0, LAS float* scr, int lane) {
#pragma unroll 8
    for (int i = 0; i < 32; ++i) { const int kk = 2 * i + (lane >> 5); scr[kk * 33 + (lane & 31)] = W[(size_t)(k0 + kk) * N + n0 + (lane & 31)]; }
    asm volatile("s_waitcnt lgkmcnt(0)" ::: "memory");
    const int c = lane & 7;
#pragma unroll
    for (int j = 0; j < 4; ++j) { const int n = (lane >> 3) + 8 * j; const LAS float* s = scr + (8 * c) * 33 + n;
        u32x4 o; o.x = pk2(s[0 * 33], s[1 * 33]); o.y = pk2(s[2 * 33], s[3 * 33]); o.z = pk2(s[4 * 33], s[5 * 33]); o.w = pk2(s[6 * 33], s[7 * 33]);
        *(u32x4*)(WT + (dst_row0 + n) * (size_t)dst_ld + dst_k0 + k0 + 8 * c) = o; }
    asm volatile("s_waitcnt lgkmcnt(0)" ::: "memory");
}

template <int MODE>
__device__ __forceinline__ void norm_rows(const float* xp, const float* xs_, const float* nw, const float* mod, int sh_off, int sc_off, bf16_t* ob, float* of, int gw, int NGW, int lane) {
    for (int m = gw; m < MTOK; m += NGW) {
        const float* xr = (m < NPROMPT ? xp + (size_t)m * D : xs_ + (size_t)(m - NPROMPT) * D);
        f32x4 v[16]; float ss = 0.f;
#pragma unroll
        for (int j = 0; j < 16; ++j) { v[j] = *(const f32x4*)(xr + (j * 64 + lane) * 4); ss += (v[j].x * v[j].x + v[j].y * v[j].y) + (v[j].z * v[j].z + v[j].w * v[j].w); }
        const float rstd = 1.0f / sqrtf(wave_sum(ss) * (1.0f / D) + 1e-6f);
        if (MODE == 0) {
            const int s = seq_of_row(m); const float* mr = mod + (size_t)s * NMOD;
#pragma unroll
            for (int j = 0; j < 16; ++j) { const int c = (j * 64 + lane) * 4; const f32x4 w = *(const f32x4*)(nw + c), sc = *(const f32x4*)(mr + sc_off + c), sh = *(const f32x4*)(mr + sh_off + c);
                const f32x4 y = v[j] * rstd * w * (sc + 1.0f) + sh; u32x2 o; o.x = pk2(y.x, y.y); o.y = pk2(y.z, y.w); *(u32x2*)(ob + (size_t)m * D + c) = o; }
        } else {
#pragma unroll
            for (int j = 0; j < 16; ++j) { const int c = (j * 64 + lane) * 4; const f32x4 w = *(const f32x4*)(nw + c); *(f32x4*)(of + (size_t)m * D + c) = v[j] * rstd * w; }
        }
    }
}

#define RWKV_STEP(S, w4, kk4, b4, kp4, r4, vv, oo) do { \
    float sa_ = S.x * kk4.x + S.y * kk4.y + S.z * kk4.z + S.w * kk4.w; sa_ = -row16_sum(sa_); \
    S.x = S.x * w4.x + sa_ * b4.x + vv * kp4.x; S.y = S.y * w4.y + sa_ * b4.y + vv * kp4.y; S.z = S.z * w4.z + sa_ * b4.z + vv * kp4.z; S.w = S.w * w4.w + sa_ * b4.w + vv * kp4.w; \
    float o_ = S.x * r4.x + S.y * r4.y + S.z * r4.z + S.w * r4.w; oo = row16_sum(o_); } while (0)

__device__ __forceinline__ void rwkv_prompt_item(LAS unsigned char* lds, const float* RS, float* OA, float* outS, int item, int w, int lane) {
    constexpr int CH = 16, CHB = CH * RREC * 4, NB = 5, NCH = TP / CH;
    const int bh = item >> 1, half = item & 1, b = bh >> 5, h = bh & 31, rg = lane >> 4, kq = lane & 15, row = half * 32 + w * 4 + rg;
    const char* src = (const char*)(RS + (size_t)bh * TP * RREC);
#define RW_ISSUE(ci) do { const int cs_ = (ci) < NCH ? (ci) : NCH - 1; const int sl_ = (ci) % NB; _Pragma("unroll") for (int i_ = 0; i_ < 3; ++i_) { const int pc_ = w * 3 + i_; \
        __builtin_amdgcn_global_load_lds((const unsigned*)(src + (size_t)cs_ * CHB + pc_ * 1024 + lane * 16), (LAS unsigned*)(lds + sl_ * CHB + pc_ * 1024), 16, 0, 0); } } while (0)
    f32x4 S = (f32x4){0.f, 0.f, 0.f, 0.f}; float okeep = 0.f;
#pragma unroll
    for (int ci = 0; ci < NB - 1; ++ci) RW_ISSUE(ci);
    for (int ci = 0; ci < NCH; ++ci) {
        asm volatile("s_waitcnt vmcnt(9)" ::: "memory"); __builtin_amdgcn_s_barrier(); asm volatile("" ::: "memory");
        RW_ISSUE(ci + NB - 1);
        const LAS unsigned char* sl = lds + (ci % NB) * CHB;
#pragma unroll 4
        for (int st = 0; st < CH; ++st) { const LAS unsigned char* rec = sl + st * (RREC * 4);
            const f32x4 w4 = *(const LAS f32x4*)(rec + kq * 16), kk4 = *(const LAS f32x4*)(rec + 256 + kq * 16), b4 = *(const LAS f32x4*)(rec + 512 + kq * 16), kp4 = *(const LAS f32x4*)(rec + 768 + kq * 16), r4 = *(const LAS f32x4*)(rec + 1024 + kq * 16);
            const float vv = *(const LAS float*)(rec + 1280 + row * 4); float oo;
            RWKV_STEP(S, w4, kk4, b4, kp4, r4, vv, oo);
            okeep = (kq == st) ? oo : okeep; }
        OA[(size_t)(b * TP + ci * CH + kq) * RW + h * RH + row] = okeep;
    }
    *(f32x4*)(outS + ((size_t)bh * RH + row) * RH + 4 * kq) = S;
    asm volatile("s_waitcnt vmcnt(0)" ::: "memory"); __builtin_amdgcn_s_barrier(); asm volatile("" ::: "memory");
#undef RW_ISSUE
}
__device__ __forceinline__ void rwkv_sample_item(const float* RS, const float* S0, float* OA, float* outS, int item, int lane) {
    const int bh = item >> 2, q4 = item & 3, b = bh >> 5, h = bh & 31, rg = lane >> 4, kq = lane & 15;
    const float* rec = RS + ((size_t)BP * RHEADS * TP + (size_t)bh * TS) * RREC;
    f32x4 w4[4], kk4[4], b4[4], kp4[4], r4[4];
#pragma unroll
    for (int t = 0; t < 4; ++t) { const float* r = rec + t * RREC + 4 * kq; w4[t] = *(const f32x4*)(r); kk4[t] = *(const f32x4*)(r + 64); b4[t] = *(const f32x4*)(r + 128); kp4[t] = *(const f32x4*)(r + 192); r4[t] = *(const f32x4*)(r + 256); }
    f32x4 S[4]; float vv[4][4];
#pragma unroll
    for (int sub = 0; sub < 4; ++sub) { const int row = q4 * 16 + sub * 4 + rg; S[sub] = *(const f32x4*)(S0 + ((size_t)bh * RH + row) * RH + 4 * kq);
#pragma unroll
        for (int t = 0; t < 4; ++t) vv[sub][t] = rec[t * RREC + 320 + row]; }
#pragma unroll
    for (int sub = 0; sub < 4; ++sub) { const int row = q4 * 16 + sub * 4 + rg; float okeep = 0.f;
#pragma unroll
        for (int t = 0; t < 4; ++t) { float oo; RWKV_STEP(S[sub], w4[t], kk4[t], b4[t], kp4[t], r4[t], vv[sub][t], oo); okeep = (kq == t) ? oo : okeep; }
        if (kq < 4) OA[(size_t)(NPROMPT + b * TS + kq) * RW + h * RH + row] = okeep;
        *(f32x4*)(outS + ((size_t)bh * RH + row) * RH + 4 * kq) = S[sub]; }
}
__device__ __forceinline__ void gdn_prompt_item(LAS unsigned char* lds, const float* GS, float* OB, float* outS, int item, int w, int lane) {
    constexpr int CH = 16, CHB = CH * GREC * 4, NB = 5, NCH = TP / CH, NPIECE = CHB / 1024;
    const int bh = item >> 2, qd = item & 3, b = bh >> 4, h = bh & 15, cc = lane >> 4, dq = lane & 15, col = qd * 32 + w * 4 + cc;
    const char* src = (const char*)(GS + (size_t)bh * TP * GREC);
#define GD_ISSUE(ci) do { const int cs_ = (ci) < NCH ? (ci) : NCH - 1; const int sl_ = (ci) % NB; _Pragma("unroll") for (int i_ = 0; i_ < 4; ++i_) { int pc_ = w * 4 + i_; pc_ = pc_ < NPIECE ? pc_ : NPIECE - 1; \
        __builtin_amdgcn_global_load_lds((const unsigned*)(src + (size_t)cs_ * CHB + pc_ * 1024 + lane * 16), (LAS unsigned*)(lds + sl_ * CHB + pc_ * 1024), 16, 0, 0); } } while (0)
    float S[8];
#pragma unroll
    for (int j = 0; j < 8; ++j) S[j] = 0.f;
    float okeep = 0.f;
#pragma unroll
    for (int ci = 0; ci < NB - 1; ++ci) GD_ISSUE(ci);
    for (int ci = 0; ci < NCH; ++ci) {
        asm volatile("s_waitcnt vmcnt(12)" ::: "memory"); __builtin_amdgcn_s_barrier(); asm volatile("" ::: "memory");
        GD_ISSUE(ci + NB - 1);
        const LAS unsigned char* sl = lds + (ci % NB) * CHB;
#pragma unroll 4
        for (int st = 0; st < CH; ++st) { const LAS unsigned char* rec = sl + st * (GREC * 4);
            const f32x4 q0 = *(const LAS f32x4*)(rec + dq * 32), q1 = *(const LAS f32x4*)(rec + dq * 32 + 16), k0 = *(const LAS f32x4*)(rec + 512 + dq * 32), k1 = *(const LAS f32x4*)(rec + 512 + dq * 32 + 16);
            const float vv = *(const LAS float*)(rec + 1024 + col * 4); const f32x4 sc = *(const LAS f32x4*)(rec + 1536);
            float ks = S[0] * k0.x + S[1] * k0.y + S[2] * k0.z + S[3] * k0.w + S[4] * k1.x + S[5] * k1.y + S[6] * k1.z + S[7] * k1.w;
            float qs = S[0] * q0.x + S[1] * q0.y + S[2] * q0.z + S[3] * q0.w + S[4] * q1.x + S[5] * q1.y + S[6] * q1.z + S[7] * q1.w;
            ks = row16_sum(ks); qs = row16_sum(qs);
            const float u = sc.y * (vv - sc.x * ks), oo = sc.x * qs + sc.z * u;
            S[0] = sc.x * S[0] + k0.x * u; S[1] = sc.x * S[1] + k0.y * u; S[2] = sc.x * S[2] + k0.z * u; S[3] = sc.x * S[3] + k0.w * u;
            S[4] = sc.x * S[4] + k1.x * u; S[5] = sc.x * S[5] + k1.y * u; S[6] = sc.x * S[6] + k1.z * u; S[7] = sc.x * S[7] + k1.w * u;
            okeep = (dq == st) ? oo : okeep; }
        OB[(size_t)(b * TP + ci * CH + dq) * GW + h * GH + col] = okeep;
    }
#pragma unroll
    for (int j = 0; j < 8; ++j) outS[((size_t)bh * GH + dq * 8 + j) * GH + col] = S[j];
    asm volatile("s_waitcnt vmcnt(0)" ::: "memory"); __builtin_amdgcn_s_barrier(); asm volatile("" ::: "memory");
#undef GD_ISSUE
}
__device__ __forceinline__ void gdn_sample_item(LAS float* scr, const float* GS, const float* S0, float* OB, float* outS, int item, int lane) {
    const int bh = item >> 2, qd = item & 3, b = bh >> 4, h = bh & 15, hf = lane >> 5, col = qd * 32 + (lane & 31);
    const float* rec = GS + ((size_t)BP * GHEADS * TP + (size_t)bh * TS) * GREC;
#pragma unroll
    for (int i = 0; i < 25; ++i) scr[i * 64 + lane] = rec[i * 64 + lane];
    float S[64];
    const float* s0 = S0 + ((size_t)bh * GH + hf * 64) * GH + col;
#pragma unroll
    for (int j = 0; j < 64; ++j) S[j] = s0[(size_t)j * GH];
    asm volatile("s_waitcnt lgkmcnt(0)" ::: "memory");
#pragma unroll
    for (int t = 0; t < 4; ++t) { const LAS float* r = scr + t * GREC;
        float ks = 0.f, qs = 0.f;
#pragma unroll
        for (int j4 = 0; j4 < 16; ++j4) { const f32x4 q4 = *(const LAS f32x4*)(r + hf * 64 + j4 * 4), k4 = *(const LAS f32x4*)(r + 128 + hf * 64 + j4 * 4);
            ks += S[j4 * 4] * k4.x + S[j4 * 4 + 1] * k4.y + S[j4 * 4 + 2] * k4.z + S[j4 * 4 + 3] * k4.w; qs += S[j4 * 4] * q4.x + S[j4 * 4 + 1] * q4.y + S[j4 * 4 + 2] * q4.z + S[j4 * 4 + 3] * q4.w; }
        ks += __shfl_xor(ks, 32); qs += __shfl_xor(qs, 32);
        const float vv = r[256 + col]; const f32x4 sc = *(const LAS f32x4*)(r + 384);
        const float u = sc.y * (vv - sc.x * ks), oo = sc.x * qs + sc.z * u;
#pragma unroll
        for (int j4 = 0; j4 < 16; ++j4) { const f32x4 k4 = *(const LAS f32x4*)(r + 128 + hf * 64 + j4 * 4);
            S[j4 * 4] = sc.x * S[j4 * 4] + k4.x * u; S[j4 * 4 + 1] = sc.x * S[j4 * 4 + 1] + k4.y * u; S[j4 * 4 + 2] = sc.x * S[j4 * 4 + 2] + k4.z * u; S[j4 * 4 + 3] = sc.x * S[j4 * 4 + 3] + k4.w * u; }
        if (hf == 0) OB[(size_t)(NPROMPT + b * TS + t) * GW + h * GH + col] = oo; }
    float* so = outS + ((size_t)bh * GH + hf * 64) * GH + col;
#pragma unroll
    for (int j = 0; j < 64; ++j) so[(size_t)j * GH] = S[j];
    asm volatile("s_waitcnt lgkmcnt(0)" ::: "memory");
}

__global__ void __launch_bounds__(NTHREADS, 2) fwd_kernel(Args args) {
    extern __shared__ __attribute__((aligned(16))) unsigned char lds_raw[];
    LAS unsigned char* lds = (LAS unsigned char*)lds_raw;
    volatile LAS unsigned* MISC = (volatile LAS unsigned*)(lds + MISC_OFF);
    const int tid = threadIdx.x, lane = tid & 63, wave = __builtin_amdgcn_readfirstlane(tid >> 6);
    const int G = gridDim.x, bx = blockIdx.x;
    const int vcu = (G % 8 == 0) ? (bx % 8) * (G / 8) + bx / 8 : bx;
    const int gw = vcu * NWAVES + wave, NGW = G * NWAVES;
    unsigned char* ws = args.ws;
    unsigned* ctl = (unsigned*)(ws + WS_CTL);
    for (int u = tid; u < (LDS_BYTES - RING_BYTES) / 4; u += NTHREADS) ((LAS unsigned*)(lds + RING_BYTES))[u] = 0u;
    __syncthreads();
    XcdBarrier bar; bar.bar = ctl + CW_BAR; bar.x = 0; bar.st = nullptr;
    if (!MK_PER_PHASE) bar = xcd_barrier_post(ctl + CW_BAR, MISC + 8);
#define GRID_BAR() do { if (!MK_PER_PHASE) xcd_barrier(bar); } while (0)
    const int lo = args.ph_lo, hi = args.ph_hi;
#ifndef PHASE_MASK
#define PHASE_MASK 0x7fff
#endif
#define IN(k) (((PHASE_MASK >> (k)) & 1) && lo <= (k) && (k) < hi)
#define BOTH(k) (IN(k) && IN((k) + 1))
    const float* const* in = args.in; float* out = args.out;
    bf16_t* WT_ADA = (bf16_t*)(ws + WS_WADA); bf16_t* A_ADA = (bf16_t*)(ws + WS_AADA); bf16_t* WT_IN = (bf16_t*)(ws + WS_WIN); bf16_t* WT_OAB = (bf16_t*)(ws + WS_WOAB); bf16_t* WT_OUT = (bf16_t*)(ws + WS_WOUT);
    bf16_t* WT_UP = (bf16_t*)(ws + WS_WUP); bf16_t* WT_DOWN = (bf16_t*)(ws + WS_WDOWN); bf16_t* WT_LORA = (bf16_t*)(ws + WS_WLORA); bf16_t* ALORA = (bf16_t*)(ws + WS_ALORA);
    float* MOD = (float*)(ws + WS_MOD); bf16_t* H = (bf16_t*)(ws + WS_H); bf16_t* P = (bf16_t*)(ws + WS_P); float* LWAG = (float*)(ws + WS_LWAG); float* RSCAN = (float*)(ws + WS_RSCAN); float* GSCAN = (float*)(ws + WS_GSCAN);
    float* OA = (float*)(ws + WS_OA); float* OB = (float*)(ws + WS_OB); bf16_t* YAB = (bf16_t*)(ws + WS_YAB); bf16_t* MERGED = (bf16_t*)(ws + WS_MERGED); float* X1 = (float*)(ws + WS_X1); bf16_t* U = (bf16_t*)(ws + WS_U); float* X2 = (float*)(ws + WS_X2);

    if (IN(0)) {
        LAS float* scr = (LAS float*)(lds + wave * 16384);
        constexpr int I0 = (D / 64) * (NMOD / 32), I1 = (D / 64) * (INCOLS / 32), I2 = (RW / 64) * (D / 32), I3 = I2, I4 = (D / 64) * (D / 32), I5 = (D / 64) * (DFF / 32), I6 = (DFF / 64) * (D / 32),
                      I7 = 1 * (RW / 32), I8 = I7, I9 = 4 * (RW / 32), NITEMS = I0 + I1 + I2 + I3 + I4 + I5 + I6 + I7 + I8 + I9;
        for (int it = gw; it < NITEMS; it += NGW) {
            int r = it;
            if (r < I0) { const int nb = NMOD / 32; transpose_item(in[I_WADA], NMOD, 64 * (r / nb), 32 * (r % nb), WT_ADA, 32 * (r % nb), D, 0, scr, lane); continue; } r -= I0;
            if (r < I1) { const int nb = INCOLS / 32; const int n0 = 32 * (r % nb); transpose_item(in[I_WIN], INCOLS, 64 * (r / nb), n0, WT_IN, n0 < 14752 ? n0 : n0 + 96, D, 0, scr, lane); continue; } r -= I1;
            if (r < I2) { const int nb = D / 32; transpose_item(in[I_WOA], D, 64 * (r / nb), 32 * (r % nb), WT_OAB, 32 * (r % nb), D, 0, scr, lane); continue; } r -= I2;
            if (r < I3) { const int nb = D / 32; transpose_item(in[I_WOB], D, 64 * (r / nb), 32 * (r % nb), WT_OAB, 32 * (r % nb), D, RW, scr, lane); continue; } r -= I3;
            if (r < I4) { const int nb = D / 32; transpose_item(in[I_WOUT], D, 64 * (r / nb), 32 * (r % nb), WT_OUT, 32 * (r % nb), D, 0, scr, lane); continue; } r -= I4;
            if (r < I5) { const int nb = DFF / 32; transpose_item(in[I_WUP], DFF, 64 * (r / nb), 32 * (r % nb), WT_UP, 32 * (r % nb), D, 0, scr, lane); continue; } r -= I5;
            if (r < I6) { const int nb = D / 32; transpose_item(in[I_WDOWN], D, 64 * (r / nb), 32 * (r % nb), WT_DOWN, 32 * (r % nb), DFF, 0, scr, lane); continue; } r -= I6;
            if (r < I7) { const int nb = RW / 32; transpose_item(in[I_RWW2], RW, 64 * (r / nb), 32 * (r % nb), WT_LORA, 32 * (r % nb), LORA_K, 0, scr, lane); continue; } r -= I7;
            if (r < I8) { const int nb = RW / 32; transpose_item(in[I_RWA2], RW, 64 * (r / nb), 32 * (r % nb), WT_LORA, 2048 + 32 * (r % nb), LORA_K, 64, scr, lane); continue; } r -= I8;
            { const int nb = RW / 32; transpose_item(in[I_RWG2], RW, 64 * (r / nb), 32 * (r % nb), WT_LORA, 4096 + 32 * (r % nb), LORA_K, 128, scr, lane); }
        }
        for (int i = gw * 64 + lane; i < LORA_N * 48; i += NGW * 64) { const int n = i / 48, ch = i % 48, k = ch * 8, seg = n >> 11;
            const bool diag = seg == 0 ? (k < 64) : seg == 1 ? (k >= 64 && k < 128) : (k >= 128);
            if (!diag) *(u32x4*)(WT_LORA + (size_t)n * LORA_K + k) = (u32x4){0u, 0u, 0u, 0u}; }
        for (int i = gw * 64 + lane; i < 256 * (D / 4); i += NGW * 64) { const int s = i / (D / 4), c4 = (i % (D / 4)) * 4; u32x2 o = (u32x2){0u, 0u};
            if (s < NSEQ) { const f32x4 c = *(const f32x4*)((s < BP ? in[I_CP] + (size_t)s * D : in[I_CS] + (size_t)(s - BP) * D) + c4);
                o.x = pk2(c.x * sigmoidf_(c.x), c.y * sigmoidf_(c.y)); o.y = pk2(c.z * sigmoidf_(c.z), c.w * sigmoidf_(c.w)); }
            *(u32x2*)(A_ADA + (size_t)s * D + c4) = o; }
        if (BOTH(0)) GRID_BAR();
    }
    if (IN(1)) {
        pg8::Gemm g{A_ADA, WT_ADA, D, D}; pg8::TileOrder<1> S; S.init(1, NMOD / 256, G, bx, D / 64);
        pg8::EpiF32Bias E{MOD, NMOD, in[I_BADA]};
        pg8::gemm_phase(lds, g, S, E);
        if (BOTH(1)) GRID_BAR();
    }
    if (IN(2)) {
        norm_rows<0>(in[I_XP], in[I_XS], in[I_N1W], MOD, 0, D, H, nullptr, gw, NGW, lane);
        if (BOTH(2)) GRID_BAR();
    }
    if (IN(3)) {
        pg8::Gemm g{H, WT_IN, D, D}; pg8::TileOrder<1> S; S.init(MTOK / 256, LDP / 256, G, bx, D / 64);
        pg8::EpiBf16<0> E{P, LDP};
        pg8::gemm_phase(lds, g, S, E);
        if (BOTH(3)) GRID_BAR();
    }
    if (IN(4)) {
        const float* mu = in[I_RMU];
        for (int m = gw; m < MTOK; m += NGW) {
            const bool pr = m < NPROMPT; const int ms = m - NPROMPT; const int b = pr ? (m >> 11) : (ms >> 2), t = pr ? (m & 2047) : (ms & 3), T = pr ? TP : TS;
            const bf16_t* cur = P + (size_t)m * LDP;
#pragma unroll
            for (int i = 0; i < 6; ++i) { const int j = lane + 64 * i, col = 6144 + j; const float c = bf2f(cur[col]);
                const float p = t > 0 ? bf2f(cur[col - LDP]) : (pr ? 0.f : in[I_SSHIFT][(size_t)b * RCOLS + col]);
                const float xs = c + (p - c) * mu[col];
                const float val = j < 64 ? tanhf(xs) : j < 128 ? xs : sigmoidf_(xs);
                ALORA[(size_t)m * LORA_K + j] = (bf16_t)f2bf(val); }
            if (t == T - 1) { float* so = out + (pr ? O_PSHIFT : O_SSHIFT) + (size_t)b * RCOLS; for (int col = lane; col < RCOLS; col += 64) so[col] = bf2f(cur[col]); }
            if (t >= T - 3) { float* co = out + (pr ? O_PCONV : O_SCONV) + ((size_t)b * 3 + (t - (T - 3))) * GCONV; for (int col = lane; col < GCONV; col += 64) co[col] = bf2f(cur[PC_G + col]); }
        }
        if (BOTH(4)) GRID_BAR();
    }
    if (IN(5)) {
        pg8::Gemm g{ALORA, WT_LORA, LORA_K, LORA_K}; pg8::TileOrder<1> S; S.init(MTOK / 256, LORA_N / 256, G, bx, LORA_K / 64);
        pg8::EpiLora E{LWAG, in[I_RW0], in[I_RA0]};
        pg8::gemm_phase(lds, g, S, E);
        if (BOTH(5)) GRID_BAR();
    }
    if (IN(6)) {
        const float* mu = in[I_RMU];
        for (int m = gw; m < MTOK; m += NGW) {
            const bool pr = m < NPROMPT; const int ms = m - NPROMPT; const int b = pr ? (m >> 11) : (ms >> 2), t = pr ? (m & 2047) : (ms & 3), T = pr ? TP : TS;
            const bf16_t* cur = P + (size_t)m * LDP; const float* lw = LWAG + (size_t)m * LORA_N;
            for (int h = 0; h < RHEADS; ++h) {
                const int c = h * RH + lane; float x3[3];
#pragma unroll
                for (int q = 0; q < 3; ++q) { const int col = q * RW + c; const float cv = bf2f(cur[col]); const float pv = t > 0 ? bf2f(cur[col - LDP]) : (pr ? 0.f : in[I_SSHIFT][(size_t)b * RCOLS + col]); x3[q] = cv + (pv - cv) * mu[col]; }
                const float r = x3[0], k = x3[1], v = x3[2], wdec = lw[c], a = lw[RW + c];
                const float kr = k * in[I_RKK][c]; const float kk = kr * (1.0f / sqrtf(wave_sum(kr * kr) + 1e-6f));
                const float kp = k * (1.0f + (a - 1.0f) * in[I_RKA][c]);
                float* rec = RSCAN + ((pr ? ((size_t)(b * RHEADS + h) * TP + t) : ((size_t)BP * RHEADS * TP + (size_t)(b * RHEADS + h) * TS + t))) * RREC;
                rec[lane] = wdec; rec[64 + lane] = kk; rec[128 + lane] = kk * a; rec[192 + lane] = kp; rec[256 + lane] = r; rec[320 + lane] = v;
            }
            for (int h = 0; h < GHEADS; ++h) {
                const int c = h * GH + 2 * lane; float y[3][2];
#pragma unroll
                for (int q = 0; q < 3; ++q) { const int colp = q * GW + c; float a0 = 0.f, a1 = 0.f;
#pragma unroll
                    for (int j = 0; j < 4; ++j) { const f32x2 cw = *(const f32x2*)(in[I_CONVW] + (size_t)(3 - j) * GCONV + colp); float x0, x1;
                        if (t - j >= 0) { const unsigned wv = *(const unsigned*)(cur - (size_t)j * LDP + PC_G + colp); x0 = bflo(wv); x1 = bfhi(wv); }
                        else if (pr) { x0 = 0.f; x1 = 0.f; }
                        else { const f32x2 sv = *(const f32x2*)(in[I_SCONV] + ((size_t)b * 3 + (3 + t - j)) * GCONV + colp); x0 = sv.x; x1 = sv.y; }
                        a0 += cw.x * x0; a1 += cw.y * x1; }
                    y[q][0] = a0 * sigmoidf_(a0); y[q][1] = a1 * sigmoidf_(a1); }
                const float qn = 1.0f / sqrtf(wave_sum(y[0][0] * y[0][0] + y[0][1] * y[0][1]) + 1e-6f) * 0.08838834764831845f;
                const float kn = 1.0f / sqrtf(wave_sum(y[1][0] * y[1][0] + y[1][1] * y[1][1]) + 1e-6f);
                const float q0 = y[0][0] * qn, q1 = y[0][1] * qn, k0 = y[1][0] * kn, k1 = y[1][1] * kn;
                const float qk = wave_sum(q0 * k0 + q1 * k1);
                const float beta = sigmoidf_(bf2f(cur[PC_BETA + h]));
                const float alpha = __expf(-__expf(in[I_ALOG][h]) * softplusf_(bf2f(cur[PC_ALPHA + h]) + in[I_DTB][h]));
                float* rec = GSCAN + ((pr ? ((size_t)(b * GHEADS + h) * TP + t) : ((size_t)BP * GHEADS * TP + (size_t)(b * GHEADS + h) * TS + t))) * GREC;
                *(f32x2*)(rec + 2 * lane) = (f32x2){q0, q1}; *(f32x2*)(rec + 128 + 2 * lane) = (f32x2){k0, k1}; *(f32x2*)(rec + 256 + 2 * lane) = (f32x2){y[2][0], y[2][1]};
                if (lane < 16) rec[384 + lane] = lane == 0 ? alpha : lane == 1 ? beta : lane == 2 ? qk : 0.f;
            }
        }
        if (BOTH(6)) GRID_BAR();
    }
    if (IN(7)) {
        for (int it = bx; it < BP * RHEADS * 2; it += G) rwkv_prompt_item(lds, RSCAN, OA, out + O_PWKV, it, wave, lane);
        for (int it = bx; it < BP * GHEADS * 4; it += G) gdn_prompt_item(lds, GSCAN, OB, out + O_PGDN, it, wave, lane);
        for (int it = gw; it < BS * RHEADS * 4; it += NGW) rwkv_sample_item(RSCAN, in[I_SWKV], OA, out + O_SWKV, it, lane);
        { LAS float* scr = (LAS float*)(lds + wave * 8192);
          for (int it = gw; it < BS * GHEADS * 4; it += NGW) gdn_sample_item(scr, GSCAN, in[I_SGDN], OB, out + O_SGDN, it, lane); }
        if (BOTH(7)) GRID_BAR();
    }
    if (IN(8)) {
        for (int m = gw; m < MTOK; m += NGW) {
            const bool pr = m < NPROMPT; const int ms = m - NPROMPT; const int b = pr ? (m >> 11) : (ms >> 2), t = pr ? (m & 2047) : (ms & 3);
            for (int h = 0; h < RHEADS; ++h) { const int c = h * RH + lane;
                const float o = OA[(size_t)m * RW + c]; const float mean = wave_sum(o) * (1.0f / 64.0f); const float d = o - mean; const float var = wave_sum(d * d) * (1.0f / 64.0f);
                float on = d * (1.0f / sqrtf(var + 64e-5f)) * in[I_LNXW][c] + in[I_LNXB][c];
                const float* rec = RSCAN + ((pr ? ((size_t)(b * RHEADS + h) * TP + t) : ((size_t)BP * RHEADS * TP + (size_t)(b * RHEADS + h) * TS + t))) * RREC;
                const float bonus = wave_sum(rec[256 + lane] * rec[192 + lane] * in[I_RRK][c]);
                on = (on + bonus * rec[320 + lane]) * LWAG[(size_t)m * LORA_N + 2 * RW + c];
                YAB[(size_t)m * D + c] = (bf16_t)f2bf(on); }
            for (int h = 0; h < GHEADS; ++h) { const int c = h * GH + 2 * lane;
                const f32x2 o = *(const f32x2*)(OB + (size_t)m * GW + c); const float rs = 1.0f / sqrtf(wave_sum(o.x * o.x + o.y * o.y) * (1.0f / 128.0f) + 1e-6f);
                const f32x2 nw = *(const f32x2*)(in[I_GNW] + 2 * lane); const unsigned zw = *(const unsigned*)(P + (size_t)m * LDP + PC_Z + c); const float z0 = bflo(zw), z1 = bfhi(zw);
                *(unsigned*)(YAB + (size_t)m * D + RW + c) = pk2(o.x * rs * nw.x * z0 * sigmoidf_(z0), o.y * rs * nw.y * z1 * sigmoidf_(z1)); }
        }
        if (BOTH(8)) GRID_BAR();
    }
    if (IN(9)) {
        pg8::Gemm g{YAB, WT_OAB, D, D}; pg8::TileOrder<2> S; S.init(MTOK / 256, D / 256, G, bx, RW / 64);
        pg8::EpiMerge E{MERGED, P, (float*)(ws + WS_RSCAN)};
        pg8::gemm_phase(lds, g, S, E);
        if (BOTH(9)) GRID_BAR();
    }
    if (IN(10)) {
        pg8::Gemm g{MERGED, WT_OUT, D, D}; pg8::TileOrder<1> S; S.init(MTOK / 256, D / 256, G, bx, D / 64);
        pg8::EpiResGate E{in[I_XP], in[I_XS], MOD + 2 * D, X1};
        pg8::gemm_phase(lds, g, S, E);
        if (BOTH(10)) GRID_BAR();
    }
    if (IN(11)) {
        norm_rows<0>(X1, X1 + (size_t)NPROMPT * D, in[I_N2W], MOD, 3 * D, 4 * D, H, nullptr, gw, NGW, lane);
        if (BOTH(11)) GRID_BAR();
    }
    if (IN(12)) {
        pg8::Gemm g{H, WT_UP, D, D}; pg8::TileOrder<1> S; S.init(MTOK / 256, DFF / 256, G, bx, D / 64);
        pg8::EpiBf16<1> E{U, DFF};
        pg8::gemm_phase(lds, g, S, E);
        if (BOTH(12)) GRID_BAR();
    }
    if (IN(13)) {
        pg8::Gemm g{U, WT_DOWN, DFF, DFF}; pg8::TileOrder<1> S; S.init(MTOK / 256, D / 256, G, bx, DFF / 64);
        pg8::EpiResGate E{X1, X1 + (size_t)NPROMPT * D, MOD + 5 * D, X2};
        pg8::gemm_phase(lds, g, S, E);
        if (BOTH(13)) GRID_BAR();
    }
    if (IN(14)) {
        norm_rows<1>(X2, X2 + (size_t)NPROMPT * D, in[I_FNW], nullptr, 0, 0, nullptr, out + O_Y, gw, NGW, lane);
    }
#undef IN
#undef BOTH
#undef GRID_BAR
}

extern "C" void kernel_launch(void* const* d_in, const int* in_sizes, int n_in, void* d_out, int out_size, void* d_ws, size_t ws_size, hipStream_t stream) {
    static int grid = 0;
    if (grid == 0) {
        if (n_in != 34 || (size_t)out_size != O_END || ws_size < WS_END) { fprintf(stderr, "kernel_launch: unexpected problem: n_in %d out %d ws %zu (need %zu)\n", n_in, out_size, ws_size, (size_t)WS_END); grid = -1; return; }
        int dev = 0, cus = 0, per_cu = 0;
        if (hipGetDevice(&dev) != hipSuccess || hipDeviceGetAttribute(&cus, hipDeviceAttributeMultiprocessorCount, dev) != hipSuccess) { grid = -1; return; }
        if (hipFuncSetAttribute((const void*)fwd_kernel, hipFuncAttributeMaxDynamicSharedMemorySize, LDS_BYTES) != hipSuccess) { fprintf(stderr, "kernel_launch: hipFuncSetAttribute failed\n"); grid = -1; return; }
        if (hipOccupancyMaxActiveBlocksPerMultiprocessor(&per_cu, (const void*)fwd_kernel, NTHREADS, LDS_BYTES) != hipSuccess || per_cu < 1) fprintf(stderr, "kernel_launch: occupancy query says %d\n", per_cu);
        (void)hipGetLastError();
        grid = cus;
    }
    if (grid < 0) return;
    if (hipMemsetAsync((char*)d_ws + WS_CTL, 0, CTL_ZERO_BYTES, stream) != hipSuccess) return;
    Args a{};
    for (int i = 0; i < 34; ++i) a.in[i] = (const float*)d_in[i];
    a.out = (float*)d_out; a.ws = (unsigned char*)d_ws;
#if MK_PER_PHASE
    for (int p = 0; p < NPHASE; ++p) { a.ph_lo = p; a.ph_hi = p + 1; hipLaunchKernelGGL(fwd_kernel, dim3(grid), dim3(NTHREADS), LDS_BYTES, stream, a); }
#else
    a.ph_lo = 0; a.ph_hi = NPHASE; hipLaunchKernelGGL(fwd_kernel, dim3(grid), dim3(NTHREADS), LDS_BYTES, stream, a);
#endif
    const hipError_t le = hipPeekAtLastError();
    if (le != hipSuccess) fprintf(stderr, "kernel_launch: launch failed: %s\n", hipGetErrorName(le));
}
```

```cpp
#include <hip/hip_runtime.h>
#include <cstdio>
#include <cstdint>

#ifndef MK_PER_PHASE
#define MK_PER_PHASE 0
#endif

#define GAS __attribute__((address_space(1)))
#define LAS __attribute__((address_space(3)))
typedef unsigned short bf16_t;
typedef short bf16x8 __attribute__((ext_vector_type(8)));
typedef float f32x4 __attribute__((ext_vector_type(4)));
typedef float f32x2 __attribute__((ext_vector_type(2)));
typedef unsigned u32x4 __attribute__((ext_vector_type(4)));
typedef unsigned u32x2 __attribute__((ext_vector_type(2)));

constexpr int D = 4096, NPROMPT = 8192, NSAMP = 512, MTOK = NPROMPT + NSAMP;
constexpr int TP = 2048, TS = 4, BP = 4, BS = 128, NSEQ = BP + BS;
constexpr int RW = 2048, RH = 64, RHEADS = 32, RCOLS = 6528;
constexpr int GW = 2048, GH = 128, GHEADS = 16, GCONV = 6144;
constexpr int INCOLS = 22944, LDP = 23040;
constexpr int PC_G = 6528, PC_Z = 6528 + 6144, PC_BETA = 14720, PC_ALPHA = 14736, PC_GA = 14848, PC_GB = 14848 + 4096;
constexpr int DFF = 16384, NMOD = 6 * D;
constexpr int LORA_K = 384, LORA_N = 6144;
constexpr int RREC = 384, GREC = 400, GRB = 784;
constexpr size_t O_Y = 0, O_PWKV = 35651584, O_PSHIFT = 36175872, O_PGDN = 36201984, O_PCONV = 37250560, O_SWKV = 37324288, O_SSHIFT = 54101504, O_SGDN = 54937088, O_SCONV = 88491520, O_END = 90850816;

constexpr size_t MiB = 1u << 20;
constexpr size_t WS_CTL = 0, CTL_ZERO_BYTES = 1 * MiB;
constexpr size_t WS_WOAB = 2 * MiB, WS_WOUT = 34 * MiB, WS_WUP = 66 * MiB, WS_WDOWN = 194 * MiB, WS_MOD = 322 * MiB, WS_WLORA = 346 * MiB, WS_ALORA = 351 * MiB;
constexpr size_t WS_H = 358 * MiB, WS_P = 426 * MiB, WS_X = 809 * MiB;
constexpr size_t WS_WADA = WS_X, WS_AADA = WS_X + 192 * MiB, WS_WIN = WS_X + 194 * MiB;
constexpr size_t WS_LWAG = WS_X, WS_RSCAN = WS_X + 204 * MiB, WS_GSCAN = WS_X + 612 * MiB, WS_OA = WS_X + 825 * MiB, WS_OB = WS_H;
constexpr size_t WS_BON = WS_X + 893 * MiB;
constexpr size_t WS_YAB = WS_GSCAN, WS_MERGED = WS_GSCAN + 68 * MiB, WS_X1 = WS_X, WS_U = WS_RSCAN, WS_X2 = WS_RSCAN + 272 * MiB;
constexpr size_t WS_END = 1728 * MiB;
static_assert(WS_OA + (size_t)MTOK * 2048 * 4 <= WS_END && WS_GSCAN + (size_t)MTOK * 16 * GREC * 4 <= WS_OA && WS_RSCAN + (size_t)MTOK * 32 * RREC * 4 <= WS_GSCAN && WS_LWAG + (size_t)MTOK * LORA_N * 4 <= WS_RSCAN, "ws map A");
static_assert(WS_WIN + (size_t)LDP * D * 2 <= WS_END && WS_P + (size_t)MTOK * LDP * 2 <= WS_X && WS_H + (size_t)MTOK * D * 2 <= WS_P && WS_X2 + (size_t)MTOK * D * 4 <= WS_GSCAN && WS_U + (size_t)MTOK * DFF * 2 <= WS_X2, "ws map B");

constexpr int RING_BYTES = 131072, MISC_OFF = RING_BYTES + 320, LDS_BYTES = 147456;
constexpr int NWAVES = 8, NTHREADS = 512;

__device__ __forceinline__ unsigned f2bf(float f) { unsigned u = __builtin_bit_cast(unsigned, f); return (u + 0x7fffu + ((u >> 16) & 1u)) >> 16; }
__device__ __forceinline__ float bf2f(unsigned short b) { return __builtin_bit_cast(float, ((unsigned)b) << 16); }
__device__ __forceinline__ unsigned pk2(float lo, float hi) { return f2bf(lo) | (f2bf(hi) << 16); }
__device__ __forceinline__ float bflo(unsigned w) { return __builtin_bit_cast(float, w << 16); }
__device__ __forceinline__ float bfhi(unsigned w) { return __builtin_bit_cast(float, w & 0xffff0000u); }
__device__ __forceinline__ unsigned cvt2(float lo, float hi);
__device__ __forceinline__ f32x4 cvt4(u32x2 w) { return (f32x4){bflo(w.x), bfhi(w.x), bflo(w.y), bfhi(w.y)}; }
__device__ __forceinline__ float wave_sum(float v) {
#pragma unroll
    for (int o = 1; o < 64; o <<= 1) v += __shfl_xor(v, o);
    return v;
}
template <int CTRL> __device__ __forceinline__ float dppf(float x) { return __builtin_bit_cast(float, __builtin_amdgcn_mov_dpp(__builtin_bit_cast(int, x), CTRL, 0xf, 0xf, true)); }
__device__ __forceinline__ float row16_sum(float x) { x += dppf<0x128>(x); x += dppf<0x124>(x); x += dppf<0x122>(x); x += dppf<0x121>(x); return x; }
__device__ __forceinline__ float sigmoidf_(float x) { return 1.0f / (1.0f + __expf(-x)); }
__device__ __forceinline__ float fsig(float x) { return __builtin_amdgcn_rcpf(1.0f + __builtin_amdgcn_exp2f(x * -1.4426950408889634f)); }
__device__ __forceinline__ float softplusf_(float y) { return fmaxf(y, 0.f) + log1pf(__expf(-fabsf(y))); }
__device__ __forceinline__ int seq_of_row(int m) { return m < NPROMPT ? (m >> 11) : 4 + ((m - NPROMPT) >> 2); }

namespace pg8 {
constexpr int BM = 256, BK = 64, HALF = 128, HTB = HALF * BK * 2, STAGE_BYTES = 8 * HTB, NXCD = 8, WGM = 8;
__host__ __device__ __forceinline__ int lds_byte(int r, int c) { const int st = r >> 3, rr = r & 7, ch = c >> 3; return st * 1024 + rr * 128 + ((ch ^ ((rr >> 1) << 1)) << 4) + (c & 7) * 2; }
__host__ __device__ __forceinline__ void stage_rc(int b, int& R, int& C) { const int st = b / 1024, sb = b % 1024, rr = sb / 128, chs = (sb % 128) / 16, ch = chs ^ ((rr >> 1) << 1); R = st * 8 + rr; C = ch * 8 + (sb % 16) / 2; }
__host__ __device__ __forceinline__ int perm32(int rho) { const int n = rho >> 4, i = rho & 15; return 8 * (i >> 2) + 4 * n + (i & 3); }

struct Unit { int pm, pn, koff, nt, fin; };
struct Gemm { const bf16_t* A; const bf16_t* Bt; int lda, ldb; };

__device__ __forceinline__ void tile_of(int L, int nM, int nN, int& pm, int& pn) {
    const int nwg = nM * nN; int wgid = L; { const int q = nwg / NXCD, r = nwg % NXCD, xcd = wgid % NXCD, off = wgid / NXCD; wgid = (xcd < r ? xcd * (q + 1) : r * (q + 1) + (xcd - r) * q) + off; }
    const int nig = WGM * nN, gid = wgid / nig, fm = gid * WGM, gsz = (nM - fm) < WGM ? (nM - fm) : WGM;
    pm = fm + ((wgid % nig) % gsz); pn = (wgid % nig) / gsz;
}
template <int SPLIT> struct TileOrder {
    int nM, nN, lim, G, c, nt; bool chain = false;
    __device__ void init(int nM_, int nN_, int G_, int c_, int nt_, int lim_ = 0) { nM = nM_; nN = nN_; lim = lim_ ? lim_ : nM * nN; G = G_; c = c_; nt = nt_; }
    __device__ bool next(int i, Unit& u) const {
        const int ti = i / SPLIT, hf = i % SPLIT;
        const long L = (long)ti * G + c; if (L >= lim) return false;
        tile_of((int)L, nM, nN, u.pm, u.pn); u.nt = nt; u.koff = hf * nt * BK * 2; u.fin = chain ? (hf == SPLIT - 1) : 1; return true;
    }
};
struct OneUnit { Unit u; __device__ bool next(int i, Unit& o) const { if (i) return false; o = u; return true; } };

__device__ __forceinline__ unsigned cvt_pk_bf16(float lo, float hi) { unsigned r; asm volatile("v_cvt_pk_bf16_f32 %0, %1, %2" : "=v"(r) : "v"(lo), "v"(hi)); return r; }

#define ACC_T f32x4 (&acc)[2][2][4][2]
#define FOR_AIM _Pragma("unroll") for (int ai = 0; ai < 2; ++ai) _Pragma("unroll") for (int m = 0; m < 4; ++m)
#define FOR_BJN _Pragma("unroll") for (int bj = 0; bj < 2; ++bj) _Pragma("unroll") for (int n = 0; n < 2; ++n)

struct EpiF32Bias {
    static constexpr bool PERM = false, HAS_MID = false;
    float* C; int ldc; const float* bias;
    __device__ __forceinline__ void mid(ACC_T, const Unit&, int, int, int, int) const {}
    __device__ __forceinline__ void operator()(ACC_T, const Unit& u, int wr, int wc, int fr, int fq) const {
        const int row0 = u.pm * BM + wr * 64 + fr, col0 = u.pn * BM + wc * 32 + 4 * fq;
        f32x4 bv[2][2];
        FOR_BJN bv[bj][n] = *(const f32x4*)(bias + col0 + bj * HALF + n * 16);
        FOR_AIM { float* rowp = C + (size_t)(row0 + ai * HALF + m * 16) * ldc + col0;
            FOR_BJN *(f32x4*)(rowp + bj * HALF + n * 16) = acc[ai][bj][m][n] + bv[bj][n]; }
    }
};
__device__ __forceinline__ float gate_em(float x) { return __builtin_amdgcn_exp2f(fminf(x * -1.4426950408889634f, 115.f)); }
template <int ACT  > struct EpiBf16 {
    static constexpr bool PERM = true, HAS_MID = false;
    bf16_t* O; int ldc; int gate_pn0 = 1 << 30;
    __device__ __forceinline__ void mid(ACC_T, const Unit&, int, int, int, int) const {}
    __device__ __forceinline__ void operator()(ACC_T, const Unit& u, int wr, int wc, int fr, int fq) const {
        const int row0 = u.pm * BM + wr * 64 + fr, col0 = u.pn * BM + wc * 32 + 8 * fq;
        if (ACT == 0 && u.pn >= gate_pn0) {
            FOR_AIM { bf16_t* rowp = O + (size_t)(row0 + ai * HALF + m * 16) * ldc + col0; float rr[8], ss[8];
#pragma unroll
                for (int e = 0; e < 8; ++e) { const float eb = 1.0f + gate_em(acc[ai][1][m][e >> 2][e & 3]), ea = 1.0f + gate_em(acc[ai][0][m][e >> 2][e & 3]); ss[e] = __builtin_amdgcn_rcpf(eb); rr[e] = eb * __builtin_amdgcn_rcpf(ea); }
                u32x4 w; w.x = cvt_pk_bf16(rr[0], rr[1]); w.y = cvt_pk_bf16(rr[2], rr[3]); w.z = cvt_pk_bf16(rr[4], rr[5]); w.w = cvt_pk_bf16(rr[6], rr[7]); *(u32x4*)(rowp) = w;
                w.x = cvt_pk_bf16(ss[0], ss[1]); w.y = cvt_pk_bf16(ss[2], ss[3]); w.z = cvt_pk_bf16(ss[4], ss[5]); w.w = cvt_pk_bf16(ss[6], ss[7]); *(u32x4*)(rowp + HALF) = w; }
            return; }
        FOR_AIM { bf16_t* rowp = O + (size_t)(row0 + ai * HALF + m * 16) * ldc + col0;
#pragma unroll
            for (int bj = 0; bj < 2; ++bj) { f32x4 v0 = acc[ai][bj][m][0], v1 = acc[ai][bj][m][1];
                if (ACT == 1) {
#pragma unroll
                    for (int j = 0; j < 4; ++j) { const float a = fmaxf(v0[j], 0.f), b = fmaxf(v1[j], 0.f); v0[j] = a * a; v1[j] = b * b; } }
                u32x4 w; w.x = cvt_pk_bf16(v0[0], v0[1]); w.y = cvt_pk_bf16(v0[2], v0[3]); w.z = cvt_pk_bf16(v1[0], v1[1]); w.w = cvt_pk_bf16(v1[2], v1[3]);
                *(u32x4*)(rowp + bj * HALF) = w; } }
    }
};
struct EpiLora {
    static constexpr bool PERM = true, HAS_MID = false;
    bf16_t* C; const float* w0; const float* a0;
    __device__ __forceinline__ void mid(ACC_T, const Unit&, int, int, int, int) const {}
    __device__ __forceinline__ void operator()(ACC_T, const Unit& u, int wr, int wc, int fr, int fq) const {
        const int row0 = u.pm * BM + wr * 64 + fr, col0 = u.pn * BM + wc * 32 + 8 * fq, seg = u.pn >> 3, cs0 = col0 - seg * 2048;
        f32x4 bv[2][2];
        FOR_BJN bv[bj][n] = seg == 0 ? *(const f32x4*)(w0 + cs0 + bj * HALF + n * 4) : seg == 1 ? *(const f32x4*)(a0 + cs0 + bj * HALF + n * 4) : (f32x4){0.f, 0.f, 0.f, 0.f};
        FOR_AIM { bf16_t* rowp = C + (size_t)(row0 + ai * HALF + m * 16) * LORA_N + col0;
#pragma unroll
            for (int bj = 0; bj < 2; ++bj) { f32x4 vv[2];
#pragma unroll
                for (int n = 0; n < 2; ++n) { f32x4 v = acc[ai][bj][m][n] + bv[bj][n];
                    if (seg == 0) {
#pragma unroll
                        for (int j = 0; j < 4; ++j) { const float y = -v[j]; const float sp = fmaxf(y, 0.f) + 0.6931471805599453f * __builtin_amdgcn_logf(1.0f + __builtin_amdgcn_exp2f(-1.4426950408889634f * fabsf(y)));
                            v[j] = -__builtin_amdgcn_exp2f(1.4426950408889634f * (-sp - 0.5f)); } }
                    else if (seg == 1) {
#pragma unroll
                        for (int j = 0; j < 4; ++j) v[j] = fsig(v[j]); }
                    vv[n] = v; }
                u32x4 w; w.x = cvt_pk_bf16(vv[0][0], vv[0][1]); w.y = cvt_pk_bf16(vv[0][2], vv[0][3]); w.z = cvt_pk_bf16(vv[1][0], vv[1][1]); w.w = cvt_pk_bf16(vv[1][2], vv[1][3]);
                *(u32x4*)(rowp + bj * HALF) = w; } }
    }
};
struct EpiMerge {
    static constexpr bool PERM = true, HAS_MID = false;
    bf16_t* O; const bf16_t* P; float* T;
    __device__ __forceinline__ void mid(ACC_T, const Unit&, int, int, int, int) const {}
    __device__ __forceinline__ void operator()(ACC_T, const Unit& u, int wr, int wc, int fr, int fq) const {
        const int row0 = u.pm * BM + wr * 64 + fr, col0 = u.pn * BM + wc * 32 + 8 * fq; const bool second = u.koff != 0;
        FOR_AIM { const int row = row0 + ai * HALF + m * 16; bf16_t* rowp = O + (size_t)row * D + col0; float* trow = T + (size_t)row * D + col0; const bf16_t* grow = P + (size_t)row * LDP + (second ? PC_GB : PC_GA) + col0;
#pragma unroll
            for (int bj = 0; bj < 2; ++bj) { const u32x4 gw = *(const u32x4*)(grow + bj * HALF);
                f32x4 v0 = acc[ai][bj][m][0], v1 = acc[ai][bj][m][1];
                v0[0] *= fsig(bflo(gw.x)); v0[1] *= fsig(bfhi(gw.x)); v0[2] *= fsig(bflo(gw.y)); v0[3] *= fsig(bfhi(gw.y));
                v1[0] *= fsig(bflo(gw.z)); v1[1] *= fsig(bfhi(gw.z)); v1[2] *= fsig(bflo(gw.w)); v1[3] *= fsig(bfhi(gw.w));
                if (!second) { *(f32x4*)(trow + bj * HALF) = v0; *(f32x4*)(trow + bj * HALF + 4) = v1; }
                else { v0 += *(const f32x4*)(trow + bj * HALF); v1 += *(const f32x4*)(trow + bj * HALF + 4);
                    u32x4 w; w.x = cvt_pk_bf16(v0[0], v0[1]); w.y = cvt_pk_bf16(v0[2], v0[3]); w.z = cvt_pk_bf16(v1[0], v1[1]); w.w = cvt_pk_bf16(v1[2], v1[3]);
                    *(u32x4*)(rowp + bj * HALF) = w; } }
            asm volatile("" ::: "memory"); }
    }
};
struct EpiMergeChain {
    static constexpr bool PERM = true, HAS_MID = false, CHAIN = true;
    bf16_t* O; const bf16_t* P;
    __device__ __forceinline__ static float em(float x) { return __builtin_amdgcn_exp2f(fminf(x * -1.4426950408889634f, 115.f)); }
    __device__ __forceinline__ void mid(ACC_T, const Unit&, int, int, int, int) const {}
    __device__ __forceinline__ void operator()(ACC_T, const Unit&, int, int, int, int) const {}
    __device__ __forceinline__ void chain(ACC_T, const Unit& u, int wr, int wc, int fr, int fq) const {
        const int row0 = u.pm * BM + wr * 64 + fr, col0 = u.pn * BM + wc * 32 + 8 * fq; const bool fin = u.fin != 0; const float keep = fin ? 0.f : 1.f;
#pragma unroll
        for (int ai = 0; ai < 2; ++ai) {
            int rb = row0; asm volatile("" : "+v"(rb));
            u32x4 gq[4][2];
#pragma unroll
            for (int m = 0; m < 4; ++m) { const bf16_t* grow = P + (size_t)(rb + ai * HALF + m * 16) * LDP + PC_GA + (2 * u.pn) * 256 + (fin ? HALF : 0) + wc * 32 + 8 * fq;
#pragma unroll
                for (int bj = 0; bj < 2; ++bj) gq[m][bj] = *(const u32x4*)(grow + bj * 256); }
            __builtin_amdgcn_sched_barrier(0);
#pragma unroll
            for (int m = 0; m < 4; ++m) { bf16_t* rowp = O + (size_t)(rb + ai * HALF + m * 16) * D + col0;
#pragma unroll
                for (int bj = 0; bj < 2; ++bj) { const u32x4 g = gq[m][bj];
                    const float gv[8] = {bflo(g.x), bfhi(g.x), bflo(g.y), bfhi(g.y), bflo(g.z), bfhi(g.z), bflo(g.w), bfhi(g.w)};
                    float v[8];
#pragma unroll
                    for (int e = 0; e < 8; ++e) v[e] = acc[ai][bj][m][e >> 2][e & 3] * gv[e];
                    if (fin) { u32x4 w; w.x = cvt_pk_bf16(v[0], v[1]); w.y = cvt_pk_bf16(v[2], v[3]); w.z = cvt_pk_bf16(v[4], v[5]); w.w = cvt_pk_bf16(v[6], v[7]); *(u32x4*)(rowp + bj * HALF) = w; }
#pragma unroll
                    for (int e = 0; e < 8; ++e) acc[ai][bj][m][e >> 2][e & 3] = v[e] * keep;
                    asm volatile("" : "+v"(acc[ai][bj][m][0]), "+v"(acc[ai][bj][m][1])); } }
            asm volatile("" ::: "memory"); }
    }
};
template <bool BASE_BF16> struct EpiResGate {
    static constexpr bool PERM = true, HAS_MID = false;
    const float* bp; const float* bs; const float* gate; bf16_t* out;
    __device__ __forceinline__ void mid(ACC_T, const Unit&, int, int, int, int) const {}
    __device__ __forceinline__ void operator()(ACC_T, const Unit& u, int wr, int wc, int fr, int fq) const {
        const int row0 = u.pm * BM + wr * 64 + fr, col0 = u.pn * BM + wc * 32 + 8 * fq;
        FOR_AIM { const int row = row0 + ai * HALF + m * 16; const int s = seq_of_row(row);
            const float* grow = gate + (size_t)s * NMOD + col0; bf16_t* orow = out + (size_t)row * D + col0;
#pragma unroll
            for (int bj = 0; bj < 2; ++bj) { f32x4 b0, b1;
                if (BASE_BF16) { const u32x4 bw = *(const u32x4*)((const bf16_t*)bp + (size_t)row * D + col0 + bj * HALF);
                    b0 = (f32x4){bflo(bw.x), bfhi(bw.x), bflo(bw.y), bfhi(bw.y)}; b1 = (f32x4){bflo(bw.z), bfhi(bw.z), bflo(bw.w), bfhi(bw.w)}; }
                else { const float* brow = (row < NPROMPT ? bp + (size_t)row * D : bs + (size_t)(row - NPROMPT) * D) + col0 + bj * HALF; b0 = *(const f32x4*)brow; b1 = *(const f32x4*)(brow + 4); }
                const f32x4 v0 = b0 + *(const f32x4*)(grow + bj * HALF) * acc[ai][bj][m][0], v1 = b1 + *(const f32x4*)(grow + bj * HALF + 4) * acc[ai][bj][m][1];
                u32x4 w; w.x = cvt_pk_bf16(v0[0], v0[1]); w.y = cvt_pk_bf16(v0[2], v0[3]); w.z = cvt_pk_bf16(v1[0], v1[1]); w.w = cvt_pk_bf16(v1[2], v1[3]);
                *(u32x4*)(orow + bj * HALF) = w; } }
    }
};

template <class T, class = void> struct epi_chain { static constexpr bool value = false; };
template <class T> struct epi_chain<T, decltype((void)T::CHAIN)> { static constexpr bool value = T::CHAIN; };
template <class Epi, class Sched>
__device__ __forceinline__ void gemm_phase(LAS unsigned char* lds, const Gemm g, const Sched& S, const Epi& E) {
    const int tid = threadIdx.x, wid = __builtin_amdgcn_readfirstlane(tid >> 6), lane = tid & 63, wr = wid >> 2, wc = wid & 3, fr = lane & 15, fq = lane >> 4;
    unsigned voffA[2], voffB[2];
#pragma unroll
    for (int i = 0; i < 2; ++i) { int R, C; stage_rc(tid * 16 + i * 8192, R, C); const int Rb = Epi::PERM ? ((R & ~31) + perm32(R & 31)) : R;
        voffA[i] = (unsigned)(R * g.lda + C) * 2u; voffB[i] = (unsigned)(Rb * g.ldb + C) * 2u; }
    const size_t kstep = (size_t)(BK * 2);
    const size_t hstepA = (size_t)HALF * g.lda * 2, hstepB = (size_t)HALF * g.ldb * 2, tstepA = 2 * hstepA, tstepB = 2 * hstepB;
    const unsigned ldsw = (unsigned)wid * 1024u;
    const int aoff0 = lds_byte(wr * 64 + fr, fq * 8), aoff1 = lds_byte(wr * 64 + fr, 32 + fq * 8), boff0 = lds_byte(wc * 32 + fr, fq * 8), boff1 = lds_byte(wc * 32 + fr, 32 + fq * 8);
#define PG8_SA(b, h) (((b) * 2 + (h)) * HTB)
#define PG8_SB(b, h) ((4 + (b) * 2 + (h)) * HTB)
#define PG8_STAGE(bufoff, gbase, voff) do { _Pragma("unroll") for (int _i = 0; _i < 2; ++_i) \
        __builtin_amdgcn_global_load_lds((const unsigned*)((const char*)(gbase) + (voff)[_i]), (LAS unsigned*)(lds + (bufoff) + ldsw + _i * 8192), 16, 0, 0); } while (0)
#define PG8_LDA(dst, b, h) do { _Pragma("unroll") for (int m = 0; m < 4; ++m) _Pragma("unroll") for (int k = 0; k < 2; ++k) dst[m][k] = *(const LAS bf16x8*)(lds + PG8_SA(b, h) + (k ? aoff1 : aoff0) + m * 2048); } while (0)
#define PG8_LDB(dst, b, h) do { _Pragma("unroll") for (int n = 0; n < 2; ++n) _Pragma("unroll") for (int k = 0; k < 2; ++k) dst[n][k] = *(const LAS bf16x8*)(lds + PG8_SB(b, h) + (k ? boff1 : boff0) + n * 2048); } while (0)
#define PG8_MMA(ai, bj, At, Bt) do { __builtin_amdgcn_s_setprio(1); _Pragma("unroll") for (int m = 0; m < 4; ++m) _Pragma("unroll") for (int n = 0; n < 2; ++n) _Pragma("unroll") for (int k = 0; k < 2; ++k) \
        acc[ai][bj][m][n] = __builtin_amdgcn_mfma_f32_16x16x32_bf16(Bt[n][k], At[m][k], acc[ai][bj][m][n], 0, 0, 0); __builtin_amdgcn_s_setprio(0); } while (0)
#define PG8_WAIT_V(n) asm volatile("s_waitcnt vmcnt(" #n ")" ::: "memory")
#define PG8_WAIT_L(n) asm volatile("s_waitcnt lgkmcnt(" #n ")" ::: "memory")
#define PG8_BAR __builtin_amdgcn_s_barrier()
#define PG8_SCHED __builtin_amdgcn_sched_barrier(0)
    Unit cur, nxt; int ui = 0;
    if (!S.next(0, cur)) return;
    f32x4 acc[2][2][4][2];
#pragma unroll
    for (int a = 0; a < 2; ++a)
#pragma unroll
        for (int b = 0; b < 2; ++b)
#pragma unroll
            for (int m = 0; m < 4; ++m)
#pragma unroll
                for (int n = 0; n < 2; ++n) acc[a][b][m][n] = (f32x4){0.f, 0.f, 0.f, 0.f};
    bf16x8 At[4][2], B0[2][2], B1[2][2];
    const char* cA = (const char*)g.A + (size_t)cur.pm * tstepA + cur.koff; const char* cB = (const char*)g.Bt + (size_t)cur.pn * tstepB + cur.koff;
    PG8_STAGE(PG8_SB(0, 0), cB, voffB); PG8_STAGE(PG8_SB(0, 1), cB + hstepB, voffB); PG8_STAGE(PG8_SA(0, 0), cA, voffA); PG8_STAGE(PG8_SA(0, 1), cA + hstepA, voffA);
    if (wr == 1) PG8_BAR;
    PG8_WAIT_V(2); PG8_BAR;
    PG8_STAGE(PG8_SB(1, 0), cB + kstep, voffB); PG8_STAGE(PG8_SA(1, 0), cA + kstep, voffA); PG8_STAGE(PG8_SB(1, 1), cB + hstepB + kstep, voffB);
    PG8_WAIT_V(6); PG8_BAR;
    for (;;) {
        const bool has_next = S.next(ui + 1, nxt);
        const char* nA = has_next ? (const char*)g.A + (size_t)nxt.pm * tstepA + nxt.koff : cA; const char* nB = has_next ? (const char*)g.Bt + (size_t)nxt.pn * tstepB + nxt.koff : cB;
        const int nt = cur.nt;
        for (int t = 0; t < nt; t += 2) {
            const bool last = (t == nt - 2);
            const char* a1 = cA + (size_t)(t + 1) * kstep;
            const char* a2 = last ? nA : cA + (size_t)(t + 2) * kstep; const char* b2 = last ? nB : cB + (size_t)(t + 2) * kstep;
            const char* a3 = a2 + kstep; const char* b3 = b2 + kstep;
            PG8_LDB(B0, 0, 0); PG8_LDB(B1, 0, 1); PG8_SCHED; PG8_LDA(At, 0, 0); PG8_STAGE(PG8_SA(1, 1), a1 + hstepA, voffA);
            PG8_WAIT_V(8); PG8_WAIT_L(0); PG8_BAR; PG8_MMA(0, 0, At, B0); PG8_MMA(0, 1, At, B1); PG8_BAR; PG8_SCHED;
            PG8_LDA(At, 0, 1); PG8_STAGE(PG8_SB(0, 0), b2, voffB); PG8_STAGE(PG8_SB(0, 1), b2 + hstepB, voffB); PG8_STAGE(PG8_SA(0, 0), a2, voffA);
            PG8_WAIT_V(8); PG8_WAIT_L(0); PG8_BAR; PG8_MMA(1, 0, At, B0); PG8_MMA(1, 1, At, B1); PG8_BAR; PG8_SCHED;
            PG8_LDB(B0, 1, 0); PG8_LDB(B1, 1, 1); PG8_SCHED; PG8_LDA(At, 1, 0); PG8_STAGE(PG8_SA(0, 1), a2 + hstepA, voffA);
            PG8_WAIT_V(8); PG8_WAIT_L(0); PG8_BAR; PG8_MMA(0, 0, At, B0); PG8_MMA(0, 1, At, B1); PG8_BAR; PG8_SCHED;
            PG8_LDA(At, 1, 1); PG8_STAGE(PG8_SB(1, 0), b3, voffB); PG8_STAGE(PG8_SB(1, 1), b3 + hstepB, voffB); PG8_STAGE(PG8_SA(1, 0), a3, voffA);
            PG8_WAIT_V(8); PG8_WAIT_L(0); PG8_BAR; PG8_MMA(1, 0, At, B0); PG8_MMA(1, 1, At, B1); PG8_BAR; PG8_SCHED;
        }
        if (wr == 0) PG8_BAR;
        if constexpr (epi_chain<Epi>::value) { E.chain(acc, cur, wr, wc, fr, fq); }
        else if (cur.fin) {
            E(acc, cur, wr, wc, fr, fq);
            if (has_next) {
#pragma unroll
                for (int a = 0; a < 2; ++a)
#pragma unroll
                    for (int b = 0; b < 2; ++b)
#pragma unroll
                        for (int m = 0; m < 4; ++m)
#pragma unroll
                            for (int n = 0; n < 2; ++n) acc[a][b][m][n] = (f32x4){0.f, 0.f, 0.f, 0.f};
            }
        } else { if constexpr (Epi::HAS_MID) E.mid(acc, cur, wr, wc, fr, fq); }
        if (!has_next) break;
        cur = nxt; cA = nA; cB = nB; ++ui;
        if (wr == 1) PG8_BAR;
    }
    PG8_WAIT_V(0);
    PG8_BAR;
#undef PG8_SA
#undef PG8_SB
#undef PG8_STAGE
#undef PG8_LDA
#undef PG8_LDB
#undef PG8_MMA
#undef PG8_WAIT_V
#undef PG8_WAIT_L
#undef PG8_BAR
#undef PG8_SCHED
}
__device__ __forceinline__ void st_sc1(float* p, f32x4 v) { asm volatile("global_store_dwordx4 %0, %1, off sc1\n\ts_nop 1" :: "v"(p), "v"(v) : "memory"); }
struct EpiSlab {
    static constexpr bool PERM = false, HAS_MID = false;
    float* C;
    __device__ __forceinline__ void mid(ACC_T, const Unit&, int, int, int, int) const {}
    __device__ __forceinline__ void operator()(ACC_T, const Unit&, int wr, int wc, int fr, int fq) const {
        FOR_AIM { float* rowp = C + (size_t)(wr * 64 + fr + ai * HALF + m * 16) * 256 + wc * 32 + 4 * fq;
            FOR_BJN st_sc1(rowp + bj * HALF + n * 16, acc[ai][bj][m][n]); }
    }
};
struct TailArgs { float* slabs; unsigned* flags; const float* bp; const float* bs; const float* gate; float* outf; bf16_t* outb; int ldo; const bf16_t* P; };
template <int S, int MODE>
__device__ __forceinline__ void gemm_tail(LAS unsigned char* lds, const Gemm g, int nM, int nN, int G, int c, int R, int nt_slice, const TailArgs& a) {
    const int ntail = nM * nN - R * G, tileIdx = c % ntail, slice = c / ntail, tid = threadIdx.x;
    if (ntail * S != G) return;
    OneUnit S1; tile_of(R * G + tileIdx, nM, nN, S1.u.pm, S1.u.pn); S1.u.koff = slice * nt_slice * BK * 2; S1.u.nt = nt_slice; S1.u.fin = 1;
    float* tslab = a.slabs + (size_t)tileIdx * S * 65536;
    EpiSlab E{tslab + (size_t)slice * 65536};
    gemm_phase(lds, g, S1, E);
    unsigned* flag = a.flags + tileIdx * 64;
    if (tid == 0) { __hip_atomic_fetch_add(flag, 1u, __ATOMIC_RELAXED, __HIP_MEMORY_SCOPE_AGENT); unsigned sp = 0;
        while (__hip_atomic_load(flag, __ATOMIC_RELAXED, __HIP_MEMORY_SCOPE_AGENT) < (unsigned)S) { __builtin_amdgcn_s_sleep(1); if (++sp > (1u << 22)) break; }
        __builtin_amdgcn_fence(__ATOMIC_ACQUIRE, "agent"); asm volatile("s_waitcnt vmcnt(0)" ::: "memory"); }
    __syncthreads();
    constexpr int RPS = 256 / S;
#pragma unroll
    for (int j = 0; j < RPS / 8; ++j) { const int idx = j * 512 + tid, r = slice * RPS + (idx >> 6), c4 = (idx & 63) * 4;
        f32x4 s0 = (f32x4){0.f, 0.f, 0.f, 0.f}, s1 = s0;
#pragma unroll
        for (int q = 0; q < S; ++q) { const f32x4 v = *(const f32x4*)(tslab + (size_t)q * 65536 + r * 256 + c4); if (MODE == 2 && q >= S / 2) s1 += v; else s0 += v; }
        const int row = S1.u.pm * 256 + r, col = S1.u.pn * 256 + c4;
        if (MODE == 0 || MODE == 3) { const f32x4 gv = *(const f32x4*)(a.gate + (size_t)seq_of_row(row) * NMOD + col); f32x4 bv;
            if (MODE == 0) bv = *(const f32x4*)((row < NPROMPT ? a.bp + (size_t)row * D : a.bs + (size_t)(row - NPROMPT) * D) + col);
            else { const u32x2 bw = *(const u32x2*)((const bf16_t*)a.bp + (size_t)row * D + col); bv = (f32x4){bflo(bw.x), bfhi(bw.x), bflo(bw.y), bfhi(bw.y)}; }
            const f32x4 v = bv + gv * s0; u32x2 w; w.x = cvt_pk_bf16(v[0], v[1]); w.y = cvt_pk_bf16(v[2], v[3]); *(u32x2*)(a.outb + (size_t)row * a.ldo + col) = w; }
        else if (MODE == 1) { f32x4 v = s0;
#pragma unroll
            for (int e = 0; e < 4; ++e) { const float x = fmaxf(v[e], 0.f); v[e] = x * x; }
            u32x2 w; w.x = cvt_pk_bf16(v[0], v[1]); w.y = cvt_pk_bf16(v[2], v[3]); *(u32x2*)(a.outb + (size_t)row * a.ldo + col) = w; }
        else { const bf16_t* gp_ = a.P + (size_t)row * LDP + PC_GA + (2 * S1.u.pn + (c4 >> 7)) * 256 + (c4 & 127);
            const f32x4 rq = cvt4(*(const u32x2*)gp_), sq = cvt4(*(const u32x2*)(gp_ + HALF));
            const float o0 = sq[0] * (rq[0] * s0[0] + s1[0]), o1 = sq[1] * (rq[1] * s0[1] + s1[1]), o2 = sq[2] * (rq[2] * s0[2] + s1[2]), o3 = sq[3] * (rq[3] * s0[3] + s1[3]);
            u32x2 w; w.x = cvt_pk_bf16(o0, o1); w.y = cvt_pk_bf16(o2, o3); *(u32x2*)(a.outb + (size_t)row * a.ldo + col) = w; }
    }
}
}

#define XB_TMO      128
#define XB_XCNT(j)  (256  + 64 * (j))
#define XB_XSUB(j)  (1280 + 64 * (j))
#define XB_XGEN(j)  (2304 + 64 * (j))
#define XB_TOP      3328
#define XB_TOPGEN   3392
#define XCD_BAR_WORDS 3456
#define XB_SPIN_CAP (1u << 18)
__device__ __forceinline__ unsigned xb_ld(unsigned* p)              { return __hip_atomic_load(p, __ATOMIC_RELAXED, __HIP_MEMORY_SCOPE_AGENT); }
__device__ __forceinline__ unsigned xb_add(unsigned* p, unsigned v) { return __hip_atomic_fetch_add(p, v, __ATOMIC_RELAXED, __HIP_MEMORY_SCOPE_AGENT); }
__device__ __forceinline__ unsigned xb_xcc_id() { return (unsigned)__builtin_amdgcn_s_getreg((3 << 11) | 20) & 0xFu; }
#define XB_SPIN(cond, bar) do { unsigned _sp = 0; while (cond) { __builtin_amdgcn_s_sleep(1); \
    if ((++_sp & 255u) == 0u) { if (xb_ld(&(bar)[XB_TMO])) break; if (_sp > XB_SPIN_CAP) { atomicAdd(&(bar)[XB_TMO], 1u); break; } } } } while (0)
struct XcdBarrier { unsigned* bar; unsigned x; volatile LAS unsigned* st; };
__device__ __forceinline__ XcdBarrier xcd_barrier_post(unsigned* bar, volatile LAS unsigned* st) {
    XcdBarrier b; b.bar = bar; b.x = xb_xcc_id(); b.st = st;
    if (threadIdx.x == 0) (void)xb_add(&bar[XB_XCNT(b.x)], 1u);
    return b;
}
__device__ __forceinline__ void xcd_barrier_complete(unsigned* bar, unsigned x, unsigned& nloc, unsigned& nx) {
    const unsigned G = gridDim.x * gridDim.y * gridDim.z;
    unsigned sum, cnt, mine, sp = 0u;
    for (;;) {
        sum = 0u; cnt = 0u; mine = 0u;
#pragma unroll
        for (unsigned j = 0; j < 16; ++j) { const unsigned c = xb_ld(&bar[XB_XCNT(j)]); sum += c; cnt += (c > 0u) ? 1u : 0u; mine = (j == x) ? c : mine; }
        if (sum == G) break;
        __builtin_amdgcn_s_sleep(1);
        if ((++sp & 255u) == 0u) { if (xb_ld(&bar[XB_TMO])) break; if (sp > XB_SPIN_CAP) { atomicAdd(&bar[XB_TMO], 1u); break; } }
    }
    nloc = mine > 0u ? mine : 1u; nx = cnt > 0u ? cnt : 1u;
}
__device__ __forceinline__ void xcd_barrier(const XcdBarrier& b) {
    asm volatile("s_waitcnt vmcnt(0)" ::: "memory");
    __syncthreads();
    if (threadIdx.x == 0) {
        unsigned* bar = b.bar;
        __builtin_amdgcn_s_waitcnt(0);
        unsigned nloc = b.st[0], nx = b.st[1];
        if (nloc == 0u) { xcd_barrier_complete(bar, b.x, nloc, nx); b.st[0] = nloc; b.st[1] = nx; }
        const unsigned old = xb_add(&bar[XB_XSUB(b.x)], 1u);
        const unsigned gen = old / nloc;
        if (old + 1u == (gen + 1u) * nloc) {
            __builtin_amdgcn_fence(__ATOMIC_RELEASE, "agent");
            asm volatile("s_waitcnt vmcnt(0)" ::: "memory");
            const unsigned og = xb_add(&bar[XB_TOP], 1u);
            const unsigned tg = og / nx;
            if (og + 1u == (tg + 1u) * nx) xb_add(&bar[XB_TOPGEN], 1u);
            else XB_SPIN(xb_ld(&bar[XB_TOPGEN]) == tg, bar);
            __builtin_amdgcn_fence(__ATOMIC_ACQUIRE, "agent");
            xb_add(&bar[XB_XGEN(b.x)], 1u);
            asm volatile("s_waitcnt vmcnt(0)" ::: "memory");
        } else {
            XB_SPIN(xb_ld(&bar[XB_XGEN(b.x)]) == gen, bar);
            __builtin_amdgcn_fence(__ATOMIC_ACQUIRE, "agent");
            asm volatile("s_waitcnt vmcnt(0)" ::: "memory");
        }
    }
    __syncthreads();
}

constexpr int CW_BAR = 4096, CW_TAIL = 16384;
struct Args { const float* in[34]; float* out; unsigned char* ws; int ph_lo, ph_hi, sub; };
enum { I_XP = 0, I_XS, I_SWKV, I_SSHIFT, I_SGDN, I_SCONV, I_CP, I_CS, I_N1W, I_N2W, I_WADA, I_BADA, I_WIN, I_RMU, I_RW0, I_RWW2, I_RA0, I_RWA2, I_RWG2, I_RKK, I_RKA, I_RRK, I_LNXW, I_LNXB, I_CONVW, I_ALOG, I_DTB, I_GNW, I_WOA, I_WOB, I_WOUT, I_WUP, I_WDOWN, I_FNW };
constexpr int NPHASE = 16;

__device__ __forceinline__ void transpose_item(const float* W, int N, int k0, int n0, bf16_t* WT, size_t dst_row0, int dst_ld, int dst_k0, LAS float* scr, int lane) {
    float xv[32];
#pragma unroll
    for (int i = 0; i < 32; ++i) { const int kk = 2 * i + (lane >> 5); xv[i] = W[(size_t)(k0 + kk) * N + n0 + (lane & 31)]; }
    __builtin_amdgcn_sched_barrier(0);
#pragma unroll
    for (int i = 0; i < 32; ++i) { const int kk = 2 * i + (lane >> 5); scr[kk * 33 + (lane & 31)] = xv[i]; }
    asm volatile("s_waitcnt lgkmcnt(0)" ::: "memory");
    const int c = lane & 7;
#pragma unroll
    for (int j = 0; j < 4; ++j) { const int n = (lane >> 3) + 8 * j; const LAS float* s = scr + (8 * c) * 33 + n;
        u32x4 o; o.x = pk2(s[0 * 33], s[1 * 33]); o.y = pk2(s[2 * 33], s[3 * 33]); o.z = pk2(s[4 * 33], s[5 * 33]); o.w = pk2(s[6 * 33], s[7 * 33]);
        *(u32x4*)(WT + (dst_row0 + n) * (size_t)dst_ld + dst_k0 + k0 + 8 * c) = o; }
    asm volatile("s_waitcnt lgkmcnt(0)" ::: "memory");
}

template <int MODE, bool IN_BF16>
__device__ __forceinline__ void norm_rows(const float* xp, const float* xs_, const float* nw, const float* mod, int sh_off, int sc_off, bf16_t* ob, float* of, int gw, int NGW, int lane) {
    constexpr int NR = IN_BF16 ? 8 : 16;
    f32x4 rc[NR], rn[NR];
#define NR_LOAD(R, mm) do { if (IN_BF16) { const bf16_t* xr_ = (const bf16_t*)xp + (size_t)(mm) * D; _Pragma("unroll") for (int j = 0; j < NR; ++j) R[j] = *(const f32x4*)(xr_ + (j * 64 + lane) * 8); } \
        else { const float* xr_ = ((mm) < NPROMPT ? xp + (size_t)(mm) * D : xs_ + (size_t)((mm) - NPROMPT) * D); _Pragma("unroll") for (int j = 0; j < NR; ++j) R[j] = *(const f32x4*)(xr_ + (j * 64 + lane) * 4); } } while (0)
    if (gw < MTOK) NR_LOAD(rc, gw);
    for (int m = gw; m < MTOK; m += NGW) {
        { const int mn = m + NGW < MTOK ? m + NGW : m; NR_LOAD(rn, mn); }
        f32x4 v[16]; float ss = 0.f;
        if (IN_BF16) {
#pragma unroll
            for (int j = 0; j < 8; ++j) { const u32x4 w = __builtin_bit_cast(u32x4, rc[j]); v[2 * j] = (f32x4){bflo(w.x), bfhi(w.x), bflo(w.y), bfhi(w.y)}; v[2 * j + 1] = (f32x4){bflo(w.z), bfhi(w.z), bflo(w.w), bfhi(w.w)}; }
        } else {
#pragma unroll
            for (int j = 0; j < 16; ++j) v[j] = rc[j < NR ? j : 0]; }
#pragma unroll
        for (int j = 0; j < 16; ++j) ss += (v[j].x * v[j].x + v[j].y * v[j].y) + (v[j].z * v[j].z + v[j].w * v[j].w);
        const float rstd = 1.0f / sqrtf(wave_sum(ss) * (1.0f / D) + 1e-6f);
        if (MODE == 0) {
            const int s = seq_of_row(m); const float* mr = mod + (size_t)s * NMOD;
#pragma unroll
            for (int j = 0; j < 16; ++j) { const int c = IN_BF16 ? ((j >> 1) * 64 + lane) * 8 + (j & 1) * 4 : (j * 64 + lane) * 4; const f32x4 w = *(const f32x4*)(nw + c), sc = *(const f32x4*)(mr + sc_off + c), sh = *(const f32x4*)(mr + sh_off + c);
                const f32x4 y = v[j] * rstd * w * (sc + 1.0f) + sh; u32x2 o; o.x = pk2(y.x, y.y); o.y = pk2(y.z, y.w); *(u32x2*)(ob + (size_t)m * D + c) = o; }
        } else {
#pragma unroll
            for (int j = 0; j < 16; ++j) { const int c = IN_BF16 ? ((j >> 1) * 64 + lane) * 8 + (j & 1) * 4 : (j * 64 + lane) * 4; const f32x4 w = *(const f32x4*)(nw + c); *(f32x4*)(of + (size_t)m * D + c) = v[j] * rstd * w; }
        }
#pragma unroll
        for (int j = 0; j < NR; ++j) rc[j] = rn[j];
    }
#undef NR_LOAD
}

#define RWKV_STEP(S, w4, kk4, b4, kp4, r4, vv, oo) do { \
    float sa_ = S.x * kk4.x + S.y * kk4.y + S.z * kk4.z + S.w * kk4.w; sa_ = -row16_sum(sa_); \
    S.x = S.x * w4.x + sa_ * b4.x + vv * kp4.x; S.y = S.y * w4.y + sa_ * b4.y + vv * kp4.y; S.z = S.z * w4.z + sa_ * b4.z + vv * kp4.z; S.w = S.w * w4.w + sa_ * b4.w + vv * kp4.w; \
    float o_ = S.x * r4.x + S.y * r4.y + S.z * r4.z + S.w * r4.w; oo = row16_sum(o_); } while (0)

struct RwStep { f32x4 w4, kk4, b4, kp4, r4; float vv; };
#define RW_LD(d, bk, bv, off) do { \
    asm volatile("ds_read_b128 %0, %1 offset:%2" : "=v"(d.w4) : "v"(bk), "n"((off))); asm volatile("ds_read_b128 %0, %1 offset:%2" : "=v"(d.kk4) : "v"(bk), "n"((off) + 256)); \
    asm volatile("ds_read_b128 %0, %1 offset:%2" : "=v"(d.b4) : "v"(bk), "n"((off) + 512)); asm volatile("ds_read_b128 %0, %1 offset:%2" : "=v"(d.kp4) : "v"(bk), "n"((off) + 768)); \
    asm volatile("ds_read_b128 %0, %1 offset:%2" : "=v"(d.r4) : "v"(bk), "n"((off) + 1024)); asm volatile("ds_read_b32 %0, %1 offset:%2" : "=v"(d.vv) : "v"(bv), "n"((off))); } while (0)
#define RW_WAIT(d, n) do { asm volatile("s_waitcnt lgkmcnt(" #n ")" : "+v"(d.w4), "+v"(d.kk4), "+v"(d.b4), "+v"(d.kp4), "+v"(d.r4), "+v"(d.vv)); __builtin_amdgcn_sched_barrier(0); } while (0)
#define RW_STEP(d, opart) do { \
    f32x2 p_ = S01 * (f32x2){d.kk4.x, d.kk4.y}; p_ = S23 * (f32x2){d.kk4.z, d.kk4.w} + p_; const float nsa_ = -row16_sum(p_.x + p_.y); \
    f32x2 t0_ = (f32x2){d.b4.x, d.b4.y} * nsa_, t1_ = (f32x2){d.b4.z, d.b4.w} * nsa_; \
    t0_ = S01 * (f32x2){d.w4.x, d.w4.y} + t0_; t1_ = S23 * (f32x2){d.w4.z, d.w4.w} + t1_; \
    S01 = (f32x2){d.kp4.x, d.kp4.y} * d.vv + t0_; S23 = (f32x2){d.kp4.z, d.kp4.w} * d.vv + t1_; \
    f32x2 q_ = S01 * (f32x2){d.r4.x, d.r4.y}; q_ = S23 * (f32x2){d.r4.z, d.r4.w} + q_; opart = q_.x + q_.y; } while (0)
__device__ __forceinline__ float swz_xor4(float x) { return __builtin_bit_cast(float, __builtin_amdgcn_ds_swizzle(__builtin_bit_cast(int, x), 0x101F)); }
__device__ __forceinline__ float swz_xor8(float x) { return __builtin_bit_cast(float, __builtin_amdgcn_ds_swizzle(__builtin_bit_cast(int, x), 0x201F)); }
__device__ __forceinline__ float transpose_reduce16(const float (&op)[16], int kq) {
    const bool b0 = kq & 1, b1 = kq & 2, b2 = kq & 4, b3 = kq & 8; float r1[8], r2[4], r3[2];
#pragma unroll
    for (int i = 0; i < 8; ++i) { const float a = op[2 * i], b = op[2 * i + 1]; r1[i] = (b0 ? b : a) + dppf<0xB1>(b0 ? a : b); }
#pragma unroll
    for (int i = 0; i < 4; ++i) { const float a = r1[2 * i], b = r1[2 * i + 1]; r2[i] = (b1 ? b : a) + dppf<0x4E>(b1 ? a : b); }
#pragma unroll
    for (int i = 0; i < 2; ++i) { const float a = r2[2 * i], b = r2[2 * i + 1]; r3[i] = (b2 ? b : a) + swz_xor4(b2 ? a : b); }
    return (b3 ? r3[1] : r3[0]) + swz_xor8(b3 ? r3[0] : r3[1]);
}
__device__ __forceinline__ void rwkv_prompt_item(LAS unsigned char* lds, const float* RS, float* OA, float* outS, int item, int w, int lane) {
    constexpr int CH = 16, CHB = CH * RREC * 4, NB = 5, NCH = TP / CH, RB = RREC * 4;
    const int bh = item >> 1, half = item & 1, b = bh >> 5, h = bh & 31, rg = lane >> 4, kq = lane & 15, row = half * 32 + w * 4 + rg;
    const char* src = (const char*)(RS + (size_t)bh * TP * RREC);
#define RW_ISSUE(ci) do { const int cs_ = (ci) < NCH ? (ci) : NCH - 1; const int sl_ = (ci) % NB; _Pragma("unroll") for (int i_ = 0; i_ < 3; ++i_) { const int pc_ = w * 3 + i_; \
        __builtin_amdgcn_global_load_lds((const unsigned*)(src + (size_t)cs_ * CHB + pc_ * 1024 + lane * 16), (LAS unsigned*)(lds + sl_ * CHB + pc_ * 1024), 16, 0, 0); } } while (0)
    f32x2 S01 = (f32x2){0.f, 0.f}, S23 = (f32x2){0.f, 0.f};
#pragma unroll
    for (int ci = 0; ci < NB - 1; ++ci) RW_ISSUE(ci);
    asm volatile("s_waitcnt vmcnt(9)" ::: "memory"); __builtin_amdgcn_s_barrier(); asm volatile("" ::: "memory");
    const unsigned lbase = (unsigned)(size_t)lds;
    RwStep A, B; { const unsigned bk = lbase + kq * 16, bv = lbase + 1280 + row * 4; RW_LD(A, bk, bv, 0); }
    for (int ci = 0; ci < NCH; ++ci) {
        asm volatile("s_waitcnt vmcnt(6)" ::: "memory"); __builtin_amdgcn_s_barrier(); asm volatile("" ::: "memory");
        RW_ISSUE(ci + NB - 1);
        const unsigned sl = lbase + (ci % NB) * CHB, nsl = lbase + ((ci + 1) % NB) * CHB;
        const unsigned bk = sl + kq * 16, bv = sl + 1280 + row * 4, nbk = nsl + kq * 16, nbv = nsl + 1280 + row * 4;
        float op[16];
#define RW_PAIR(st) do { RW_LD(B, bk, bv, ((st) + 1) * RB); RW_WAIT(A, 6); RW_STEP(A, op[st]); RW_LD(A, bk, bv, ((st) + 2) * RB); RW_WAIT(B, 6); RW_STEP(B, op[(st) + 1]); } while (0)
        RW_PAIR(0); RW_PAIR(2); RW_PAIR(4); RW_PAIR(6); RW_PAIR(8); RW_PAIR(10); RW_PAIR(12);
        RW_LD(B, bk, bv, 15 * RB); RW_WAIT(A, 6); RW_STEP(A, op[14]); RW_LD(A, nbk, nbv, 0); RW_WAIT(B, 6); RW_STEP(B, op[15]);
#undef RW_PAIR
        OA[(size_t)(b * TP + ci * CH + kq) * RW + h * RH + row] = transpose_reduce16(op, kq);
    }
    *(f32x4*)(outS + ((size_t)bh * RH + row) * RH + 4 * kq) = (f32x4){S01.x, S01.y, S23.x, S23.y};
    asm volatile("s_waitcnt vmcnt(0) lgkmcnt(0)" ::: "memory"); __builtin_amdgcn_s_barrier(); asm volatile("" ::: "memory");
#undef RW_ISSUE
}
__device__ __forceinline__ void rwkv_sample_item(const float* RS, const float* S0, bf16_t* OA, float* outS, int item, int lane) {
    const int bh = item >> 2, q4 = item & 3, b = bh >> 5, h = bh & 31, rg = lane >> 4, kq = lane & 15;
    const float* rec = RS + ((size_t)BP * RHEADS * TP + (size_t)bh * TS) * RREC;
    f32x4 w4[4], kk4[4], b4[4], kp4[4], r4[4];
#pragma unroll
    for (int t = 0; t < 4; ++t) { const float* r = rec + t * RREC + 4 * kq; w4[t] = *(const f32x4*)(r); kk4[t] = *(const f32x4*)(r + 64); b4[t] = *(const f32x4*)(r + 128); kp4[t] = *(const f32x4*)(r + 192); r4[t] = *(const f32x4*)(r + 256); }
    f32x4 S[4]; float vv[4][4];
#pragma unroll
    for (int sub = 0; sub < 4; ++sub) { const int row = q4 * 16 + sub * 4 + rg; S[sub] = *(const f32x4*)(S0 + ((size_t)bh * RH + row) * RH + 4 * kq);
#pragma unroll
        for (int t = 0; t < 4; ++t) vv[sub][t] = rec[t * RREC + 320 + row]; }
#pragma unroll
    for (int sub = 0; sub < 4; ++sub) { const int row = q4 * 16 + sub * 4 + rg; float okeep = 0.f;
#pragma unroll
        for (int t = 0; t < 4; ++t) { float oo; RWKV_STEP(S[sub], w4[t], kk4[t], b4[t], kp4[t], r4[t], vv[sub][t], oo); okeep = (kq == t) ? oo : okeep; }
        if (kq < 4) OA[(size_t)(NPROMPT + b * TS + kq) * RW + h * RH + row] = (bf16_t)cvt2(okeep, 0.f);
        *(f32x4*)(outS + ((size_t)bh * RH + row) * RH + 4 * kq) = S[sub]; }
}
struct GdStep { f32x4 q0, q1, k0, k1, sc; float vv; };
#define GD_LD(d, bk, bv, bs, off) do { \
    asm volatile("ds_read_b128 %0, %1 offset:%2" : "=v"(d.q0) : "v"(bk), "n"((off))); asm volatile("ds_read_b128 %0, %1 offset:%2" : "=v"(d.q1) : "v"(bk), "n"((off) + 16)); \
    asm volatile("ds_read_b128 %0, %1 offset:%2" : "=v"(d.k0) : "v"(bk), "n"((off) + 512)); asm volatile("ds_read_b128 %0, %1 offset:%2" : "=v"(d.k1) : "v"(bk), "n"((off) + 528)); \
    asm volatile("ds_read_b128 %0, %1 offset:%2" : "=v"(d.sc) : "v"(bs), "n"((off) + 1536)); asm volatile("ds_read_b32 %0, %1 offset:%2" : "=v"(d.vv) : "v"(bv), "n"((off))); } while (0)
#define GD_WAIT(d, n) do { asm volatile("s_waitcnt lgkmcnt(" #n ")" : "+v"(d.q0), "+v"(d.q1), "+v"(d.k0), "+v"(d.k1), "+v"(d.sc), "+v"(d.vv)); __builtin_amdgcn_sched_barrier(0); } while (0)
#define GD_STEP(d, opart) do { \
    f32x2 p_ = S0 * (f32x2){d.k0.x, d.k0.y}; p_ = S1 * (f32x2){d.k0.z, d.k0.w} + p_; p_ = S2 * (f32x2){d.k1.x, d.k1.y} + p_; p_ = S3 * (f32x2){d.k1.z, d.k1.w} + p_; \
    f32x2 q_ = S0 * (f32x2){d.q0.x, d.q0.y}; q_ = S1 * (f32x2){d.q0.z, d.q0.w} + q_; q_ = S2 * (f32x2){d.q1.x, d.q1.y} + q_; q_ = S3 * (f32x2){d.q1.z, d.q1.w} + q_; \
    const float ks_ = row16_sum(p_.x + p_.y); const float u_ = d.sc.y * (d.vv - d.sc.x * ks_); opart = d.sc.x * (q_.x + q_.y) + d.sc.w * u_; \
    S0 = S0 * d.sc.x + (f32x2){d.k0.x, d.k0.y} * u_; S1 = S1 * d.sc.x + (f32x2){d.k0.z, d.k0.w} * u_; S2 = S2 * d.sc.x + (f32x2){d.k1.x, d.k1.y} * u_; S3 = S3 * d.sc.x + (f32x2){d.k1.z, d.k1.w} * u_; } while (0)
__device__ __forceinline__ void gdn_prompt_item(LAS unsigned char* lds, const float* GS, float* OB, float* outS, int item, int w, int lane) {
    constexpr int CH = 16, CHB = CH * GREC * 4, NB = 5, NCH = TP / CH, NPIECE = CHB / 1024, GB = GREC * 4;
    const int bh = item >> 2, qd = item & 3, b = bh >> 4, h = bh & 15, cc = lane >> 4, dq = lane & 15, col = qd * 32 + w * 4 + cc;
    const char* src = (const char*)(GS + (size_t)bh * TP * GREC);
#define GD_ISSUE(ci) do { const int cs_ = (ci) < NCH ? (ci) : NCH - 1; const int sl_ = (ci) % NB; _Pragma("unroll") for (int i_ = 0; i_ < 4; ++i_) { int pc_ = w * 4 + i_; pc_ = pc_ < NPIECE ? pc_ : NPIECE - 1; \
        __builtin_amdgcn_global_load_lds((const unsigned*)(src + (size_t)cs_ * CHB + pc_ * 1024 + lane * 16), (LAS unsigned*)(lds + sl_ * CHB + pc_ * 1024), 16, 0, 0); } } while (0)
    f32x2 S0 = (f32x2){0.f, 0.f}, S1 = S0, S2 = S0, S3 = S0;
#pragma unroll
    for (int ci = 0; ci < NB - 1; ++ci) GD_ISSUE(ci);
    asm volatile("s_waitcnt vmcnt(12)" ::: "memory"); __builtin_amdgcn_s_barrier(); asm volatile("" ::: "memory");
    const unsigned lbase = (unsigned)(size_t)lds;
    GdStep A, B; { const unsigned bk = lbase + dq * 32, bv = lbase + 1024 + col * 4; GD_LD(A, bk, bv, lbase, 0); }
    for (int ci = 0; ci < NCH; ++ci) {
        asm volatile("s_waitcnt vmcnt(8)" ::: "memory"); __builtin_amdgcn_s_barrier(); asm volatile("" ::: "memory");
        GD_ISSUE(ci + NB - 1);
        const unsigned sl = lbase + (ci % NB) * CHB, nsl = lbase + ((ci + 1) % NB) * CHB;
        const unsigned bk = sl + dq * 32, bv = sl + 1024 + col * 4, nbk = nsl + dq * 32, nbv = nsl + 1024 + col * 4;
        float op[16];
#define GD_PAIR(st) do { GD_LD(B, bk, bv, sl, ((st) + 1) * GB); GD_WAIT(A, 6); GD_STEP(A, op[st]); GD_LD(A, bk, bv, sl, ((st) + 2) * GB); GD_WAIT(B, 6); GD_STEP(B, op[(st) + 1]); } while (0)
        GD_PAIR(0); GD_PAIR(2); GD_PAIR(4); GD_PAIR(6); GD_PAIR(8); GD_PAIR(10); GD_PAIR(12);
        GD_LD(B, bk, bv, sl, 15 * GB); GD_WAIT(A, 6); GD_STEP(A, op[14]); GD_LD(A, nbk, nbv, nsl, 0); GD_WAIT(B, 6); GD_STEP(B, op[15]);
#undef GD_PAIR
        OB[(size_t)(b * TP + ci * CH + dq) * GW + h * GH + col] = transpose_reduce16(op, dq);
    }
    { const float Sv[8] = {S0.x, S0.y, S1.x, S1.y, S2.x, S2.y, S3.x, S3.y};
#pragma unroll
      for (int j = 0; j < 8; ++j) outS[((size_t)bh * GH + dq * 8 + j) * GH + col] = Sv[j]; }
    asm volatile("s_waitcnt vmcnt(0) lgkmcnt(0)" ::: "memory"); __builtin_amdgcn_s_barrier(); asm volatile("" ::: "memory");
#undef GD_ISSUE
}
struct Rw8 { f32x4 w0, w1, k0, k1, b0, b1, p0, p1, r0, r1; float vv; };
#define RW8_LD(d, bk, bv, off) do { \
    asm volatile("ds_read_b128 %0, %1 offset:%2" : "=v"(d.w0) : "v"(bk), "n"((off))); asm volatile("ds_read_b128 %0, %1 offset:%2" : "=v"(d.w1) : "v"(bk), "n"((off) + 16)); \
    asm volatile("ds_read_b128 %0, %1 offset:%2" : "=v"(d.k0) : "v"(bk), "n"((off) + 256)); asm volatile("ds_read_b128 %0, %1 offset:%2" : "=v"(d.k1) : "v"(bk), "n"((off) + 272)); \
    asm volatile("ds_read_b128 %0, %1 offset:%2" : "=v"(d.b0) : "v"(bk), "n"((off) + 512)); asm volatile("ds_read_b128 %0, %1 offset:%2" : "=v"(d.b1) : "v"(bk), "n"((off) + 528)); \
    asm volatile("ds_read_b128 %0, %1 offset:%2" : "=v"(d.p0) : "v"(bk), "n"((off) + 768)); asm volatile("ds_read_b128 %0, %1 offset:%2" : "=v"(d.p1) : "v"(bk), "n"((off) + 784)); \
    asm volatile("ds_read_b128 %0, %1 offset:%2" : "=v"(d.r0) : "v"(bk), "n"((off) + 1024)); asm volatile("ds_read_b128 %0, %1 offset:%2" : "=v"(d.r1) : "v"(bk), "n"((off) + 1040)); \
    asm volatile("ds_read_b32 %0, %1 offset:%2" : "=v"(d.vv) : "v"(bv), "n"((off))); } while (0)
#define RW8_WAIT(d) do { asm volatile("s_waitcnt lgkmcnt(11)" : "+v"(d.w0), "+v"(d.w1), "+v"(d.k0), "+v"(d.k1), "+v"(d.b0), "+v"(d.b1), "+v"(d.p0), "+v"(d.p1), "+v"(d.r0), "+v"(d.r1), "+v"(d.vv)); __builtin_amdgcn_sched_barrier(0); } while (0)
__device__ __forceinline__ float oct_sum(float x) { x += dppf<0xB1>(x); x += dppf<0x4E>(x); x += dppf<0x141>(x); return x; }
#define LO2(v) ((f32x2){(v).x, (v).y})
#define HI2(v) ((f32x2){(v).z, (v).w})
#define RW8_STEP(d, opart) do { \
    f32x2 p_ = R0 * LO2(d.k0); p_ = R1 * HI2(d.k0) + p_; p_ = R2 * LO2(d.k1) + p_; p_ = R3 * HI2(d.k1) + p_; const float nsa_ = -oct_sum(p_.x + p_.y); \
    f32x2 t0_ = LO2(d.b0) * nsa_, t1_ = HI2(d.b0) * nsa_, t2_ = LO2(d.b1) * nsa_, t3_ = HI2(d.b1) * nsa_; \
    t0_ = R0 * LO2(d.w0) + t0_; t1_ = R1 * HI2(d.w0) + t1_; t2_ = R2 * LO2(d.w1) + t2_; t3_ = R3 * HI2(d.w1) + t3_; \
    R0 = LO2(d.p0) * d.vv + t0_; R1 = HI2(d.p0) * d.vv + t1_; R2 = LO2(d.p1) * d.vv + t2_; R3 = HI2(d.p1) * d.vv + t3_; \
    f32x2 q_ = R0 * LO2(d.r0); q_ = R1 * HI2(d.r0) + q_; q_ = R2 * LO2(d.r1) + q_; q_ = R3 * HI2(d.r1) + q_; opart = q_.x + q_.y; } while (0)
struct Gd8 { f32x4 q0, q1, q2, q3, k0, k1, k2, k3, sc; float vv; };
#define GD8_LD(d, bk, bv, bs, off) do { \
    asm volatile("ds_read_b128 %0, %1 offset:%2" : "=v"(d.q0) : "v"(bk), "n"((off))); asm volatile("ds_read_b128 %0, %1 offset:%2" : "=v"(d.q1) : "v"(bk), "n"((off) + 16)); \
    asm volatile("ds_read_b128 %0, %1 offset:%2" : "=v"(d.q2) : "v"(bk), "n"((off) + 32)); asm volatile("ds_read_b128 %0, %1 offset:%2" : "=v"(d.q3) : "v"(bk), "n"((off) + 48)); \
    asm volatile("ds_read_b128 %0, %1 offset:%2" : "=v"(d.k0) : "v"(bk), "n"((off) + 512)); asm volatile("ds_read_b128 %0, %1 offset:%2" : "=v"(d.k1) : "v"(bk), "n"((off) + 528)); \
    asm volatile("ds_read_b128 %0, %1 offset:%2" : "=v"(d.k2) : "v"(bk), "n"((off) + 544)); asm volatile("ds_read_b128 %0, %1 offset:%2" : "=v"(d.k3) : "v"(bk), "n"((off) + 560)); \
    asm volatile("ds_read_b128 %0, %1 offset:%2" : "=v"(d.sc) : "v"(bs), "n"((off) + 1536)); asm volatile("ds_read_b32 %0, %1 offset:%2" : "=v"(d.vv) : "v"(bv), "n"((off))); } while (0)
#define GD8_WAIT(d) do { asm volatile("s_waitcnt lgkmcnt(10)" : "+v"(d.q0), "+v"(d.q1), "+v"(d.q2), "+v"(d.q3), "+v"(d.k0), "+v"(d.k1), "+v"(d.k2), "+v"(d.k3), "+v"(d.sc), "+v"(d.vv)); __builtin_amdgcn_sched_barrier(0); } while (0)
#define GD8_STEP(d, opart) do { \
    f32x2 p_ = G0 * LO2(d.k0); p_ = G1 * HI2(d.k0) + p_; p_ = G2 * LO2(d.k1) + p_; p_ = G3 * HI2(d.k1) + p_; p_ = G4 * LO2(d.k2) + p_; p_ = G5 * HI2(d.k2) + p_; p_ = G6 * LO2(d.k3) + p_; p_ = G7 * HI2(d.k3) + p_; \
    f32x2 q_ = G0 * LO2(d.q0); q_ = G1 * HI2(d.q0) + q_; q_ = G2 * LO2(d.q1) + q_; q_ = G3 * HI2(d.q1) + q_; q_ = G4 * LO2(d.q2) + q_; q_ = G5 * HI2(d.q2) + q_; q_ = G6 * LO2(d.q3) + q_; q_ = G7 * HI2(d.q3) + q_; \
    const float ks_ = oct_sum(p_.x + p_.y); const float u_ = d.sc.y * (d.vv - d.sc.x * ks_); opart = d.sc.x * (q_.x + q_.y) + d.sc.w * u_; \
    G0 = G0 * d.sc.x + LO2(d.k0) * u_; G1 = G1 * d.sc.x + HI2(d.k0) * u_; G2 = G2 * d.sc.x + LO2(d.k1) * u_; G3 = G3 * d.sc.x + HI2(d.k1) * u_; \
    G4 = G4 * d.sc.x + LO2(d.k2) * u_; G5 = G5 * d.sc.x + HI2(d.k2) * u_; G6 = G6 * d.sc.x + LO2(d.k3) * u_; G7 = G7 * d.sc.x + HI2(d.k3) * u_; } while (0)
__device__ __forceinline__ float transpose_reduce8(const float (&op)[8], int k8) {
    const bool b0 = k8 & 1, b1 = k8 & 2, b2 = k8 & 4; float r1[4], r2[2];
#pragma unroll
    for (int i = 0; i < 4; ++i) { const float a = op[2 * i], b = op[2 * i + 1]; r1[i] = (b0 ? b : a) + dppf<0xB1>(b0 ? a : b); }
#pragma unroll
    for (int i = 0; i < 2; ++i) { const float a = r1[2 * i], b = r1[2 * i + 1]; r2[i] = (b1 ? b : a) + dppf<0x4E>(b1 ? a : b); }
    return (b2 ? r2[1] : r2[0]) + swz_xor4(b2 ? r2[0] : r2[1]);
}
__device__ __forceinline__ void scan_prompt_split(LAS unsigned char* lds, const float* RS, const float* GS, float* OA, float* OB, float* outSR, float* outSG, int item, int w, int lane) {
    constexpr int CH = 8, RCB = CH * RREC * 4  , GCB = CH * GREC * 4  , GSL = 13312, SLB = RCB + GSL  , NB = 5, NCH = TP / CH, RB = RREC * 4, GB = GREC * 4;
    const int rbh = item >> 1, half = item & 1, gbh = item >> 2, qd = item & 3, g8 = lane >> 3, l8 = lane & 7;
    const char* rsrc = (const char*)(RS + (size_t)rbh * TP * RREC); const char* gsrc = (const char*)(GS + (size_t)gbh * TP * GREC);
#define SP_ISSUE(ci) do { const int cs_ = (ci) < NCH ? (ci) : NCH - 1; const int sl_ = (ci) % NB; _Pragma("unroll") for (int i_ = 0; i_ < 4; ++i_) { int pc_ = w * 4 + i_; pc_ = pc_ < 25 ? pc_ : 24; \
        const char* g_ = pc_ < 12 ? rsrc + (size_t)cs_ * RCB + pc_ * 1024 : gsrc + (size_t)cs_ * GCB + (pc_ - 12) * 1024; \
        __builtin_amdgcn_global_load_lds((const unsigned*)(g_ + lane * 16), (LAS unsigned*)(lds + sl_ * SLB + pc_ * 1024), 16, 0, 0); } } while (0)
#define SP_TOP() do { asm volatile("s_waitcnt vmcnt(8)" ::: "memory"); __builtin_amdgcn_s_barrier(); asm volatile("" ::: "memory"); SP_ISSUE(ci + NB - 1); } while (0)
#pragma unroll
    for (int ci = 0; ci < NB - 1; ++ci) SP_ISSUE(ci);
    asm volatile("s_waitcnt vmcnt(12)" ::: "memory"); __builtin_amdgcn_s_barrier(); asm volatile("" ::: "memory");
    const unsigned lbase = (unsigned)(size_t)lds;
    if (w < 4) {
        const int rb = rbh >> 5, rh = rbh & 31, row = half * 32 + w * 8 + g8;
        f32x2 R0 = (f32x2){0.f, 0.f}, R1 = R0, R2 = R0, R3 = R0;
        Rw8 A, B; RW8_LD(A, lbase + l8 * 32, lbase + 1280 + row * 4, 0);
        for (int ci = 0; ci < NCH; ++ci) {
            SP_TOP();
            const unsigned sl = lbase + (ci % NB) * SLB, nsl = lbase + ((ci + 1) % NB) * SLB, bk = sl + l8 * 32, bv = sl + 1280 + row * 4, nbk = nsl + l8 * 32, nbv = nsl + 1280 + row * 4;
            float op[8];
            RW8_LD(B, bk, bv, 1 * RB); RW8_WAIT(A); RW8_STEP(A, op[0]); RW8_LD(A, bk, bv, 2 * RB); RW8_WAIT(B); RW8_STEP(B, op[1]);
            RW8_LD(B, bk, bv, 3 * RB); RW8_WAIT(A); RW8_STEP(A, op[2]); RW8_LD(A, bk, bv, 4 * RB); RW8_WAIT(B); RW8_STEP(B, op[3]);
            RW8_LD(B, bk, bv, 5 * RB); RW8_WAIT(A); RW8_STEP(A, op[4]); RW8_LD(A, bk, bv, 6 * RB); RW8_WAIT(B); RW8_STEP(B, op[5]);
            RW8_LD(B, bk, bv, 7 * RB); RW8_WAIT(A); RW8_STEP(A, op[6]); RW8_LD(A, nbk, nbv, 0); RW8_WAIT(B); RW8_STEP(B, op[7]);
            OA[(size_t)(rb * TP + ci * CH + l8) * RW + rh * RH + row] = transpose_reduce8(op, l8);
        }
        float* so = outSR + ((size_t)rbh * RH + row) * RH + 8 * l8;
        *(f32x4*)so = (f32x4){R0.x, R0.y, R1.x, R1.y}; *(f32x4*)(so + 4) = (f32x4){R2.x, R2.y, R3.x, R3.y};
    } else {
        const int gb = gbh >> 4, gh = gbh & 15, col = qd * 32 + (w - 4) * 8 + g8;
        f32x2 G0 = (f32x2){0.f, 0.f}, G1 = G0, G2 = G0, G3 = G0, G4 = G0, G5 = G0, G6 = G0, G7 = G0;
        Gd8 A, B; { const unsigned gs0 = lbase + RCB; GD8_LD(A, gs0 + l8 * 64, gs0 + 1024 + col * 4, gs0, 0); }
        for (int ci = 0; ci < NCH; ++ci) {
            SP_TOP();
            const unsigned gs = lbase + (ci % NB) * SLB + RCB, ngs = lbase + ((ci + 1) % NB) * SLB + RCB, bk = gs + l8 * 64, bv = gs + 1024 + col * 4, nbk = ngs + l8 * 64, nbv = ngs + 1024 + col * 4;
            float op[8];
            GD8_LD(B, bk, bv, gs, 1 * GB); GD8_WAIT(A); GD8_STEP(A, op[0]); GD8_LD(A, bk, bv, gs, 2 * GB); GD8_WAIT(B); GD8_STEP(B, op[1]);
            GD8_LD(B, bk, bv, gs, 3 * GB); GD8_WAIT(A); GD8_STEP(A, op[2]); GD8_LD(A, bk, bv, gs, 4 * GB); GD8_WAIT(B); GD8_STEP(B, op[3]);
            GD8_LD(B, bk, bv, gs, 5 * GB); GD8_WAIT(A); GD8_STEP(A, op[4]); GD8_LD(A, bk, bv, gs, 6 * GB); GD8_WAIT(B); GD8_STEP(B, op[5]);
            GD8_LD(B, bk, bv, gs, 7 * GB); GD8_WAIT(A); GD8_STEP(A, op[6]); GD8_LD(A, nbk, nbv, ngs, 0); GD8_WAIT(B); GD8_STEP(B, op[7]);
            OB[(size_t)(gb * TP + ci * CH + l8) * GW + gh * GH + col] = transpose_reduce8(op, l8);
        }
        const float Sv[16] = {G0.x, G0.y, G1.x, G1.y, G2.x, G2.y, G3.x, G3.y, G4.x, G4.y, G5.x, G5.y, G6.x, G6.y, G7.x, G7.y};
#pragma unroll
        for (int j = 0; j < 16; ++j) outSG[((size_t)gbh * GH + l8 * 16 + j) * GH + col] = Sv[j];
    }
    asm volatile("s_waitcnt vmcnt(0) lgkmcnt(0)" ::: "memory"); __builtin_amdgcn_s_barrier(); asm volatile("" ::: "memory");
#undef SP_ISSUE
#undef SP_TOP
}
__device__ __forceinline__ void gdn_sample_item(LAS float* scr, const float* GS, const float* S0, bf16_t* OB, float* outS, int item, int lane) {
    const int bh = item >> 2, qd = item & 3, b = bh >> 4, h = bh & 15, hf = lane >> 5, col = qd * 32 + (lane & 31);
    const float* rec = GS + ((size_t)BP * GHEADS * TP + (size_t)bh * TS) * GREC;
#pragma unroll
    for (int i = 0; i < 25; ++i) scr[i * 64 + lane] = rec[i * 64 + lane];
    float S[64];
    const float* s0 = S0 + ((size_t)bh * GH + hf * 64) * GH + col;
#pragma unroll
    for (int j = 0; j < 64; ++j) S[j] = s0[(size_t)j * GH];
    asm volatile("s_waitcnt lgkmcnt(0)" ::: "memory");
#pragma unroll
    for (int t = 0; t < 4; ++t) { const LAS float* r = scr + t * GREC;
        float ks = 0.f, qs = 0.f;
#pragma unroll
        for (int j4 = 0; j4 < 16; ++j4) { const f32x4 q4 = *(const LAS f32x4*)(r + hf * 64 + j4 * 4), k4 = *(const LAS f32x4*)(r + 128 + hf * 64 + j4 * 4);
            ks += S[j4 * 4] * k4.x + S[j4 * 4 + 1] * k4.y + S[j4 * 4 + 2] * k4.z + S[j4 * 4 + 3] * k4.w; qs += S[j4 * 4] * q4.x + S[j4 * 4 + 1] * q4.y + S[j4 * 4 + 2] * q4.z + S[j4 * 4 + 3] * q4.w; }
        ks += __shfl_xor(ks, 32); qs += __shfl_xor(qs, 32);
        const float vv = r[256 + col]; const f32x4 sc = *(const LAS f32x4*)(r + 384);
        const float u = sc.y * (vv - sc.x * ks), oo = sc.x * qs + sc.z * u;
#pragma unroll
        for (int j4 = 0; j4 < 16; ++j4) { const f32x4 k4 = *(const LAS f32x4*)(r + 128 + hf * 64 + j4 * 4);
            S[j4 * 4] = sc.x * S[j4 * 4] + k4.x * u; S[j4 * 4 + 1] = sc.x * S[j4 * 4 + 1] + k4.y * u; S[j4 * 4 + 2] = sc.x * S[j4 * 4 + 2] + k4.z * u; S[j4 * 4 + 3] = sc.x * S[j4 * 4 + 3] + k4.w * u; }
        if (hf == 0) OB[(size_t)(NPROMPT + b * TS + t) * GW + h * GH + col] = (bf16_t)cvt2(oo, 0.f); }
    float* so = outS + ((size_t)bh * GH + hf * 64) * GH + col;
#pragma unroll
    for (int j = 0; j < 64; ++j) so[(size_t)j * GH] = S[j];
    asm volatile("s_waitcnt lgkmcnt(0)" ::: "memory");
}

typedef float f32x16 __attribute__((ext_vector_type(16)));
__device__ __forceinline__ int rowperm(int reg, int h) { return (reg & 3) + 8 * (reg >> 2) + 4 * h; }
typedef __bf16 bf16x2n __attribute__((ext_vector_type(2)));
__device__ __forceinline__ unsigned cvt2(float lo, float hi) { const f32x2 v = (f32x2){lo, hi}; return __builtin_bit_cast(unsigned, __builtin_convertvector(v, bf16x2n)); }
__device__ __forceinline__ bf16x8 pack8(f32x4 a, f32x4 b) { u32x4 w; w.x = cvt2(a.x, a.y); w.y = cvt2(a.z, a.w); w.z = cvt2(b.x, b.y); w.w = cvt2(b.z, b.w); return __builtin_bit_cast(bf16x8, w); }
#define MFMA32(a, b, c) __builtin_amdgcn_mfma_f32_32x32x16_bf16(a, b, c, 0, 0, 0)
constexpr int CK_WK = 0, CK_QG = 8192, CK_KT = 16384, CK_ATT = 24576, CK_FR = 26624, CK_UB = 8192, NCHUNK = BP * GHEADS * (TP / 32);
static_assert((size_t)NCHUNK * (CK_FR + CK_UB) <= (size_t)MTOK * D * 4, "chunk data fits the y region of d_out");
__device__ __forceinline__ void gdn_chunk_prep(LAS unsigned char* wl, const unsigned char* chunk, unsigned char* fr, unsigned char* ub, float* cdp, int lane) {
    const int r = lane & 31, h = lane >> 5;
    LAS bf16_t* kL = (LAS bf16_t*)wl; LAS float* Lm = (LAS float*)(wl + 8192); LAS float* gL = (LAS float*)(wl + 12288);
    const unsigned char* rec = chunk + r * GRB;
    const f32x4 scv = *(const f32x4*)(rec + 768); const float beta_r = scv.y, la_r = scv.w;
    float g = la_r;
#pragma unroll
    for (int d = 1; d < 32; d <<= 1) { const float t = __shfl_up(g, d, 32); if (r >= d) g += t; }
    const float glast = __shfl(g, 31, 32), e_r = __expf(g);
    if (h == 0) { gL[r] = g; gL[32 + r] = beta_r; gL[64 + r] = e_r * beta_r; gL[96 + r] = __expf(glast - g); }
    if (lane == 0) *cdp = __expf(glast);
    f32x16 d1;
#pragma unroll
    for (int i = 0; i < 16; ++i) d1[i] = 0.f;
#pragma unroll
    for (int blk = 0; blk < 8; ++blk) {
        const u32x2 ka = *(const u32x2*)(rec + 256 + 2 * (16 * blk + 4 * h)), kb4 = *(const u32x2*)(rec + 256 + 2 * (16 * blk + 8 + 4 * h));
        const bf16x8 kf = __builtin_bit_cast(bf16x8, (u32x4){ka.x, ka.y, kb4.x, kb4.y});
        *(LAS u32x2*)(kL + r * 128 + 16 * blk + 4 * h) = ka; *(LAS u32x2*)(kL + r * 128 + 16 * blk + 8 + 4 * h) = kb4;
        d1 = MFMA32(kf, kf, d1);
        if (blk & 1) asm volatile("" ::: "memory"); }
#pragma unroll
    for (int reg = 0; reg < 16; ++reg) { const int i = rowperm(reg, h); const float ex = (i > r) ? gL[i] - g : -1e30f; Lm[i * 32 + r] = d1[reg] * gL[32 + i] * __expf(ex); }
    for (int i = 0; i < 32; ++i) { float acc = (i == r) ? 1.f : 0.f;
        const int n4 = (i + 3) >> 2;
#pragma unroll 8
        for (int m4 = 0; m4 < n4; ++m4) { const f32x4 l4 = *(const LAS f32x4*)(Lm + i * 32 + 4 * m4);
            acc -= l4.x * Lm[(4 * m4) * 32 + r] + l4.y * Lm[(4 * m4 + 1) * 32 + r] + l4.z * Lm[(4 * m4 + 2) * 32 + r] + l4.w * Lm[(4 * m4 + 3) * 32 + r]; }
        Lm[i * 32 + r] = acc; }
    bf16x8 tmf[2];
#pragma unroll
    for (int s = 0; s < 2; ++s) tmf[s] = pack8(*(const LAS f32x4*)(Lm + r * 32 + 16 * s + 8 * h), *(const LAS f32x4*)(Lm + r * 32 + 16 * s + 8 * h + 4));
    { bf16x8 vf[4][2];
      const unsigned char* vb = chunk + (size_t)(8 * h) * GRB + 512 + 2 * r; const LAS float* bl = gL + 32 + 8 * h;
#pragma unroll
      for (int s = 0; s < 2; ++s) { float x[4][8];
#pragma unroll
          for (int jj = 0; jj < 8; ++jj) { const unsigned char* vp = vb + (16 * s + jj) * GRB; const float bt = bl[16 * s + jj];
#pragma unroll
              for (int sl = 0; sl < 4; ++sl) x[sl][jj] = bf2f(*(const unsigned short*)(vp + 64 * sl)) * bt; }
#pragma unroll
          for (int sl = 0; sl < 4; ++sl) vf[sl][s] = pack8((f32x4){x[sl][0], x[sl][1], x[sl][2], x[sl][3]}, (f32x4){x[sl][4], x[sl][5], x[sl][6], x[sl][7]});
          asm volatile("" ::: "memory"); }
#pragma unroll
      for (int sl = 0; sl < 4; ++sl) { f32x16 u;
#pragma unroll
          for (int i = 0; i < 16; ++i) u[i] = 0.f;
          u = MFMA32(tmf[0], vf[sl][0], u); u = MFMA32(tmf[1], vf[sl][1], u);
          ((bf16x8*)ub)[(sl * 64 + lane) * 2] = pack8((f32x4){u[0], u[1], u[2], u[3]}, (f32x4){u[4], u[5], u[6], u[7]});
          ((bf16x8*)ub)[(sl * 64 + lane) * 2 + 1] = pack8((f32x4){u[8], u[9], u[10], u[11]}, (f32x4){u[12], u[13], u[14], u[15]}); }
      asm volatile("" ::: "memory"); }
    f32x16 d2;
#pragma unroll
    for (int i = 0; i < 16; ++i) d2[i] = 0.f;
#pragma unroll
    for (int blk = 0; blk < 8; ++blk) {
        const u32x2 qaw = *(const u32x2*)(rec + 2 * (16 * blk + 4 * h)), qbw = *(const u32x2*)(rec + 2 * (16 * blk + 8 + 4 * h));
        const u32x2 k0 = *(const LAS u32x2*)(kL + r * 128 + 16 * blk + 4 * h), k1 = *(const LAS u32x2*)(kL + r * 128 + 16 * blk + 8 + 4 * h);
        d2 = MFMA32(__builtin_bit_cast(bf16x8, (u32x4){k0.x, k0.y, k1.x, k1.y}), __builtin_bit_cast(bf16x8, (u32x4){qaw.x, qaw.y, qbw.x, qbw.y}), d2);
        const f32x4 qa = (f32x4){bflo(qaw.x), bfhi(qaw.x), bflo(qaw.y), bfhi(qaw.y)}, qb = (f32x4){bflo(qbw.x), bfhi(qbw.x), bflo(qbw.y), bfhi(qbw.y)};
        ((bf16x8*)(fr + CK_QG))[blk * 64 + lane] = pack8(qa * e_r, qb * e_r);
        if (blk & 1) asm volatile("" ::: "memory"); }
#pragma unroll
    for (int s = 0; s < 2; ++s) { float x[8];
#pragma unroll
        for (int jj = 0; jj < 8; ++jj) { const int j = rowperm(8 * s + jj, h); const float ex = (r >= j) ? g - gL[j] : -1e30f; x[jj] = d2[8 * s + jj] * __expf(ex); }
        ((bf16x8*)(fr + CK_ATT))[s * 64 + lane] = pack8((f32x4){x[0], x[1], x[2], x[3]}, (f32x4){x[4], x[5], x[6], x[7]}); }
    asm volatile("" ::: "memory");
#pragma unroll
    for (int kb = 0; kb < 4; ++kb) { f32x16 wv;
#pragma unroll
        for (int i = 0; i < 16; ++i) wv[i] = 0.f;
#pragma unroll
        for (int s = 0; s < 2; ++s) { float x[8];
#pragma unroll
            for (int jj = 0; jj < 8; ++jj) { const int tok = 16 * s + 8 * h + jj; x[jj] = bf2f(kL[tok * 128 + 32 * kb + r]) * gL[64 + tok]; }
            wv = MFMA32(pack8((f32x4){x[0], x[1], x[2], x[3]}, (f32x4){x[4], x[5], x[6], x[7]}), tmf[s], wv); }
#pragma unroll
        for (int s = 0; s < 2; ++s) { ((bf16x8*)(fr + CK_WK))[(kb * 2 + s) * 64 + lane] = pack8((f32x4){-wv[8 * s], -wv[8 * s + 1], -wv[8 * s + 2], -wv[8 * s + 3]}, (f32x4){-wv[8 * s + 4], -wv[8 * s + 5], -wv[8 * s + 6], -wv[8 * s + 7]});
            float x[8];
#pragma unroll
            for (int jj = 0; jj < 8; ++jj) { const int tok = rowperm(8 * s + jj, h); x[jj] = bf2f(kL[tok * 128 + 32 * kb + r]) * gL[96 + tok]; }
            ((bf16x8*)(fr + CK_KT))[(kb * 2 + s) * 64 + lane] = pack8((f32x4){x[0], x[1], x[2], x[3]}, (f32x4){x[4], x[5], x[6], x[7]}); }
        asm volatile("" ::: "memory"); }
    asm volatile("s_waitcnt lgkmcnt(0)" ::: "memory");
}
__device__ __forceinline__ void gdn_mfma_wave(const unsigned char* FR, const unsigned char* UB, const float* CD, bf16_t* OB, float* outS, int witem, int lane) {
    const int bh = witem >> 2, sl = witem & 3, b = bh >> 4, hh = bh & 15, r = lane & 31, h = lane >> 5;
    f32x16 S[4];
#pragma unroll
    for (int kb = 0; kb < 4; ++kb)
#pragma unroll
        for (int i = 0; i < 16; ++i) S[kb][i] = 0.f;
    for (int cc = 0; cc < TP / 32; ++cc) {
        const int ch = bh * (TP / 32) + cc;
        const unsigned char* ck = FR + (size_t)ch * CK_FR;
        const float cd = CD[ch];
        f32x16 vn, o;
        { const u32x4 u0 = ((const u32x4*)(UB + (size_t)ch * CK_UB))[(sl * 64 + lane) * 2], u1 = ((const u32x4*)(UB + (size_t)ch * CK_UB))[(sl * 64 + lane) * 2 + 1];
          vn[0] = bflo(u0.x); vn[1] = bfhi(u0.x); vn[2] = bflo(u0.y); vn[3] = bfhi(u0.y); vn[4] = bflo(u0.z); vn[5] = bfhi(u0.z); vn[6] = bflo(u0.w); vn[7] = bfhi(u0.w);
          vn[8] = bflo(u1.x); vn[9] = bfhi(u1.x); vn[10] = bflo(u1.y); vn[11] = bfhi(u1.y); vn[12] = bflo(u1.z); vn[13] = bfhi(u1.z); vn[14] = bflo(u1.w); vn[15] = bfhi(u1.w); }
#pragma unroll
        for (int reg = 0; reg < 16; ++reg) o[reg] = 0.f;
#pragma unroll
        for (int kb = 0; kb < 4; ++kb)
#pragma unroll
            for (int s = 0; s < 2; ++s) { const bf16x8 sf = pack8((f32x4){S[kb][8 * s], S[kb][8 * s + 1], S[kb][8 * s + 2], S[kb][8 * s + 3]}, (f32x4){S[kb][8 * s + 4], S[kb][8 * s + 5], S[kb][8 * s + 6], S[kb][8 * s + 7]});
                vn = MFMA32(((const bf16x8*)(ck + CK_WK))[(kb * 2 + s) * 64 + lane], sf, vn); o = MFMA32(((const bf16x8*)(ck + CK_QG))[(kb * 2 + s) * 64 + lane], sf, o); }
        bf16x8 vf[2];
#pragma unroll
        for (int s = 0; s < 2; ++s) { vf[s] = pack8((f32x4){vn[8 * s], vn[8 * s + 1], vn[8 * s + 2], vn[8 * s + 3]}, (f32x4){vn[8 * s + 4], vn[8 * s + 5], vn[8 * s + 6], vn[8 * s + 7]});
            o = MFMA32(((const bf16x8*)(ck + CK_ATT))[s * 64 + lane], vf[s], o); }
#pragma unroll
        for (int kb = 0; kb < 4; ++kb) { S[kb] = S[kb] * cd;
#pragma unroll
            for (int s = 0; s < 2; ++s) S[kb] = MFMA32(((const bf16x8*)(ck + CK_KT))[(kb * 2 + s) * 64 + lane], vf[s], S[kb]); }
#pragma unroll
        for (int reg = 0; reg < 16; ++reg) OB[(size_t)(b * TP + cc * 32 + rowperm(reg, h)) * GW + hh * GH + sl * 32 + r] = (bf16_t)cvt2(o[reg], 0.f);
    }
#pragma unroll
    for (int kb = 0; kb < 4; ++kb)
#pragma unroll
        for (int reg = 0; reg < 16; ++reg) outS[((size_t)bh * GH + 32 * kb + rowperm(reg, h)) * GH + sl * 32 + r] = S[kb][reg];
}
constexpr int RK_WC = 0, RK_RG = 4096, RK_ARB = 8192, RK_BT = 10240, RK_ARK = 14336, RK_KPT = 16384, RK_UC = 20480, RK_BYTES = 24576, NRCHUNK = BP * RHEADS * (TP / 32);
static_assert(68 * MiB + (size_t)NRCHUNK * RK_BYTES <= (size_t)BP * RHEADS * TP * RREC * 4 && (size_t)BP * RHEADS * TP * RH * 4 <= 68 * MiB, "VCH and the RWKV chunk data fit the prompt part of the RSCAN region");
__device__ __forceinline__ bf16x8 words8(unsigned a, unsigned b, unsigned c, unsigned d) { return __builtin_bit_cast(bf16x8, (u32x4){a, b, c, d}); }
struct RwPrepIn { const bf16_t* P; const bf16_t* LWAG; const float* mu; const float* kkw; const float* kaw; const float* rkw; float* BON; unsigned char* VF; };
__device__ __forceinline__ f32x4 mix4(u32x2 c, u32x2 p, f32x4 m) { const f32x4 cv = (f32x4){bflo(c.x), bfhi(c.x), bflo(c.y), bfhi(c.y)}, pv = (f32x4){bflo(p.x), bfhi(p.x), bflo(p.y), bfhi(p.y)}; return cv + (pv - cv) * m; }
__device__ __forceinline__ void rwkv_chunk_prep(LAS unsigned char* wl, const RwPrepIn& I, int bh, int cc, unsigned char* rk, float* gc, int lane) {
    int r = lane & 31, h = lane >> 5;
    asm volatile("" : "+v"(r), "+v"(h));
    LAS bf16_t* KKgL = (LAS bf16_t*)wl; LAS bf16_t* BTL = (LAS bf16_t*)(wl + 4096); LAS bf16_t* KpTL = (LAS bf16_t*)(wl + 8192); LAS float* Lm = (LAS float*)(wl + 12288);
    const int b = bh >> 5, hh = bh & 31, t = cc * 32 + r, m = b * TP + t, cb = hh * RH; const bool hp = t > 0;
    const bf16_t* cur = I.P + (size_t)m * LDP + cb; const bf16_t* lw = I.LWAG + (size_t)m * LORA_N + cb;
    float ss = 0.f;
#pragma unroll
    for (int blk = 0; blk < 4; ++blk) {
#pragma unroll
        for (int q = 0; q < 2; ++q) { const int c = 16 * blk + 4 * h + 8 * q;
            const u32x2 kc = *(const u32x2*)(cur + RW + c), kp = hp ? *(const u32x2*)(cur - LDP + RW + c) : (u32x2){0u, 0u};
            const f32x4 kr = mix4(kc, kp, *(const f32x4*)(I.mu + RW + cb + c)) * *(const f32x4*)(I.kkw + cb + c); ss += kr.x * kr.x + kr.y * kr.y + kr.z * kr.z + kr.w * kr.w; } }
    asm volatile("" ::: "memory");
    ss += __shfl_xor(ss, 32);
    const float rinv = __builtin_amdgcn_rsqf(ss + 1e-6f); float bon = 0.f;
    f32x16 g1, g2, g3, g4;
#pragma unroll
    for (int i = 0; i < 16; ++i) { g1[i] = 0.f; g2[i] = 0.f; g3[i] = 0.f; g4[i] = 0.f; }
    u32x2 nw0, nw1, na0, na1, nrc0, nrp0, nrc1, nrp1, nkc0, nkp0, nkc1, nkp1;
#define RWP_LOAD(bq) do { const int c0_ = 16 * (bq) + 4 * h, c1_ = c0_ + 8; const u32x2 z_ = (u32x2){0u, 0u}; \
        nw0 = *(const u32x2*)(lw + c0_); nw1 = *(const u32x2*)(lw + c1_); na0 = *(const u32x2*)(lw + RW + c0_); na1 = *(const u32x2*)(lw + RW + c1_); \
        nrc0 = *(const u32x2*)(cur + c0_); nrp0 = hp ? *(const u32x2*)(cur - LDP + c0_) : z_; nrc1 = *(const u32x2*)(cur + c1_); nrp1 = hp ? *(const u32x2*)(cur - LDP + c1_) : z_; \
        nkc0 = *(const u32x2*)(cur + RW + c0_); nkp0 = hp ? *(const u32x2*)(cur - LDP + RW + c0_) : z_; nkc1 = *(const u32x2*)(cur + RW + c1_); nkp1 = hp ? *(const u32x2*)(cur - LDP + RW + c1_) : z_; } while (0)
    RWP_LOAD(0);
#pragma unroll 1
    for (int blk = 0; blk < 4; ++blk) {
        const int c0 = 16 * blk + 4 * h, c1 = c0 + 8;
        const u32x2 qw0 = nw0, qw1 = nw1, qa0 = na0, qa1 = na1, qrc0 = nrc0, qrp0 = nrp0, qrc1 = nrc1, qrp1 = nrp1, qkc0 = nkc0, qkp0 = nkp0, qkc1 = nkc1, qkp1 = nkp1;
        { const int bn = blk < 3 ? blk + 1 : 3; RWP_LOAD(bn); }
        const f32x4 w0 = cvt4(qw0), w1 = cvt4(qw1);
        const float wv8[8] = {w0.x, w0.y, w0.z, w0.w, w1.x, w1.y, w1.z, w1.w};
        float ep[8], en[8], eg[8], el[8], eG[8];
#pragma unroll
        for (int e = 0; e < 8; ++e) { float x = wv8[e];
            x += dppf<0x111>(x); x += dppf<0x112>(x); x += dppf<0x114>(x); x += dppf<0x118>(x);
            x += __builtin_bit_cast(float, __builtin_amdgcn_update_dpp(0, __builtin_bit_cast(int, x), 0x142, 0xa, 0xf, false));
            eg[e] = __expf(x); en[e] = __builtin_amdgcn_rcpf(eg[e]); ep[e] = eg[e] * __expf(-wv8[e]);
            eG[e] = __shfl(eg[e], 31, 32); el[e] = eG[e] * en[e]; }
        const f32x4 a0 = cvt4(qa0), a1 = cvt4(qa1);
        const f32x4 r0 = mix4(qrc0, qrp0, *(const f32x4*)(I.mu + cb + c0));
        const f32x4 r1 = mix4(qrc1, qrp1, *(const f32x4*)(I.mu + cb + c1));
        const f32x4 kx0 = mix4(qkc0, qkp0, *(const f32x4*)(I.mu + RW + cb + c0));
        const f32x4 kx1 = mix4(qkc1, qkp1, *(const f32x4*)(I.mu + RW + cb + c1));
        const f32x4 k0 = kx0 * *(const f32x4*)(I.kkw + cb + c0) * rinv, k1 = kx1 * *(const f32x4*)(I.kkw + cb + c1) * rinv;
        const f32x4 p0 = kx0 * ((a0 - 1.0f) * *(const f32x4*)(I.kaw + cb + c0) + 1.0f), p1 = kx1 * ((a1 - 1.0f) * *(const f32x4*)(I.kaw + cb + c1) + 1.0f);
        const f32x4 b0 = k0 * a0, b1 = k1 * a1;
        { const f32x4 q0 = r0 * p0 * *(const f32x4*)(I.rkw + cb + c0), q1 = r1 * p1 * *(const f32x4*)(I.rkw + cb + c1); bon += (q0.x + q0.y + q0.z + q0.w) + (q1.x + q1.y + q1.z + q1.w); }
        const bf16x8 kkg_ = pack8((f32x4){k0.x * ep[0], k0.y * ep[1], k0.z * ep[2], k0.w * ep[3]}, (f32x4){k1.x * ep[4], k1.y * ep[5], k1.z * ep[6], k1.w * ep[7]});
        const bf16x8 bi_ = pack8((f32x4){b0.x * en[0], b0.y * en[1], b0.z * en[2], b0.w * en[3]}, (f32x4){b1.x * en[4], b1.y * en[5], b1.z * en[6], b1.w * en[7]});
        const bf16x8 kpi_ = pack8((f32x4){p0.x * en[0], p0.y * en[1], p0.z * en[2], p0.w * en[3]}, (f32x4){p1.x * en[4], p1.y * en[5], p1.z * en[6], p1.w * en[7]});
        const bf16x8 rg_ = pack8((f32x4){r0.x * eg[0], r0.y * eg[1], r0.z * eg[2], r0.w * eg[3]}, (f32x4){r1.x * eg[4], r1.y * eg[5], r1.z * eg[6], r1.w * eg[7]});
        const bf16x8 btf = pack8((f32x4){-b0.x * el[0], -b0.y * el[1], -b0.z * el[2], -b0.w * el[3]}, (f32x4){-b1.x * el[4], -b1.y * el[5], -b1.z * el[6], -b1.w * el[7]});
        const bf16x8 ktf = pack8((f32x4){p0.x * el[0], p0.y * el[1], p0.z * el[2], p0.w * el[3]}, (f32x4){p1.x * el[4], p1.y * el[5], p1.z * el[6], p1.w * el[7]});
        const u32x4 kw = __builtin_bit_cast(u32x4, kkg_), bw = __builtin_bit_cast(u32x4, btf), pw = __builtin_bit_cast(u32x4, ktf);
        *(LAS u32x2*)(KKgL + r * 64 + c0) = (u32x2){kw.x, kw.y}; *(LAS u32x2*)(KKgL + r * 64 + c1) = (u32x2){kw.z, kw.w};
        *(LAS u32x2*)(BTL + r * 64 + c0) = (u32x2){bw.x, bw.y}; *(LAS u32x2*)(BTL + r * 64 + c1) = (u32x2){bw.z, bw.w};
        *(LAS u32x2*)(KpTL + r * 64 + c0) = (u32x2){pw.x, pw.y}; *(LAS u32x2*)(KpTL + r * 64 + c1) = (u32x2){pw.z, pw.w};
        ((bf16x8*)(rk + RK_RG))[blk * 64 + lane] = rg_;
        g1 = MFMA32(kkg_, bi_, g1); g2 = MFMA32(kpi_, kkg_, g2); g3 = MFMA32(bi_, rg_, g3); g4 = MFMA32(kpi_, rg_, g4);
        if (r == 31) { *(f32x4*)(gc + c0) = (f32x4){eG[0], eG[1], eG[2], eG[3]}; *(f32x4*)(gc + c1) = (f32x4){eG[4], eG[5], eG[6], eG[7]}; }
        asm volatile("" ::: "memory"); }
    bon += __shfl_xor(bon, 32);
    if (h == 0) I.BON[(size_t)m * RHEADS + hh] = bon;
#pragma unroll
    for (int reg = 0; reg < 16; ++reg) { const int t = rowperm(reg, h); Lm[t * 32 + r] = (t > r) ? g1[reg] : 0.f; }
    bf16x8 akkT[2];
#pragma unroll
    for (int s = 0; s < 2; ++s) { float x[8], y[8], z[8];
#pragma unroll
        for (int jj = 0; jj < 8; ++jj) { const int i = rowperm(8 * s + jj, h); x[jj] = (i < r) ? g2[8 * s + jj] : 0.f; y[jj] = (i <= r) ? -g3[8 * s + jj] : 0.f; z[jj] = (i <= r) ? g4[8 * s + jj] : 0.f; }
        akkT[s] = pack8((f32x4){x[0], x[1], x[2], x[3]}, (f32x4){x[4], x[5], x[6], x[7]});
        ((bf16x8*)(rk + RK_ARB))[s * 64 + lane] = pack8((f32x4){y[0], y[1], y[2], y[3]}, (f32x4){y[4], y[5], y[6], y[7]});
        ((bf16x8*)(rk + RK_ARK))[s * 64 + lane] = pack8((f32x4){z[0], z[1], z[2], z[3]}, (f32x4){z[4], z[5], z[6], z[7]}); }
    for (int i = 0; i < 32; ++i) { float acc = (i == r) ? 1.f : 0.f;
        const int n4 = (i + 3) >> 2;
#pragma unroll 8
        for (int m4 = 0; m4 < n4; ++m4) { const f32x4 l4 = *(const LAS f32x4*)(Lm + i * 32 + 4 * m4);
            acc -= l4.x * Lm[(4 * m4) * 32 + r] + l4.y * Lm[(4 * m4 + 1) * 32 + r] + l4.z * Lm[(4 * m4 + 2) * 32 + r] + l4.w * Lm[(4 * m4 + 3) * 32 + r]; }
        Lm[i * 32 + r] = acc; }
    bf16x8 tn[2], tp[2];
#pragma unroll
    for (int s = 0; s < 2; ++s) { tn[s] = pack8(*(const LAS f32x4*)(Lm + r * 32 + 16 * s + 8 * h), *(const LAS f32x4*)(Lm + r * 32 + 16 * s + 8 * h + 4));
        tp[s] = pack8(*(const LAS f32x4*)(Lm + r * 32 + 16 * s + 4 * h), *(const LAS f32x4*)(Lm + r * 32 + 16 * s + 8 + 4 * h)); }
#pragma unroll
    for (int kb = 0; kb < 2; ++kb) { f32x16 wv;
#pragma unroll
        for (int i = 0; i < 16; ++i) wv[i] = 0.f;
#pragma unroll
        for (int s = 0; s < 2; ++s) { unsigned wds[4];
#pragma unroll
            for (int j2 = 0; j2 < 4; ++j2) { const int t0 = 16 * s + 8 * h + 2 * j2; wds[j2] = (unsigned)KKgL[t0 * 64 + 32 * kb + r] | ((unsigned)KKgL[(t0 + 1) * 64 + 32 * kb + r] << 16); }
            wv = MFMA32(words8(wds[0], wds[1], wds[2], wds[3]), tn[s], wv); }
#pragma unroll
        for (int s = 0; s < 2; ++s) { ((bf16x8*)(rk + RK_WC))[(kb * 2 + s) * 64 + lane] = pack8((f32x4){wv[8 * s], wv[8 * s + 1], wv[8 * s + 2], wv[8 * s + 3]}, (f32x4){wv[8 * s + 4], wv[8 * s + 5], wv[8 * s + 6], wv[8 * s + 7]});
            unsigned bwd[4], pwd[4];
#pragma unroll
            for (int j2 = 0; j2 < 4; ++j2) { const int ta = rowperm(8 * s + 2 * j2, h), tb = rowperm(8 * s + 2 * j2 + 1, h);
                bwd[j2] = (unsigned)BTL[ta * 64 + 32 * kb + r] | ((unsigned)BTL[tb * 64 + 32 * kb + r] << 16); pwd[j2] = (unsigned)KpTL[ta * 64 + 32 * kb + r] | ((unsigned)KpTL[tb * 64 + 32 * kb + r] << 16); }
            ((bf16x8*)(rk + RK_BT))[(kb * 2 + s) * 64 + lane] = words8(bwd[0], bwd[1], bwd[2], bwd[3]);
            ((bf16x8*)(rk + RK_KPT))[(kb * 2 + s) * 64 + lane] = words8(pwd[0], pwd[1], pwd[2], pwd[3]); }
        asm volatile("" ::: "memory"); }
    { const bf16_t* vcol = I.P + (size_t)(b * TP + cc * 32 + 4 * h) * LDP + 2 * RW + cb + r; unsigned char* vfp = I.VF + ((size_t)bh * (TP / 32) + cc) * 4096;
#pragma unroll
      for (int sl = 0; sl < 2; ++sl) { f32x16 av; const float muv = I.mu[2 * RW + cb + 32 * sl + r];
#pragma unroll
          for (int i = 0; i < 16; ++i) av[i] = 0.f;
#pragma unroll
          for (int s = 0; s < 2; ++s) { float x[8];
#pragma unroll
              for (int g4 = 0; g4 < 2; ++g4) { const int tk = 8 * g4 + 16 * s;
                  float pv = (cc > 0 || 4 * h + tk > 0) ? bf2f(vcol[(ptrdiff_t)(tk - 1) * LDP + 32 * sl]) : 0.f;
#pragma unroll
                  for (int j = 0; j < 4; ++j) { const float cv = bf2f(vcol[(size_t)(tk + j) * LDP + 32 * sl]); x[4 * g4 + j] = cv + (pv - cv) * muv; pv = cv; } }
              const bf16x8 vf_ = pack8((f32x4){x[0], x[1], x[2], x[3]}, (f32x4){x[4], x[5], x[6], x[7]});
              ((bf16x8*)vfp)[(sl * 2 + s) * 64 + lane] = vf_;
              av = MFMA32(akkT[s], vf_, av); }
          f32x16 uc;
#pragma unroll
          for (int i = 0; i < 16; ++i) uc[i] = 0.f;
#pragma unroll
          for (int s = 0; s < 2; ++s) uc = MFMA32(tp[s], pack8((f32x4){av[8 * s], av[8 * s + 1], av[8 * s + 2], av[8 * s + 3]}, (f32x4){av[8 * s + 4], av[8 * s + 5], av[8 * s + 6], av[8 * s + 7]}), uc);
          ((bf16x8*)(rk + RK_UC))[(sl * 64 + lane) * 2] = pack8((f32x4){uc[0], uc[1], uc[2], uc[3]}, (f32x4){uc[4], uc[5], uc[6], uc[7]});
          ((bf16x8*)(rk + RK_UC))[(sl * 64 + lane) * 2 + 1] = pack8((f32x4){uc[8], uc[9], uc[10], uc[11]}, (f32x4){uc[12], uc[13], uc[14], uc[15]});
          asm volatile("" ::: "memory"); } }
    asm volatile("s_waitcnt lgkmcnt(0)" ::: "memory");
}
__device__ __forceinline__ void rwkv_mfma_wave(const unsigned char* RKD, const float* GC, const unsigned char* VF, bf16_t* OA, float* outSR, int witem, int lane) {
    const int bh = witem >> 1, vs = witem & 1, b = bh >> 5, hh = bh & 31, r = lane & 31, h = lane >> 5;
    f32x16 Z[2];
#pragma unroll
    for (int kb = 0; kb < 2; ++kb)
#pragma unroll
        for (int i = 0; i < 16; ++i) Z[kb][i] = 0.f;
    for (int cc = 0; cc < TP / 32; ++cc) {
        const int ch = bh * (TP / 32) + cc;
        const unsigned char* rk = RKD + (size_t)ch * RK_BYTES;
        const float* gcp = GC + (size_t)ch * 64 + 4 * h;
        f32x16 c, o;
        { const u32x4 u0 = ((const u32x4*)(rk + RK_UC))[(vs * 64 + lane) * 2], u1 = ((const u32x4*)(rk + RK_UC))[(vs * 64 + lane) * 2 + 1];
          c[0] = bflo(u0.x); c[1] = bfhi(u0.x); c[2] = bflo(u0.y); c[3] = bfhi(u0.y); c[4] = bflo(u0.z); c[5] = bfhi(u0.z); c[6] = bflo(u0.w); c[7] = bfhi(u0.w);
          c[8] = bflo(u1.x); c[9] = bfhi(u1.x); c[10] = bflo(u1.y); c[11] = bfhi(u1.y); c[12] = bflo(u1.z); c[13] = bfhi(u1.z); c[14] = bflo(u1.w); c[15] = bfhi(u1.w); }
#pragma unroll
        for (int i = 0; i < 16; ++i) o[i] = 0.f;
        bf16x8 vf[2];
#pragma unroll
        for (int s = 0; s < 2; ++s) vf[s] = ((const bf16x8*)(VF + (size_t)ch * 4096))[(vs * 2 + s) * 64 + lane];
#pragma unroll
        for (int kb = 0; kb < 2; ++kb)
#pragma unroll
            for (int s = 0; s < 2; ++s) { const bf16x8 zf = pack8((f32x4){Z[kb][8 * s], Z[kb][8 * s + 1], Z[kb][8 * s + 2], Z[kb][8 * s + 3]}, (f32x4){Z[kb][8 * s + 4], Z[kb][8 * s + 5], Z[kb][8 * s + 6], Z[kb][8 * s + 7]});
                c = MFMA32(((const bf16x8*)(rk + RK_WC))[(kb * 2 + s) * 64 + lane], zf, c); o = MFMA32(((const bf16x8*)(rk + RK_RG))[(kb * 2 + s) * 64 + lane], zf, o); }
        bf16x8 cf[2];
#pragma unroll
        for (int s = 0; s < 2; ++s) { cf[s] = pack8((f32x4){c[8 * s], c[8 * s + 1], c[8 * s + 2], c[8 * s + 3]}, (f32x4){c[8 * s + 4], c[8 * s + 5], c[8 * s + 6], c[8 * s + 7]});
            o = MFMA32(((const bf16x8*)(rk + RK_ARK))[s * 64 + lane], vf[s], o); o = MFMA32(((const bf16x8*)(rk + RK_ARB))[s * 64 + lane], cf[s], o); }
#pragma unroll
        for (int kb = 0; kb < 2; ++kb) {
#pragma unroll
            for (int reg = 0; reg < 16; ++reg) Z[kb][reg] *= gcp[32 * kb + (reg & 3) + 8 * (reg >> 2)];
#pragma unroll
            for (int s = 0; s < 2; ++s) { Z[kb] = MFMA32(((const bf16x8*)(rk + RK_KPT))[(kb * 2 + s) * 64 + lane], vf[s], Z[kb]); Z[kb] = MFMA32(((const bf16x8*)(rk + RK_BT))[(kb * 2 + s) * 64 + lane], cf[s], Z[kb]); } }
#pragma unroll
        for (int reg = 0; reg < 16; ++reg) OA[(size_t)(b * TP + cc * 32 + rowperm(reg, h)) * RW + hh * RH + vs * 32 + r] = (bf16_t)cvt2(o[reg], 0.f);
    }
#pragma unroll
    for (int kb = 0; kb < 2; ++kb)
#pragma unroll
        for (int reg = 0; reg < 16; ++reg) outSR[((size_t)bh * RH + vs * 32 + r) * RH + 32 * kb + rowperm(reg, h)] = Z[kb][reg];
}

__device__ __forceinline__ void spin_ge4(volatile LAS unsigned* p, unsigned need) {
    for (unsigned sp = 0;; ++sp) { const unsigned a = p[0], b = p[1], c = p[2], d = p[3]; if ((a >= need && b >= need && c >= need && d >= need) || sp > (1u << 24)) break; __builtin_amdgcn_s_sleep(1); }
}
struct Rw2 { f32x4 w4, kk4, b4, kp4, r4; float va, vb; };
#define RW2_LD(d, bk, bv, off) do { \
    asm volatile("ds_read_b128 %0, %1 offset:%2" : "=v"(d.w4) : "v"(bk), "n"((off))); asm volatile("ds_read_b128 %0, %1 offset:%2" : "=v"(d.kk4) : "v"(bk), "n"((off) + 256)); \
    asm volatile("ds_read_b128 %0, %1 offset:%2" : "=v"(d.b4) : "v"(bk), "n"((off) + 512)); asm volatile("ds_read_b128 %0, %1 offset:%2" : "=v"(d.kp4) : "v"(bk), "n"((off) + 768)); \
    asm volatile("ds_read_b128 %0, %1 offset:%2" : "=v"(d.r4) : "v"(bk), "n"((off) + 1024)); \
    asm volatile("ds_read_b32 %0, %1 offset:%2" : "=v"(d.va) : "v"(bv), "n"((off))); asm volatile("ds_read_b32 %0, %1 offset:%2" : "=v"(d.vb) : "v"(bv), "n"((off) + 16)); } while (0)
#define RW2_WAIT(d) do { asm volatile("s_waitcnt lgkmcnt(7)" : "+v"(d.w4), "+v"(d.kk4), "+v"(d.b4), "+v"(d.kp4), "+v"(d.r4), "+v"(d.va), "+v"(d.vb)); __builtin_amdgcn_sched_barrier(0); } while (0)
#define RW2_STEP(d, opa, opb) do { \
    f32x2 pa_ = A01 * LO2(d.kk4); pa_ = A23 * HI2(d.kk4) + pa_; f32x2 pb_ = B01 * LO2(d.kk4); pb_ = B23 * HI2(d.kk4) + pb_; \
    f32x2 ea0_ = LO2(d.kp4) * d.va, ea1_ = HI2(d.kp4) * d.va, eb0_ = LO2(d.kp4) * d.vb, eb1_ = HI2(d.kp4) * d.vb; \
    ea0_ = A01 * LO2(d.w4) + ea0_; ea1_ = A23 * HI2(d.w4) + ea1_; eb0_ = B01 * LO2(d.w4) + eb0_; eb1_ = B23 * HI2(d.w4) + eb1_; \
    const float nsa_ = -row16_sum(pa_.x + pa_.y), nsb_ = -row16_sum(pb_.x + pb_.y); \
    A01 = LO2(d.b4) * nsa_ + ea0_; A23 = HI2(d.b4) * nsa_ + ea1_; B01 = LO2(d.b4) * nsb_ + eb0_; B23 = HI2(d.b4) * nsb_ + eb1_; \
    f32x2 qa_ = A01 * LO2(d.r4); qa_ = A23 * HI2(d.r4) + qa_; f32x2 qb_ = B01 * LO2(d.r4); qb_ = B23 * HI2(d.r4) + qb_; opa = qa_.x + qa_.y; opb = qb_.x + qb_.y; } while (0)
__device__ __forceinline__ void rwkv_prompt_ring4(LAS unsigned char* ring, volatile LAS unsigned* cnt, const float* RS, float* OA, float* outSR, int item, int w, int lane) {
    constexpr int CH = 16, CHB = CH * RREC * 4  , NB = 4, NCH = TP / CH, RB = RREC * 4;
    const int rbh = item >> 1, half = item & 1, rb = rbh >> 5, rh = rbh & 31, rg = lane >> 4, kq = lane & 15, rowA = half * 32 + w * 8 + rg;
    const char* src = (const char*)(RS + (size_t)rbh * TP * RREC);
#define R4_ISSUE(ci) do { const int cs_ = (ci) < NCH ? (ci) : NCH - 1; const int sl_ = (ci) % NB; _Pragma("unroll") for (int i_ = 0; i_ < 6; ++i_) { const int pc_ = w * 6 + i_; \
        __builtin_amdgcn_global_load_lds((const unsigned*)(src + (size_t)cs_ * CHB + pc_ * 1024 + lane * 16), (LAS unsigned*)(ring + sl_ * CHB + pc_ * 1024), 16, 0, 0); } } while (0)
#pragma unroll
    for (int ci = 0; ci < NB - 1; ++ci) R4_ISSUE(ci);
    asm volatile("s_waitcnt vmcnt(12)" ::: "memory"); if (lane == 0) cnt[w] = 1u; spin_ge4(cnt, 1u);
    const unsigned lbase = (unsigned)(size_t)ring;
    f32x2 A01 = (f32x2){0.f, 0.f}, A23 = A01, B01 = A01, B23 = A01;
    Rw2 X, Y; RW2_LD(X, lbase + kq * 16, lbase + 1280 + rowA * 4, 0);
    for (int ci = 0; ci < NCH; ++ci) {
        asm volatile("s_waitcnt vmcnt(6)" ::: "memory"); if (lane == 0) cnt[w] = (unsigned)ci + 2u; spin_ge4(cnt, (unsigned)ci + 2u);
        spin_ge4(cnt + 4, (unsigned)ci);
        R4_ISSUE(ci + NB - 1);
        const unsigned sl = lbase + (ci % NB) * CHB, nsl = lbase + ((ci + 1) % NB) * CHB, bk = sl + kq * 16, bv = sl + 1280 + rowA * 4, nbk = nsl + kq * 16, nbv = nsl + 1280 + rowA * 4;
        float opa[16], opb[16];
#define R4_PAIR(st) do { RW2_LD(Y, bk, bv, ((st) + 1) * RB); RW2_WAIT(X); RW2_STEP(X, opa[st], opb[st]); RW2_LD(X, bk, bv, ((st) + 2) * RB); RW2_WAIT(Y); RW2_STEP(Y, opa[(st) + 1], opb[(st) + 1]); } while (0)
        R4_PAIR(0); R4_PAIR(2); R4_PAIR(4); R4_PAIR(6); R4_PAIR(8); R4_PAIR(10); R4_PAIR(12);
        RW2_LD(Y, bk, bv, 15 * RB); RW2_WAIT(X); RW2_STEP(X, opa[14], opb[14]); RW2_LD(X, nbk, nbv, 0); RW2_WAIT(Y); RW2_STEP(Y, opa[15], opb[15]);
#undef R4_PAIR
        float* orow = OA + (size_t)(rb * TP + ci * CH + kq) * RW + rh * RH + rowA;
        orow[0] = transpose_reduce16(opa, kq); orow[4] = transpose_reduce16(opb, kq);
        if (lane == 0) cnt[4 + w] = (unsigned)ci + 1u;
    }
    *(f32x4*)(outSR + ((size_t)rbh * RH + rowA) * RH + 4 * kq) = (f32x4){A01.x, A01.y, A23.x, A23.y};
    *(f32x4*)(outSR + ((size_t)rbh * RH + rowA + 4) * RH + 4 * kq) = (f32x4){B01.x, B01.y, B23.x, B23.y};
    asm volatile("s_waitcnt vmcnt(0) lgkmcnt(0)" ::: "memory");
#undef R4_ISSUE
}

__device__ __forceinline__ void adaln_skinny(LAS unsigned char* lds, const float* W, const bf16_t* A, const float* bias, float* MOD, int c, int w, int lane, int tid) {
    const int r = lane & 31, h = lane >> 5;
    LAS float* part = (LAS float*)lds;
    constexpr int NG = (D / 2) / 32, SLB = 160 * 80;
#define AD_BAR() do { asm volatile("s_waitcnt lgkmcnt(0)" ::: "memory"); __builtin_amdgcn_s_barrier(); asm volatile("" ::: "memory"); } while (0)
    if (w < 6) {
        const int j = w >> 1, kh = w & 1, n0 = (c * 3 + j) * 32, kb = kh * (D / 2);
        f32x16 acc[5];
#pragma unroll
        for (int sb = 0; sb < 5; ++sb)
#pragma unroll
            for (int i = 0; i < 16; ++i) acc[sb][i] = 0.f;
        const float* wp = W + (size_t)(kb + 8 * h) * NMOD + n0 + r;
        const LAS unsigned char* sl = lds + kh * 2 * SLB + r * 80 + h * 16;
        float x0[16], x1[16], x2[16], x3[16];
#define AD_LOADW(x, g) do { const float* p_ = wp + (size_t)(32 * (g)) * NMOD; _Pragma("unroll") for (int j_ = 0; j_ < 16; ++j_) x[j_] = p_[(size_t)((j_ >> 3) * 16 + (j_ & 7)) * NMOD]; } while (0)
#define AD_COMP(x, g) do { const LAS unsigned char* b_ = sl + ((g) & 1) * SLB; _Pragma("unroll") for (int q_ = 0; q_ < 2; ++q_) { \
        const bf16x8 wf_ = pack8((f32x4){x[q_ * 8], x[q_ * 8 + 1], x[q_ * 8 + 2], x[q_ * 8 + 3]}, (f32x4){x[q_ * 8 + 4], x[q_ * 8 + 5], x[q_ * 8 + 6], x[q_ * 8 + 7]}); \
        _Pragma("unroll") for (int sb_ = 0; sb_ < 5; ++sb_) acc[sb_] = MFMA32(wf_, *(const LAS bf16x8*)(b_ + sb_ * 32 * 80 + q_ * 32), acc[sb_]); } } while (0)
#define AD_SCHED() __builtin_amdgcn_sched_barrier(0)
        AD_LOADW(x0, 0); AD_LOADW(x1, 1); AD_LOADW(x2, 2);
        AD_BAR();
        for (int g = 0; g < NG; g += 4) {
            AD_LOADW(x3, g + 3); AD_SCHED(); AD_COMP(x0, g); AD_BAR(); AD_SCHED();
            { const int g2 = g + 4 < NG ? g + 4 : NG - 1; AD_LOADW(x0, g2); } AD_SCHED(); AD_COMP(x1, g + 1); AD_BAR(); AD_SCHED();
            { const int g2 = g + 5 < NG ? g + 5 : NG - 1; AD_LOADW(x1, g2); } AD_SCHED(); AD_COMP(x2, g + 2); AD_BAR(); AD_SCHED();
            { const int g2 = g + 6 < NG ? g + 6 : NG - 1; AD_LOADW(x2, g2); } AD_SCHED(); AD_COMP(x3, g + 3); AD_BAR(); AD_SCHED();
        }
#undef AD_LOADW
#undef AD_COMP
#pragma unroll
        for (int sb = 0; sb < 5; ++sb)
#pragma unroll
            for (int reg = 0; reg < 16; ++reg) part[(w * 160 + 32 * sb + r) * 33 + rowperm(reg, h)] = acc[sb][reg];
    } else {
        const int kh = w - 6;
        const bf16_t* ap = A + (size_t)(lane >> 2) * D + kh * (D / 2) + (lane & 3) * 8;
        LAS unsigned char* dst = lds + kh * 2 * SLB + (lane >> 2) * 80 + (lane & 3) * 16;
        u32x4 ra[10], rb[10];
#define AD_LOADA(rr, g) do { _Pragma("unroll") for (int i_ = 0; i_ < 10; ++i_) rr[i_] = *(const u32x4*)(ap + (size_t)(16 * i_) * D + 32 * (g)); } while (0)
#define AD_WRITEA(rr, g) do { _Pragma("unroll") for (int i_ = 0; i_ < 10; ++i_) *(LAS u32x4*)(dst + ((g) & 1) * SLB + i_ * 16 * 80) = rr[i_]; } while (0)
        AD_LOADA(ra, 0); AD_WRITEA(ra, 0); AD_LOADA(rb, 1);
        AD_BAR();
        for (int g = 0; g < NG; g += 2) {
            AD_WRITEA(rb, g + 1); { const int g2 = g + 2 < NG ? g + 2 : NG - 1; AD_LOADA(ra, g2); } AD_BAR();
            AD_WRITEA(ra, g + 2); { const int g2 = g + 3 < NG ? g + 3 : NG - 1; AD_LOADA(rb, g2); } AD_BAR();
        }
#undef AD_LOADA
#undef AD_WRITEA
    }
#undef AD_BAR
    __syncthreads();
    for (int i = tid; i < 3 * NSEQ * 32; i += NTHREADS) { const int j = i / (NSEQ * 32), q = i - j * (NSEQ * 32), sq = q >> 5, n = q & 31, col = (c * 3 + j) * 32 + n;
        MOD[(size_t)sq * NMOD + col] = part[((2 * j) * 160 + sq) * 33 + n] + part[((2 * j + 1) * 160 + sq) * 33 + n] + bias[col]; }
    __syncthreads();
}

__global__ void __launch_bounds__(NTHREADS, 2) fwd_kernel(Args args) {
    extern __shared__ __attribute__((aligned(16))) unsigned char lds_raw[];
    LAS unsigned char* lds = (LAS unsigned char*)lds_raw;
    volatile LAS unsigned* MISC = (volatile LAS unsigned*)(lds + MISC_OFF);
    const int tid = threadIdx.x, lane = tid & 63, wave = __builtin_amdgcn_readfirstlane(tid >> 6);
    const int G = gridDim.x, bx = blockIdx.x;
    const int vcu = (G % 8 == 0) ? (bx % 8) * (G / 8) + bx / 8 : bx;
    const int gw = vcu * NWAVES + wave, NGW = G * NWAVES;
    unsigned char* ws = args.ws;
    unsigned* ctl = (unsigned*)(ws + WS_CTL);
    for (int u = tid; u < (LDS_BYTES - RING_BYTES) / 4; u += NTHREADS) ((LAS unsigned*)(lds + RING_BYTES))[u] = 0u;
    __syncthreads();
    XcdBarrier bar; bar.bar = ctl + CW_BAR; bar.x = 0; bar.st = nullptr;
    if (!MK_PER_PHASE) bar = xcd_barrier_post(ctl + CW_BAR, MISC + 8);
#define GRID_BAR() do { if (!MK_PER_PHASE) xcd_barrier(bar); } while (0)
    const int lo = args.ph_lo, hi = args.ph_hi;
#ifndef PHASE_MASK
#define PHASE_MASK 0xffff
#endif
#define IN(k) (((PHASE_MASK >> (k)) & 1) && lo <= (k) && (k) < hi)
#define BOTH(k) (IN(k) && IN((k) + 1))
#ifndef PROBE_REP
#define PROBE_REP 0
#endif
#define REPS(k) (1 + ((PROBE_REP >> (k)) & 1))
    const float* const* in = args.in; float* out = args.out;
    bf16_t* WT_ADA = (bf16_t*)(ws + WS_WADA); bf16_t* A_ADA = (bf16_t*)(ws + WS_AADA); bf16_t* WT_IN = (bf16_t*)(ws + WS_WIN); bf16_t* WT_OAB = (bf16_t*)(ws + WS_WOAB); bf16_t* WT_OUT = (bf16_t*)(ws + WS_WOUT);
    bf16_t* WT_UP = (bf16_t*)(ws + WS_WUP); bf16_t* WT_DOWN = (bf16_t*)(ws + WS_WDOWN); bf16_t* WT_LORA = (bf16_t*)(ws + WS_WLORA); bf16_t* ALORA = (bf16_t*)(ws + WS_ALORA);
    float* MOD = (float*)(ws + WS_MOD); bf16_t* H = (bf16_t*)(ws + WS_H); bf16_t* P = (bf16_t*)(ws + WS_P); bf16_t* LWAG = (bf16_t*)(ws + WS_LWAG); float* RSCAN = (float*)(ws + WS_RSCAN); float* GSCAN = (float*)(ws + WS_GSCAN);
    float* BON = (float*)(ws + WS_BON); bf16_t* OA = (bf16_t*)(ws + WS_OA); bf16_t* OB = (bf16_t*)(ws + WS_OB); bf16_t* YAB = (bf16_t*)(ws + WS_YAB); bf16_t* MERGED = (bf16_t*)(ws + WS_MERGED); bf16_t* X1 = (bf16_t*)(ws + WS_X1); bf16_t* U = (bf16_t*)(ws + WS_U); bf16_t* X2 = (bf16_t*)(ws + WS_X2);

    if (IN(0)) for (int rep = 0; rep < REPS(0); ++rep) {
        LAS float* scr = (LAS float*)(lds + wave * 16384);
        constexpr int I0 = (D / 64) * (NMOD / 32), I1 = (D / 64) * (INCOLS / 32), I2 = (RW / 64) * (D / 32), I3 = I2, I4 = (D / 64) * (D / 32), I5 = (D / 64) * (DFF / 32), I6 = (DFF / 64) * (D / 32),
                      I7 = 1 * (RW / 32), I8 = I7, I9 = 4 * (RW / 32), NITEMS = I1 + I2 + I3 + I4 + I7 + I8 + I9;
        for (int it = gw; it < NITEMS; it += NGW) {
            int r = it;
            if (r < I1) { const int nb = INCOLS / 32; const int n0 = 32 * (r % nb); transpose_item(in[I_WIN], INCOLS, 64 * (r / nb), n0, WT_IN, n0 < 14752 ? n0 : (n0 < 14752 + 4096 ? PC_GA + ((n0 - 14752) >> 7) * 256 + ((n0 - 14752) & 127) : PC_GA + ((n0 - 14752 - 4096) >> 7) * 256 + 128 + ((n0 - 14752 - 4096) & 127)), D, 0, scr, lane); continue; } r -= I1;
            if (r < I2) { const int nb = D / 32; transpose_item(in[I_WOA], D, 64 * (r / nb), 32 * (r % nb), WT_OAB, 32 * (r % nb), D, 0, scr, lane); continue; } r -= I2;
            if (r < I3) { const int nb = D / 32; transpose_item(in[I_WOB], D, 64 * (r / nb), 32 * (r % nb), WT_OAB, 32 * (r % nb), D, RW, scr, lane); continue; } r -= I3;
            if (r < I4) { const int nb = D / 32; transpose_item(in[I_WOUT], D, 64 * (r / nb), 32 * (r % nb), WT_OUT, 32 * (r % nb), D, 0, scr, lane); continue; } r -= I4;
            if (r < I7) { const int nb = RW / 32; transpose_item(in[I_RWW2], RW, 64 * (r / nb), 32 * (r % nb), WT_LORA, 32 * (r % nb), LORA_K, 0, scr, lane); continue; } r -= I7;
            if (r < I8) { const int nb = RW / 32; transpose_item(in[I_RWA2], RW, 64 * (r / nb), 32 * (r % nb), WT_LORA, 2048 + 32 * (r % nb), LORA_K, 64, scr, lane); continue; } r -= I8;
            { const int nb = RW / 32; transpose_item(in[I_RWG2], RW, 64 * (r / nb), 32 * (r % nb), WT_LORA, 4096 + 32 * (r % nb), LORA_K, 128, scr, lane); }
        }
        for (int i = gw * 64 + lane; i < LORA_N * 48; i += NGW * 64) { const int n = i / 48, ch = i % 48, k = ch * 8, seg = n >> 11;
            const bool diag = seg == 0 ? (k < 64) : seg == 1 ? (k >= 64 && k < 128) : (k >= 128);
            if (!diag) *(u32x4*)(WT_LORA + (size_t)n * LORA_K + k) = (u32x4){0u, 0u, 0u, 0u}; }
        for (int i = gw * 64 + lane; i < 256 * (D / 4); i += NGW * 64) { const int s = i / (D / 4), c4 = (i % (D / 4)) * 4; u32x2 o = (u32x2){0u, 0u};
            if (s < NSEQ) { const f32x4 c = *(const f32x4*)((s < BP ? in[I_CP] + (size_t)s * D : in[I_CS] + (size_t)(s - BP) * D) + c4);
                o.x = pk2(c.x * sigmoidf_(c.x), c.y * sigmoidf_(c.y)); o.y = pk2(c.z * sigmoidf_(c.z), c.w * sigmoidf_(c.w)); }
            *(u32x2*)(A_ADA + (size_t)s * D + c4) = o; }
        if (BOTH(0) || rep + 1 < REPS(0)) GRID_BAR();
    }
    if (IN(1)) for (int rep = 0; rep < REPS(1); ++rep) {
        adaln_skinny(lds, in[I_WADA], A_ADA, in[I_BADA], MOD, bx, wave, lane, tid);
        if (BOTH(1) || rep + 1 < REPS(1)) GRID_BAR();
    }
    if (IN(2)) for (int rep = 0; rep < REPS(2); ++rep) {
        norm_rows<0, false>(in[I_XP], in[I_XS], in[I_N1W], MOD, 0, D, H, nullptr, gw, NGW, lane);
        if (BOTH(2) || rep + 1 < REPS(2)) GRID_BAR();
    }
    if (IN(3)) for (int rep = 0; rep < REPS(3); ++rep) {
        pg8::Gemm g{H, WT_IN, D, D}; pg8::TileOrder<1> S; S.init(MTOK / 256, LDP / 256, G, bx, D / 64);
        pg8::EpiBf16<0> E{P, LDP, PC_GA / 256};
        pg8::gemm_phase(lds, g, S, E);
        if (BOTH(3) || rep + 1 < REPS(3)) GRID_BAR();
    }
    if (IN(4)) for (int rep = 0; rep < REPS(4); ++rep) {
        const float* mu = in[I_RMU];
        for (int m = gw; m < MTOK; m += NGW) {
            const bool pr = m < NPROMPT; const int ms = m - NPROMPT; const int b = pr ? (m >> 11) : (ms >> 2), t = pr ? (m & 2047) : (ms & 3), T = pr ? TP : TS;
            const bf16_t* cur = P + (size_t)m * LDP;
#pragma unroll
            for (int i = 0; i < 6; ++i) { const int j = lane + 64 * i, col = 6144 + j; const float c = bf2f(cur[col]);
                const float p = t > 0 ? bf2f(cur[col - LDP]) : (pr ? 0.f : in[I_SSHIFT][(size_t)b * RCOLS + col]);
                const float xs = c + (p - c) * mu[col];
                const float val = j < 64 ? tanhf(xs) : j < 128 ? xs : sigmoidf_(xs);
                ALORA[(size_t)m * LORA_K + j] = (bf16_t)f2bf(val); }
            if (t == T - 1) { float* so = out + (pr ? O_PSHIFT : O_SSHIFT) + (size_t)b * RCOLS; for (int col = lane; col < RCOLS; col += 64) so[col] = bf2f(cur[col]); }
            if (t >= T - 3) { float* co = out + (pr ? O_PCONV : O_SCONV) + ((size_t)b * 3 + (t - (T - 3))) * GCONV; for (int col = lane; col < GCONV; col += 64) co[col] = bf2f(cur[PC_G + col]); }
        }
        { const int hh = lane >> 4, cq = lane & 15;
        for (int item = gw; item < BP * 4 * (TP / 16); item += NGW) {
            const int b = item >> 9, hg = (item >> 7) & 3, t0 = (item & 127) * 16, h = 4 * hg + hh, c = h * GH + 8 * cq;
            const bf16_t* base = P + (size_t)(b * TP) * LDP + PC_G + c;
            f32x4 cw[3][4][2];
#pragma unroll
            for (int q = 0; q < 3; ++q)
#pragma unroll
                for (int j = 0; j < 4; ++j) { const float* cwp = in[I_CONVW] + (size_t)(3 - j) * GCONV + q * GW + c; cw[q][j][0] = *(const f32x4*)cwp; cw[q][j][1] = *(const f32x4*)(cwp + 4); }
            u32x4 win[3][3], cu[3], nx[3], n2[3];
#pragma unroll
            for (int q = 0; q < 3; ++q) {
#pragma unroll
                for (int j = 1; j < 4; ++j) win[q][j - 1] = (t0 - j >= 0) ? *(const u32x4*)(base + (ptrdiff_t)(t0 - j) * LDP + q * GW) : (u32x4){0u, 0u, 0u, 0u};
                cu[q] = *(const u32x4*)(base + (size_t)t0 * LDP + q * GW); nx[q] = *(const u32x4*)(base + (size_t)(t0 + 1) * LDP + q * GW); }
            const float nalog = -__expf(in[I_ALOG][h]), dtb = in[I_DTB][h];
            unsigned short bt_n = 0, al_n = 0, bt_2 = 0, al_2 = 0;
            if (cq == 0) { const bf16_t* rp0 = P + (size_t)(b * TP + t0) * LDP; bt_n = rp0[PC_BETA + h]; al_n = rp0[PC_ALPHA + h]; }
#pragma unroll 1
            for (int tt = 0; tt < 16; ++tt) { const int t = t0 + tt, tn = tt < 14 ? t + 2 : t0 + 15; const bf16_t* rowp = P + (size_t)(b * TP + t) * LDP;
#pragma unroll
                for (int q = 0; q < 3; ++q) n2[q] = *(const u32x4*)(base + (size_t)tn * LDP + q * GW);
                if (cq == 0) { const bf16_t* rp1 = rowp + (tt < 15 ? LDP : 0); bt_2 = rp1[PC_BETA + h]; al_2 = rp1[PC_ALPHA + h]; }
                const float bt_raw = bf2f(bt_n), al_raw = bf2f(al_n);
                float y[3][8];
#pragma unroll
                for (int q = 0; q < 3; ++q) { float a8[8];
#pragma unroll
                    for (int e = 0; e < 8; ++e) a8[e] = 0.f;
#pragma unroll
                    for (int j = 0; j < 4; ++j) { const u32x4 w = j == 0 ? cu[q] : win[q][j - 1]; const f32x4 c0 = cw[q][j][0], c1 = cw[q][j][1];
                        a8[0] += c0.x * bflo(w.x); a8[1] += c0.y * bfhi(w.x); a8[2] += c0.z * bflo(w.y); a8[3] += c0.w * bfhi(w.y); a8[4] += c1.x * bflo(w.z); a8[5] += c1.y * bfhi(w.z); a8[6] += c1.z * bflo(w.w); a8[7] += c1.w * bfhi(w.w); }
#pragma unroll
                    for (int e = 0; e < 8; ++e) y[q][e] = a8[e] * fsig(a8[e]); }
                float sq = 0.f, sk = 0.f;
#pragma unroll
                for (int e = 0; e < 8; ++e) { sq += y[0][e] * y[0][e]; sk += y[1][e] * y[1][e]; }
                const float qn = __builtin_amdgcn_rsqf(row16_sum(sq) + 1e-6f) * 0.08838834764831845f, kn = __builtin_amdgcn_rsqf(row16_sum(sk) + 1e-6f);
                float qk = 0.f;
#pragma unroll
                for (int e = 0; e < 8; ++e) { y[0][e] *= qn; y[1][e] *= kn; qk += y[0][e] * y[1][e]; }
                qk = row16_sum(qk);
                unsigned char* recb = (unsigned char*)GSCAN + ((size_t)(b * GHEADS + h) * TP + t) * GRB;
#pragma unroll
                for (int q = 0; q < 3; ++q) *(bf16x8*)(recb + q * 256 + 16 * cq) = pack8((f32x4){y[q][0], y[q][1], y[q][2], y[q][3]}, (f32x4){y[q][4], y[q][5], y[q][6], y[q][7]});
                if (cq == 0) { const float beta = sigmoidf_(bt_raw); const float la = nalog * softplusf_(al_raw + dtb); *(f32x4*)(recb + 768) = (f32x4){__expf(la), beta, qk, la}; }
#pragma unroll
                for (int q = 0; q < 3; ++q) { win[q][2] = win[q][1]; win[q][1] = win[q][0]; win[q][0] = cu[q]; cu[q] = nx[q]; nx[q] = n2[q]; }
                bt_n = bt_2; al_n = al_2;
            }
        } }
        if (BOTH(4) || rep + 1 < REPS(4)) GRID_BAR();
    }
    if (IN(5)) for (int rep = 0; rep < REPS(5); ++rep) {
        pg8::Gemm g{ALORA, WT_LORA, LORA_K, LORA_K}; pg8::TileOrder<1> S; S.init(MTOK / 256, LORA_N / 256, G, bx, LORA_K / 64);
        pg8::EpiLora E{LWAG, in[I_RW0], in[I_RA0]};
        pg8::gemm_phase(lds, g, S, E);
        if (BOTH(5) || rep + 1 < REPS(5)) GRID_BAR();
    }
    if (IN(6)) for (int rep = 0; rep < REPS(6); ++rep) {
        const float* mu = in[I_RMU]; const int hh = lane >> 4, cq = lane & 15;
        if (args.sub & 1) for (int u = gw; u < NSAMP * 6; u += NGW) {
            const int m = NPROMPT + u / 6, gi = u - (u / 6) * 6;
            const bool pr = false; const int ms = m - NPROMPT; const int b = ms >> 2, t = ms & 3;
            const bf16_t* cur = P + (size_t)m * LDP;
            if (gi < 4) {
                if (pr) continue;
                const bf16_t* lw = LWAG + (size_t)m * LORA_N;
                u32x2 cr[2][3], pv[2][3]; f32x4 wv[2], av[2];
#pragma unroll
                for (int bi = 0; bi < 2; ++bi) { const int c = (8 * gi + 4 * bi + hh) * RH + 4 * cq;
#pragma unroll
                    for (int q = 0; q < 3; ++q) { cr[bi][q] = *(const u32x2*)(cur + q * RW + c); pv[bi][q] = t > 0 ? *(const u32x2*)(cur - LDP + q * RW + c) : (u32x2){0u, 0u}; }
                    { const f32x4 lv = cvt4(*(const u32x2*)(lw + c)); wv[bi] = (f32x4){__expf(lv.x), __expf(lv.y), __expf(lv.z), __expf(lv.w)}; } av[bi] = cvt4(*(const u32x2*)(lw + RW + c)); }
#pragma unroll
                for (int bi = 0; bi < 2; ++bi) { const int h = 8 * gi + 4 * bi + hh, c = h * RH + 4 * cq; f32x4 x[3];
#pragma unroll
                    for (int q = 0; q < 3; ++q) { const f32x4 cv = (f32x4){bflo(cr[bi][q].x), bfhi(cr[bi][q].x), bflo(cr[bi][q].y), bfhi(cr[bi][q].y)};
                        f32x4 p = (f32x4){bflo(pv[bi][q].x), bfhi(pv[bi][q].x), bflo(pv[bi][q].y), bfhi(pv[bi][q].y)};
                        if (t == 0 && !pr) p = *(const f32x4*)(in[I_SSHIFT] + (size_t)b * RCOLS + q * RW + c);
                        x[q] = cv + (p - cv) * *(const f32x4*)(mu + q * RW + c); }
                    const f32x4 kr = x[1] * *(const f32x4*)(in[I_RKK] + c);
                    const float ss = row16_sum(kr.x * kr.x + kr.y * kr.y + kr.z * kr.z + kr.w * kr.w);
                    const f32x4 kk = kr * __builtin_amdgcn_rsqf(ss + 1e-6f);
                    const f32x4 a4 = av[bi]; const f32x4 kp = x[1] * ((a4 - 1.0f) * *(const f32x4*)(in[I_RKA] + c) + 1.0f);
                    const f32x4 rk = *(const f32x4*)(in[I_RRK] + c); const f32x4 rkp = x[0] * kp * rk;
                    const float bon = row16_sum(rkp.x + rkp.y + rkp.z + rkp.w);
                    if (cq == 0) BON[(size_t)m * RHEADS + h] = bon;
                    float* rec = RSCAN + ((pr ? ((size_t)(b * RHEADS + h) * TP + t) : ((size_t)BP * RHEADS * TP + (size_t)(b * RHEADS + h) * TS + t))) * RREC + 4 * cq;
                    *(f32x4*)(rec) = wv[bi]; *(f32x4*)(rec + 64) = kk; *(f32x4*)(rec + 128) = kk * a4; *(f32x4*)(rec + 192) = kp; *(f32x4*)(rec + 256) = x[0]; *(f32x4*)(rec + 320) = x[2]; }
            } else {
                const int g8 = 8 * (gi - 4);
                u32x4 raw[2][3][4];
#pragma unroll
                for (int bi = 0; bi < 2; ++bi) { const int c = (g8 + 4 * bi + hh) * GH + 8 * cq;
#pragma unroll
                    for (int q = 0; q < 3; ++q)
#pragma unroll
                        for (int j = 0; j < 4; ++j) raw[bi][q][j] = (t - j >= 0) ? *(const u32x4*)(cur - (size_t)j * LDP + PC_G + q * GW + c) : (u32x4){0u, 0u, 0u, 0u}; }
#pragma unroll
                for (int bi = 0; bi < 2; ++bi) { const int h = g8 + 4 * bi + hh, c = h * GH + 8 * cq; float y[3][8];
#pragma unroll
                    for (int q = 0; q < 3; ++q) { float a8[8];
#pragma unroll
                        for (int e = 0; e < 8; ++e) a8[e] = 0.f;
#pragma unroll
                        for (int j = 0; j < 4; ++j) { const float* cwp = in[I_CONVW] + (size_t)(3 - j) * GCONV + q * GW + c; const f32x4 c0 = *(const f32x4*)cwp, c1 = *(const f32x4*)(cwp + 4);
                            f32x4 x0 = (f32x4){bflo(raw[bi][q][j].x), bfhi(raw[bi][q][j].x), bflo(raw[bi][q][j].y), bfhi(raw[bi][q][j].y)}, x1 = (f32x4){bflo(raw[bi][q][j].z), bfhi(raw[bi][q][j].z), bflo(raw[bi][q][j].w), bfhi(raw[bi][q][j].w)};
                            if (t - j < 0 && !pr) { const float* sp = in[I_SCONV] + ((size_t)b * 3 + (3 + t - j)) * GCONV + q * GW + c; x0 = *(const f32x4*)sp; x1 = *(const f32x4*)(sp + 4); }
                            a8[0] += c0.x * x0.x; a8[1] += c0.y * x0.y; a8[2] += c0.z * x0.z; a8[3] += c0.w * x0.w; a8[4] += c1.x * x1.x; a8[5] += c1.y * x1.y; a8[6] += c1.z * x1.z; a8[7] += c1.w * x1.w; }
#pragma unroll
                        for (int e = 0; e < 8; ++e) y[q][e] = a8[e] * fsig(a8[e]); }
                    float sq = 0.f, sk = 0.f;
#pragma unroll
                    for (int e = 0; e < 8; ++e) { sq += y[0][e] * y[0][e]; sk += y[1][e] * y[1][e]; }
                    const float qn = __builtin_amdgcn_rsqf(row16_sum(sq) + 1e-6f) * 0.08838834764831845f, kn = __builtin_amdgcn_rsqf(row16_sum(sk) + 1e-6f);
                    float qk = 0.f;
#pragma unroll
                    for (int e = 0; e < 8; ++e) { y[0][e] *= qn; y[1][e] *= kn; qk += y[0][e] * y[1][e]; }
                    qk = row16_sum(qk);
                    float* rec = GSCAN + ((size_t)BP * GHEADS * TP + (size_t)(b * GHEADS + h) * TS + t) * GREC;
                    unsigned char* recb = (unsigned char*)GSCAN + ((size_t)(b * GHEADS + h) * TP + t) * GRB;
#pragma unroll
                    for (int q = 0; q < 3; ++q) {
                        if (pr) *(bf16x8*)(recb + q * 256 + 16 * cq) = pack8((f32x4){y[q][0], y[q][1], y[q][2], y[q][3]}, (f32x4){y[q][4], y[q][5], y[q][6], y[q][7]});
                        else { *(f32x4*)(rec + q * 128 + 8 * cq) = (f32x4){y[q][0], y[q][1], y[q][2], y[q][3]}; *(f32x4*)(rec + q * 128 + 8 * cq + 4) = (f32x4){y[q][4], y[q][5], y[q][6], y[q][7]}; } }
                    if (cq == 0) { const float beta = sigmoidf_(bf2f(cur[PC_BETA + h]));
                        const float la = -__expf(in[I_ALOG][h]) * softplusf_(bf2f(cur[PC_ALPHA + h]) + in[I_DTB][h]);
                        *(f32x4*)(pr ? (float*)(recb + 768) : rec + 384) = (f32x4){__expf(la), beta, qk, la}; } }
            }
        }
        if (args.sub & 2) { LAS unsigned char* wl = lds + wave * 16384; const RwPrepIn rin{P, LWAG, in[I_RMU], in[I_RKK], in[I_RKA], in[I_RRK], BON, (unsigned char*)RSCAN}; unsigned char* RKDb = (unsigned char*)RSCAN + 68 * MiB;
          for (int ch = gw; ch < NRCHUNK; ch += NGW) rwkv_chunk_prep(wl, rin, ch >> 6, ch & 63, RKDb + (size_t)ch * RK_BYTES, (float*)(ws + WS_BON + 3 * MiB) + (size_t)ch * 64, lane); }
        if (args.sub & 4) { LAS unsigned char* wl = lds + wave * 16384;
          unsigned char* FRb = (unsigned char*)out; unsigned char* UBb = FRb + (size_t)NCHUNK * CK_FR; float* CDb = (float*)(ws + WS_BON + 2 * MiB);
          for (int ch = gw; ch < NCHUNK; ch += NGW) gdn_chunk_prep(wl, (const unsigned char*)GSCAN + (size_t)ch * 32 * GRB, FRb + (size_t)ch * CK_FR, UBb + (size_t)ch * CK_UB, CDb + ch, lane); }
        if (BOTH(6) || rep + 1 < REPS(6)) GRID_BAR();
    }
    if (IN(8)) for (int rep = 0; rep < REPS(8); ++rep) {
        const int xw = ((bx & 7) << 5) | (bx >> 3);
        if (wave == 0) gdn_mfma_wave((const unsigned char*)out, (const unsigned char*)out + (size_t)NCHUNK * CK_FR, (const float*)(ws + WS_BON + 2 * MiB), OB, out + O_PGDN, xw, lane);
        else if (wave == 1) rwkv_mfma_wave((const unsigned char*)RSCAN + 68 * MiB, (const float*)(ws + WS_BON + 3 * MiB), (const unsigned char*)RSCAN, OA, out + O_PWKV, xw, lane);
        else { const int sw = bx * 6 + (wave - 2), nsw = G * 6; LAS float* scr = (LAS float*)(lds + (wave - 2) * 8704);
            for (int it = sw; it < BS * RHEADS * 4; it += nsw) rwkv_sample_item(RSCAN, in[I_SWKV], OA, out + O_SWKV, it, lane);
            for (int it = sw; it < BS * GHEADS * 4; it += nsw) gdn_sample_item(scr, GSCAN, in[I_SGDN], OB, out + O_SGDN, it, lane);
            constexpr int J5 = (D / 64) * (DFF / 32), J6 = (DFF / 64) * (D / 32);
            for (int it = sw; it < J5 + J6; it += nsw) {
                if (it < J5) { const int nb = DFF / 32; transpose_item(in[I_WUP], DFF, 64 * (it / nb), 32 * (it % nb), WT_UP, 32 * (it % nb), D, 0, scr, lane); }
                else { const int q = it - J5, nb = D / 32; transpose_item(in[I_WDOWN], D, 64 * (q / nb), 32 * (q % nb), WT_DOWN, 32 * (q % nb), DFF, 0, scr, lane); } } }
        __syncthreads();
        if (BOTH(8) || rep + 1 < REPS(8)) GRID_BAR();
    }
    if (IN(9)) for (int rep = 0; rep < REPS(9); ++rep) {
        const float* mu = in[I_RMU]; const int hh = lane >> 4, cq = lane & 15;
        { struct RA { u32x2 o[2], g[2], cv[2], pv[2]; float bon[2]; }; RA ca, na;
#define P9_LOADA(R, uu) do { const int m_ = (uu) >> 2, gi_ = (uu) & 3; const bool pr_ = m_ < NPROMPT; const int t_ = pr_ ? (m_ & 2047) : ((m_ - NPROMPT) & 3); const bf16_t* cur_ = P + (size_t)m_ * LDP; \
            _Pragma("unroll") for (int bi = 0; bi < 2; ++bi) { const int h_ = 8 * gi_ + 4 * bi + hh, c_ = h_ * RH + 4 * cq; \
                R.o[bi] = *(const u32x2*)(OA + (size_t)m_ * RW + c_); R.g[bi] = *(const u32x2*)(LWAG + (size_t)m_ * LORA_N + 2 * RW + c_); \
                R.cv[bi] = *(const u32x2*)(cur_ + 2 * RW + c_); R.pv[bi] = t_ > 0 ? *(const u32x2*)(cur_ - LDP + 2 * RW + c_) : (u32x2){0u, 0u}; R.bon[bi] = BON[(size_t)m_ * RHEADS + h_]; } } while (0)
          constexpr int NA = MTOK * 4;
          if (gw < NA) P9_LOADA(ca, gw);
          for (int u = gw; u < NA; u += NGW) {
            { const int un = u + NGW < NA ? u + NGW : u; P9_LOADA(na, un); }
            const int m = u >> 2, gi = u & 3;
            const bool pr = m < NPROMPT; const int ms = m - NPROMPT; const int b = pr ? (m >> 11) : (ms >> 2), t = pr ? (m & 2047) : (ms & 3);
#pragma unroll
            for (int bi = 0; bi < 2; ++bi) { const int h = 8 * gi + 4 * bi + hh, c = h * RH + 4 * cq;
                const f32x4 o = cvt4(ca.o[bi]); const float mean = row16_sum(o.x + o.y + o.z + o.w) * (1.0f / 64.0f); const f32x4 d = o - mean;
                const float var = row16_sum(d.x * d.x + d.y * d.y + d.z * d.z + d.w * d.w) * (1.0f / 64.0f);
                const f32x4 vc = cvt4(ca.cv[bi]); f32x4 vp = cvt4(ca.pv[bi]);
                if (t == 0 && !pr) vp = *(const f32x4*)(in[I_SSHIFT] + (size_t)b * RCOLS + 2 * RW + c);
                const f32x4 v4 = vc + (vp - vc) * *(const f32x4*)(mu + 2 * RW + c);
                f32x4 on = d * __builtin_amdgcn_rsqf(var + 64e-5f) * *(const f32x4*)(in[I_LNXW] + c) + *(const f32x4*)(in[I_LNXB] + c);
                on = (on + v4 * ca.bon[bi]) * cvt4(ca.g[bi]);
                u32x2 w; w.x = pk2(on.x, on.y); w.y = pk2(on.z, on.w); *(u32x2*)(YAB + (size_t)m * D + c) = w; }
            ca = na; }
#undef P9_LOADA
        }
        { struct RB { u32x4 ow[2], zw[2]; }; RB cb_, nb;
#define P9_LOADB(R, uu) do { const int m_ = (uu) >> 1, g8_ = 8 * ((uu) & 1); const bf16_t* cur_ = P + (size_t)m_ * LDP; \
            _Pragma("unroll") for (int bi = 0; bi < 2; ++bi) { const int c_ = (g8_ + 4 * bi + hh) * GH + 8 * cq; R.ow[bi] = *(const u32x4*)(OB + (size_t)m_ * GW + c_); R.zw[bi] = *(const u32x4*)(cur_ + PC_Z + c_); } } while (0)
          constexpr int NB = MTOK * 2;
          const f32x4 n0 = *(const f32x4*)(in[I_GNW] + 8 * cq), n1 = *(const f32x4*)(in[I_GNW] + 8 * cq + 4);
          if (gw < NB) P9_LOADB(cb_, gw);
          for (int u = gw; u < NB; u += NGW) {
            { const int un = u + NGW < NB ? u + NGW : u; P9_LOADB(nb, un); }
            const int m = u >> 1, g8 = 8 * (u & 1);
#pragma unroll
            for (int bi = 0; bi < 2; ++bi) { const int c = (g8 + 4 * bi + hh) * GH + 8 * cq;
                const f32x4 a = cvt4((u32x2){cb_.ow[bi].x, cb_.ow[bi].y}), bq = cvt4((u32x2){cb_.ow[bi].z, cb_.ow[bi].w});
                const float rs = __builtin_amdgcn_rsqf(row16_sum(a.x * a.x + a.y * a.y + a.z * a.z + a.w * a.w + bq.x * bq.x + bq.y * bq.y + bq.z * bq.z + bq.w * bq.w) * (1.0f / 128.0f) + 1e-6f);
                const u32x4 zq = cb_.zw[bi];
                const float z[8] = {bflo(zq.x), bfhi(zq.x), bflo(zq.y), bfhi(zq.y), bflo(zq.z), bfhi(zq.z), bflo(zq.w), bfhi(zq.w)};
                u32x4 w; w.x = pk2(a.x * rs * n0.x * z[0] * fsig(z[0]), a.y * rs * n0.y * z[1] * fsig(z[1])); w.y = pk2(a.z * rs * n0.z * z[2] * fsig(z[2]), a.w * rs * n0.w * z[3] * fsig(z[3]));
                w.z = pk2(bq.x * rs * n1.x * z[4] * fsig(z[4]), bq.y * rs * n1.y * z[5] * fsig(z[5])); w.w = pk2(bq.z * rs * n1.z * z[6] * fsig(z[6]), bq.w * rs * n1.w * z[7] * fsig(z[7]));
                *(u32x4*)(YAB + (size_t)m * D + RW + c) = w; }
            cb_ = nb; }
#undef P9_LOADB
        }
        if (BOTH(9) || rep + 1 < REPS(9)) GRID_BAR();
    }
    if (IN(10)) for (int rep = 0; rep < REPS(10); ++rep) {
        pg8::Gemm g{YAB, WT_OAB, D, D}; pg8::TileOrder<2> S; S.init(MTOK / 256, D / 256, G, bx, RW / 64, G == 256 ? 2 * G : 0); S.chain = true;
        pg8::EpiMergeChain E{MERGED, P};
        pg8::gemm_phase(lds, g, S, E);
        if (G == 256) { pg8::TailArgs ta{(float*)(ws + WS_H), ctl + CW_TAIL + 0 * 8192, nullptr, nullptr, nullptr, nullptr, MERGED, D, P}; pg8::gemm_tail<8, 2>(lds, g, MTOK / 256, D / 256, G, bx, 2, 8, ta); }
        if (BOTH(10) || rep + 1 < REPS(10)) GRID_BAR();
    }
    if (IN(11)) for (int rep = 0; rep < REPS(11); ++rep) {
        pg8::Gemm g{MERGED, WT_OUT, D, D}; pg8::TileOrder<1> S; S.init(MTOK / 256, D / 256, G, bx, D / 64, G == 256 ? 2 * G : 0);
        pg8::EpiResGate<false> E{in[I_XP], in[I_XS], MOD + 2 * D, X1};
        pg8::gemm_phase(lds, g, S, E);
        if (G == 256) { pg8::TailArgs ta{(float*)(ws + WS_H), ctl + CW_TAIL + 1 * 8192, in[I_XP], in[I_XS], MOD + 2 * D, nullptr, X1, D, nullptr}; pg8::gemm_tail<8, 0>(lds, g, MTOK / 256, D / 256, G, bx, 2, 8, ta); }
        if (BOTH(11) || rep + 1 < REPS(11)) GRID_BAR();
    }
    if (IN(12)) for (int rep = 0; rep < REPS(12); ++rep) {
        norm_rows<0, true>((const float*)X1, nullptr, in[I_N2W], MOD, 3 * D, 4 * D, H, nullptr, gw, NGW, lane);
        if (BOTH(12) || rep + 1 < REPS(12)) GRID_BAR();
    }
    if (IN(13)) for (int rep = 0; rep < REPS(13); ++rep) {
        pg8::Gemm g{H, WT_UP, D, D}; pg8::TileOrder<1> S; S.init(MTOK / 256, DFF / 256, G, bx, D / 64, G == 256 ? 8 * G : 0);
        pg8::EpiBf16<1> E{U, DFF};
        pg8::gemm_phase(lds, g, S, E);
        if (G == 256) { pg8::TailArgs ta{(float*)(ws + WS_P), ctl + CW_TAIL + 2 * 8192, nullptr, nullptr, nullptr, nullptr, U, DFF, nullptr}; pg8::gemm_tail<2, 1>(lds, g, MTOK / 256, DFF / 256, G, bx, 8, 32, ta); }
        if (BOTH(13) || rep + 1 < REPS(13)) GRID_BAR();
    }
    if (IN(14)) for (int rep = 0; rep < REPS(14); ++rep) {
        pg8::Gemm g{U, WT_DOWN, DFF, DFF}; pg8::TileOrder<1> S; S.init(MTOK / 256, D / 256, G, bx, DFF / 64, G == 256 ? 2 * G : 0);
        pg8::EpiResGate<true> E{(const float*)X1, nullptr, MOD + 5 * D, X2};
        pg8::gemm_phase(lds, g, S, E);
        if (G == 256) { pg8::TailArgs ta{(float*)(ws + WS_H), ctl + CW_TAIL + 3 * 8192, (const float*)X1, nullptr, MOD + 5 * D, nullptr, X2, D, nullptr}; pg8::gemm_tail<8, 3>(lds, g, MTOK / 256, D / 256, G, bx, 2, 32, ta); }
        if (BOTH(14) || rep + 1 < REPS(14)) GRID_BAR();
    }
    if (IN(15)) for (int rep = 0; rep < REPS(15); ++rep) {
        norm_rows<1, true>((const float*)X2, nullptr, in[I_FNW], nullptr, 0, 0, nullptr, out + O_Y, gw, NGW, lane);
    }
#undef IN
#undef BOTH
#undef GRID_BAR
}

extern "C" void kernel_launch(void* const* d_in, const int* in_sizes, int n_in, void* d_out, int out_size, void* d_ws, size_t ws_size, hipStream_t stream) {
    static int grid = 0;
    if (grid == 0) {
        if (n_in != 34 || (size_t)out_size != O_END || ws_size < WS_END) { fprintf(stderr, "kernel_launch: unexpected problem: n_in %d out %d ws %zu (need %zu)\n", n_in, out_size, ws_size, (size_t)WS_END); grid = -1; return; }
        int dev = 0, cus = 0, per_cu = 0;
        if (hipGetDevice(&dev) != hipSuccess || hipDeviceGetAttribute(&cus, hipDeviceAttributeMultiprocessorCount, dev) != hipSuccess) { grid = -1; return; }
        if (hipFuncSetAttribute((const void*)fwd_kernel, hipFuncAttributeMaxDynamicSharedMemorySize, LDS_BYTES) != hipSuccess) { fprintf(stderr, "kernel_launch: hipFuncSetAttribute failed\n"); grid = -1; return; }
        if (hipOccupancyMaxActiveBlocksPerMultiprocessor(&per_cu, (const void*)fwd_kernel, NTHREADS, LDS_BYTES) != hipSuccess || per_cu < 1) fprintf(stderr, "kernel_launch: occupancy query says %d\n", per_cu);
        (void)hipGetLastError();
        grid = cus;
    }
    if (grid < 0) return;
    if (hipMemsetAsync((char*)d_ws + WS_CTL, 0, CTL_ZERO_BYTES, stream) != hipSuccess) return;
    Args a{}; a.sub = 7;
    for (int i = 0; i < 34; ++i) a.in[i] = (const float*)d_in[i];
    a.out = (float*)d_out; a.ws = (unsigned char*)d_ws;
#if MK_PER_PHASE
    for (int p = 0; p < NPHASE; ++p) { a.ph_lo = p; a.ph_hi = p + 1; hipLaunchKernelGGL(fwd_kernel, dim3(grid), dim3(NTHREADS), LDS_BYTES, stream, a); }
#else
#ifdef PROBE_PHASE
    a.ph_lo = 0; a.ph_hi = PROBE_PHASE + 1; hipLaunchKernelGGL(fwd_kernel, dim3(grid), dim3(NTHREADS), LDS_BYTES, stream, a);
    if (PROBE_TWICE) { (void)hipMemsetAsync((char*)d_ws + WS_CTL, 0, CTL_ZERO_BYTES, stream); a.ph_lo = PROBE_PHASE; a.ph_hi = PROBE_PHASE + 1; a.sub = PROBE_TWICE; hipLaunchKernelGGL(fwd_kernel, dim3(grid), dim3(NTHREADS), LDS_BYTES, stream, a); a.sub = 7; }
    if (PROBE_PHASE + 1 < NPHASE) { (void)hipMemsetAsync((char*)d_ws + WS_CTL, 0, CTL_ZERO_BYTES, stream); a.ph_lo = PROBE_PHASE + 1; a.ph_hi = NPHASE; hipLaunchKernelGGL(fwd_kernel, dim3(grid), dim3(NTHREADS), LDS_BYTES, stream, a); }
#else
    a.ph_lo = 0; a.ph_hi = NPHASE; hipLaunchKernelGGL(fwd_kernel, dim3(grid), dim3(NTHREADS), LDS_BYTES, stream, a);
#endif
#endif
    const hipError_t le = hipPeekAtLastError();
    if (le != hipSuccess) fprintf(stderr, "kernel_launch: launch failed: %s\n", hipGetErrorName(le));
}
```

```cpp
#include <hip/hip_runtime.h>
#include <cstdio>
#include <cstdint>

#ifndef MK_PER_PHASE
#define MK_PER_PHASE 0
#endif

#define GAS __attribute__((address_space(1)))
#define LAS __attribute__((address_space(3)))
typedef unsigned short bf16_t;
typedef short bf16x8 __attribute__((ext_vector_type(8)));
typedef float f32x4 __attribute__((ext_vector_type(4)));
typedef float f32x2 __attribute__((ext_vector_type(2)));
typedef unsigned u32x4 __attribute__((ext_vector_type(4)));
typedef unsigned u32x2 __attribute__((ext_vector_type(2)));

constexpr int D = 4096, NPROMPT = 8192, NSAMP = 512, MTOK = NPROMPT + NSAMP;
constexpr int TP = 2048, TS = 4, BP = 4, BS = 128, NSEQ = BP + BS;
constexpr int RW = 2048, RH = 64, RHEADS = 32, RCOLS = 6528;
constexpr int GW = 2048, GH = 128, GHEADS = 16, GCONV = 6144;
constexpr int INCOLS = 22944, LDP = 23040;
constexpr int PC_G = 6528, PC_Z = 6528 + 6144, PC_BETA = 14720, PC_ALPHA = 14736, PC_GA = 14848, PC_GB = 14848 + 4096;
constexpr int DFF = 16384, NMOD = 6 * D;
constexpr int LORA_K = 384, LORA_N = 6144;
constexpr int RREC = 384, GREC = 400, GRB = 784;
constexpr size_t O_Y = 0, O_PWKV = 35651584, O_PSHIFT = 36175872, O_PGDN = 36201984, O_PCONV = 37250560, O_SWKV = 37324288, O_SSHIFT = 54101504, O_SGDN = 54937088, O_SCONV = 88491520, O_END = 90850816;

constexpr size_t MiB = 1u << 20;
constexpr size_t WS_CTL = 0, CTL_ZERO_BYTES = 1 * MiB;
constexpr size_t WS_WOAB = 2 * MiB, WS_WOUT = 34 * MiB, WS_WUP = 66 * MiB, WS_WDOWN = 194 * MiB, WS_MOD = 322 * MiB, WS_WLORA = 346 * MiB, WS_ALORA = 351 * MiB;
constexpr size_t WS_H = 358 * MiB, WS_P = 426 * MiB, WS_X = 809 * MiB;
constexpr size_t WS_WADA = WS_X, WS_AADA = WS_X + 192 * MiB, WS_WIN = WS_X + 194 * MiB;
constexpr size_t WS_LWAG = WS_X, WS_RSCAN = WS_X + 204 * MiB, WS_GSCAN = WS_X + 612 * MiB, WS_OA = WS_X + 825 * MiB, WS_OB = WS_H;
constexpr size_t WS_BON = WS_X + 893 * MiB;
constexpr size_t WS_YAB = WS_GSCAN, WS_MERGED = WS_GSCAN + 68 * MiB, WS_X1 = WS_X, WS_U = WS_RSCAN, WS_X2 = WS_RSCAN + 272 * MiB;
constexpr size_t WS_END = 1728 * MiB;
static_assert(WS_OA + (size_t)MTOK * 2048 * 4 <= WS_END && WS_GSCAN + (size_t)MTOK * 16 * GREC * 4 <= WS_OA && WS_RSCAN + (size_t)MTOK * 32 * RREC * 4 <= WS_GSCAN && WS_LWAG + (size_t)MTOK * LORA_N * 4 <= WS_RSCAN, "ws map A");
static_assert(WS_WIN + (size_t)LDP * D * 2 <= WS_END && WS_P + (size_t)MTOK * LDP * 2 <= WS_X && WS_H + (size_t)MTOK * D * 2 <= WS_P && WS_X2 + (size_t)MTOK * D * 4 <= WS_GSCAN && WS_U + (size_t)MTOK * DFF * 2 <= WS_X2, "ws map B");

constexpr int RING_BYTES = 131072, MISC_OFF = RING_BYTES + 320, LDS_BYTES = 147456;
constexpr int NWAVES = 8, NTHREADS = 512;

__device__ __forceinline__ unsigned f2bf(float f) { unsigned u = __builtin_bit_cast(unsigned, f); return (u + 0x7fffu + ((u >> 16) & 1u)) >> 16; }
__device__ __forceinline__ float bf2f(unsigned short b) { return __builtin_bit_cast(float, ((unsigned)b) << 16); }
__device__ __forceinline__ unsigned pk2(float lo, float hi) { return f2bf(lo) | (f2bf(hi) << 16); }
__device__ __forceinline__ float bflo(unsigned w) { return __builtin_bit_cast(float, w << 16); }
__device__ __forceinline__ float bfhi(unsigned w) { return __builtin_bit_cast(float, w & 0xffff0000u); }
__device__ __forceinline__ unsigned cvt2(float lo, float hi);
__device__ __forceinline__ f32x4 cvt4(u32x2 w) { return (f32x4){bflo(w.x), bfhi(w.x), bflo(w.y), bfhi(w.y)}; }
__device__ __forceinline__ float wave_sum(float v) {
#pragma unroll
    for (int o = 1; o < 64; o <<= 1) v += __shfl_xor(v, o);
    return v;
}
template <int CTRL> __device__ __forceinline__ float dppf(float x) { return __builtin_bit_cast(float, __builtin_amdgcn_mov_dpp(__builtin_bit_cast(int, x), CTRL, 0xf, 0xf, true)); }
__device__ __forceinline__ float row16_sum(float x) { x += dppf<0x128>(x); x += dppf<0x124>(x); x += dppf<0x122>(x); x += dppf<0x121>(x); return x; }
__device__ __forceinline__ float sigmoidf_(float x) { return 1.0f / (1.0f + __expf(-x)); }
__device__ __forceinline__ float fsig(float x) { return __builtin_amdgcn_rcpf(1.0f + __builtin_amdgcn_exp2f(x * -1.4426950408889634f)); }
__device__ __forceinline__ float softplusf_(float y) { return fmaxf(y, 0.f) + log1pf(__expf(-fabsf(y))); }
__device__ __forceinline__ int seq_of_row(int m) { return m < NPROMPT ? (m >> 11) : 4 + ((m - NPROMPT) >> 2); }

namespace pg8 {
constexpr int BM = 256, BK = 64, HALF = 128, HTB = HALF * BK * 2, STAGE_BYTES = 8 * HTB, NXCD = 8, WGM = 8;
__host__ __device__ __forceinline__ int lds_byte(int r, int c) { const int st = r >> 3, rr = r & 7, ch = c >> 3; return st * 1024 + rr * 128 + ((ch ^ ((rr >> 1) << 1)) << 4) + (c & 7) * 2; }
__host__ __device__ __forceinline__ void stage_rc(int b, int& R, int& C) { const int st = b / 1024, sb = b % 1024, rr = sb / 128, chs = (sb % 128) / 16, ch = chs ^ ((rr >> 1) << 1); R = st * 8 + rr; C = ch * 8 + (sb % 16) / 2; }
__host__ __device__ __forceinline__ int perm32(int rho) { const int n = rho >> 4, i = rho & 15; return 8 * (i >> 2) + 4 * n + (i & 3); }

struct Unit { int pm, pn, koff, nt, fin; };
struct Gemm { const bf16_t* A; const bf16_t* Bt; int lda, ldb; };

__device__ __forceinline__ void tile_of(int L, int nM, int nN, int& pm, int& pn) {
    const int nwg = nM * nN; int wgid = L; { const int q = nwg / NXCD, r = nwg % NXCD, xcd = wgid % NXCD, off = wgid / NXCD; wgid = (xcd < r ? xcd * (q + 1) : r * (q + 1) + (xcd - r) * q) + off; }
    const int nig = WGM * nN, gid = wgid / nig, fm = gid * WGM, gsz = (nM - fm) < WGM ? (nM - fm) : WGM;
    pm = fm + ((wgid % nig) % gsz); pn = (wgid % nig) / gsz;
}
template <int SPLIT> struct TileOrder {
    int nM, nN, lim, G, c, nt; bool chain = false;
    __device__ void init(int nM_, int nN_, int G_, int c_, int nt_, int lim_ = 0) { nM = nM_; nN = nN_; lim = lim_ ? lim_ : nM * nN; G = G_; c = c_; nt = nt_; }
    __device__ bool next(int i, Unit& u) const {
        const int ti = i / SPLIT, hf = i % SPLIT;
        const long L = (long)ti * G + c; if (L >= lim) return false;
        tile_of((int)L, nM, nN, u.pm, u.pn); u.nt = nt; u.koff = hf * nt * BK * 2; u.fin = chain ? (hf == SPLIT - 1) : 1; return true;
    }
};
struct OneUnit { Unit u; __device__ bool next(int i, Unit& o) const { if (i) return false; o = u; return true; } };

__device__ __forceinline__ unsigned cvt_pk_bf16(float lo, float hi) { unsigned r; asm volatile("v_cvt_pk_bf16_f32 %0, %1, %2" : "=v"(r) : "v"(lo), "v"(hi)); return r; }

#define ACC_T f32x4 (&acc)[2][2][4][2]
#define FOR_AIM _Pragma("unroll") for (int ai = 0; ai < 2; ++ai) _Pragma("unroll") for (int m = 0; m < 4; ++m)
#define FOR_BJN _Pragma("unroll") for (int bj = 0; bj < 2; ++bj) _Pragma("unroll") for (int n = 0; n < 2; ++n)

struct EpiF32Bias {
    static constexpr bool PERM = false, HAS_MID = false;
    float* C; int ldc; const float* bias;
    __device__ __forceinline__ void mid(ACC_T, const Unit&, int, int, int, int) const {}
    __device__ __forceinline__ void operator()(ACC_T, const Unit& u, int wr, int wc, int fr, int fq) const {
        const int row0 = u.pm * BM + wr * 64 + fr, col0 = u.pn * BM + wc * 32 + 4 * fq;
        f32x4 bv[2][2];
        FOR_BJN bv[bj][n] = *(const f32x4*)(bias + col0 + bj * HALF + n * 16);
        FOR_AIM { float* rowp = C + (size_t)(row0 + ai * HALF + m * 16) * ldc + col0;
            FOR_BJN *(f32x4*)(rowp + bj * HALF + n * 16) = acc[ai][bj][m][n] + bv[bj][n]; }
    }
};
template <int ACT  > struct EpiBf16 {
    static constexpr bool PERM = true, HAS_MID = false;
    bf16_t* O; int ldc;
    __device__ __forceinline__ void mid(ACC_T, const Unit&, int, int, int, int) const {}
    __device__ __forceinline__ void operator()(ACC_T, const Unit& u, int wr, int wc, int fr, int fq) const {
        const int row0 = u.pm * BM + wr * 64 + fr, col0 = u.pn * BM + wc * 32 + 8 * fq;
        FOR_AIM { bf16_t* rowp = O + (size_t)(row0 + ai * HALF + m * 16) * ldc + col0;
#pragma unroll
            for (int bj = 0; bj < 2; ++bj) { f32x4 v0 = acc[ai][bj][m][0], v1 = acc[ai][bj][m][1];
                if (ACT == 1) {
#pragma unroll
                    for (int j = 0; j < 4; ++j) { const float a = fmaxf(v0[j], 0.f), b = fmaxf(v1[j], 0.f); v0[j] = a * a; v1[j] = b * b; } }
                u32x4 w; w.x = cvt_pk_bf16(v0[0], v0[1]); w.y = cvt_pk_bf16(v0[2], v0[3]); w.z = cvt_pk_bf16(v1[0], v1[1]); w.w = cvt_pk_bf16(v1[2], v1[3]);
                *(u32x4*)(rowp + bj * HALF) = w; } }
    }
};
struct EpiLora {
    static constexpr bool PERM = true, HAS_MID = false;
    bf16_t* C; const float* w0; const float* a0;
    __device__ __forceinline__ void mid(ACC_T, const Unit&, int, int, int, int) const {}
    __device__ __forceinline__ void operator()(ACC_T, const Unit& u, int wr, int wc, int fr, int fq) const {
        const int row0 = u.pm * BM + wr * 64 + fr, col0 = u.pn * BM + wc * 32 + 8 * fq, seg = u.pn >> 3, cs0 = col0 - seg * 2048;
        f32x4 bv[2][2];
        FOR_BJN bv[bj][n] = seg == 0 ? *(const f32x4*)(w0 + cs0 + bj * HALF + n * 4) : seg == 1 ? *(const f32x4*)(a0 + cs0 + bj * HALF + n * 4) : (f32x4){0.f, 0.f, 0.f, 0.f};
        FOR_AIM { bf16_t* rowp = C + (size_t)(row0 + ai * HALF + m * 16) * LORA_N + col0;
#pragma unroll
            for (int bj = 0; bj < 2; ++bj) { f32x4 vv[2];
#pragma unroll
                for (int n = 0; n < 2; ++n) { f32x4 v = acc[ai][bj][m][n] + bv[bj][n];
                    if (seg == 0) {
#pragma unroll
                        for (int j = 0; j < 4; ++j) { const float y = -v[j]; const float sp = fmaxf(y, 0.f) + 0.6931471805599453f * __builtin_amdgcn_logf(1.0f + __builtin_amdgcn_exp2f(-1.4426950408889634f * fabsf(y)));
                            v[j] = -__builtin_amdgcn_exp2f(1.4426950408889634f * (-sp - 0.5f)); } }
                    else if (seg == 1) {
#pragma unroll
                        for (int j = 0; j < 4; ++j) v[j] = fsig(v[j]); }
                    vv[n] = v; }
                u32x4 w; w.x = cvt_pk_bf16(vv[0][0], vv[0][1]); w.y = cvt_pk_bf16(vv[0][2], vv[0][3]); w.z = cvt_pk_bf16(vv[1][0], vv[1][1]); w.w = cvt_pk_bf16(vv[1][2], vv[1][3]);
                *(u32x4*)(rowp + bj * HALF) = w; } }
    }
};
struct EpiMerge {
    static constexpr bool PERM = true, HAS_MID = false;
    bf16_t* O; const bf16_t* P; float* T;
    __device__ __forceinline__ void mid(ACC_T, const Unit&, int, int, int, int) const {}
    __device__ __forceinline__ void operator()(ACC_T, const Unit& u, int wr, int wc, int fr, int fq) const {
        const int row0 = u.pm * BM + wr * 64 + fr, col0 = u.pn * BM + wc * 32 + 8 * fq; const bool second = u.koff != 0;
        FOR_AIM { const int row = row0 + ai * HALF + m * 16; bf16_t* rowp = O + (size_t)row * D + col0; float* trow = T + (size_t)row * D + col0; const bf16_t* grow = P + (size_t)row * LDP + (second ? PC_GB : PC_GA) + col0;
#pragma unroll
            for (int bj = 0; bj < 2; ++bj) { const u32x4 gw = *(const u32x4*)(grow + bj * HALF);
                f32x4 v0 = acc[ai][bj][m][0], v1 = acc[ai][bj][m][1];
                v0[0] *= fsig(bflo(gw.x)); v0[1] *= fsig(bfhi(gw.x)); v0[2] *= fsig(bflo(gw.y)); v0[3] *= fsig(bfhi(gw.y));
                v1[0] *= fsig(bflo(gw.z)); v1[1] *= fsig(bfhi(gw.z)); v1[2] *= fsig(bflo(gw.w)); v1[3] *= fsig(bfhi(gw.w));
                if (!second) { *(f32x4*)(trow + bj * HALF) = v0; *(f32x4*)(trow + bj * HALF + 4) = v1; }
                else { v0 += *(const f32x4*)(trow + bj * HALF); v1 += *(const f32x4*)(trow + bj * HALF + 4);
                    u32x4 w; w.x = cvt_pk_bf16(v0[0], v0[1]); w.y = cvt_pk_bf16(v0[2], v0[3]); w.z = cvt_pk_bf16(v1[0], v1[1]); w.w = cvt_pk_bf16(v1[2], v1[3]);
                    *(u32x4*)(rowp + bj * HALF) = w; } }
            asm volatile("" ::: "memory"); }
    }
};
struct EpiMergeChain {
    static constexpr bool PERM = true, HAS_MID = false, CHAIN = true;
    bf16_t* O; const bf16_t* P;
    __device__ __forceinline__ static float em(float x) { return __builtin_amdgcn_exp2f(fminf(x * -1.4426950408889634f, 115.f)); }
    __device__ __forceinline__ void mid(ACC_T, const Unit&, int, int, int, int) const {}
    __device__ __forceinline__ void operator()(ACC_T, const Unit&, int, int, int, int) const {}
    __device__ __forceinline__ void chain(ACC_T, const Unit& u, int wr, int wc, int fr, int fq) const {
        const int row0 = u.pm * BM + wr * 64 + fr, col0 = u.pn * BM + wc * 32 + 8 * fq; const bool fin = u.fin != 0; const float keep = fin ? 0.f : 1.f;
#pragma unroll
        for (int ai = 0; ai < 2; ++ai) {
            int rb = row0; asm volatile("" : "+v"(rb));
            u32x4 ga[4][2], gb[4][2];
#pragma unroll
            for (int m = 0; m < 4; ++m) { const bf16_t* grow = P + (size_t)(rb + ai * HALF + m * 16) * LDP + col0;
#pragma unroll
                for (int bj = 0; bj < 2; ++bj) { ga[m][bj] = (u32x4){0u, 0u, 0u, 0u}; if (!fin) ga[m][bj] = *(const u32x4*)(grow + PC_GA + bj * HALF);
                    gb[m][bj] = *(const u32x4*)(grow + PC_GB + bj * HALF); } }
            __builtin_amdgcn_sched_barrier(0);
#pragma unroll
            for (int m = 0; m < 4; ++m) { bf16_t* rowp = O + (size_t)(rb + ai * HALF + m * 16) * D + col0;
#pragma unroll
                for (int bj = 0; bj < 2; ++bj) { const u32x4 a = ga[m][bj], b = gb[m][bj];
                    const float av[8] = {bflo(a.x), bfhi(a.x), bflo(a.y), bfhi(a.y), bflo(a.z), bfhi(a.z), bflo(a.w), bfhi(a.w)}, bv[8] = {bflo(b.x), bfhi(b.x), bflo(b.y), bfhi(b.y), bflo(b.z), bfhi(b.z), bflo(b.w), bfhi(b.w)};
                    float v[8];
#pragma unroll
                    for (int e = 0; e < 8; ++e) { const float eb = 1.0f + em(bv[e]), ea = 1.0f + em(av[e]); v[e] = acc[ai][bj][m][e >> 2][e & 3] * ((fin ? 1.0f : eb) * __builtin_amdgcn_rcpf(fin ? eb : ea)); }
                    if (fin) { u32x4 w; w.x = cvt_pk_bf16(v[0], v[1]); w.y = cvt_pk_bf16(v[2], v[3]); w.z = cvt_pk_bf16(v[4], v[5]); w.w = cvt_pk_bf16(v[6], v[7]); *(u32x4*)(rowp + bj * HALF) = w; }
#pragma unroll
                    for (int e = 0; e < 8; ++e) acc[ai][bj][m][e >> 2][e & 3] = v[e] * keep;
                    asm volatile("" : "+v"(acc[ai][bj][m][0]), "+v"(acc[ai][bj][m][1])); } }
            asm volatile("" ::: "memory"); }
    }
};
template <bool BASE_BF16> struct EpiResGate {
    static constexpr bool PERM = true, HAS_MID = false;
    const float* bp; const float* bs; const float* gate; bf16_t* out;
    __device__ __forceinline__ void mid(ACC_T, const Unit&, int, int, int, int) const {}
    __device__ __forceinline__ void operator()(ACC_T, const Unit& u, int wr, int wc, int fr, int fq) const {
        const int row0 = u.pm * BM + wr * 64 + fr, col0 = u.pn * BM + wc * 32 + 8 * fq;
        FOR_AIM { const int row = row0 + ai * HALF + m * 16; const int s = seq_of_row(row);
            const float* grow = gate + (size_t)s * NMOD + col0; bf16_t* orow = out + (size_t)row * D + col0;
#pragma unroll
            for (int bj = 0; bj < 2; ++bj) { f32x4 b0, b1;
                if (BASE_BF16) { const u32x4 bw = *(const u32x4*)((const bf16_t*)bp + (size_t)row * D + col0 + bj * HALF);
                    b0 = (f32x4){bflo(bw.x), bfhi(bw.x), bflo(bw.y), bfhi(bw.y)}; b1 = (f32x4){bflo(bw.z), bfhi(bw.z), bflo(bw.w), bfhi(bw.w)}; }
                else { const float* brow = (row < NPROMPT ? bp + (size_t)row * D : bs + (size_t)(row - NPROMPT) * D) + col0 + bj * HALF; b0 = *(const f32x4*)brow; b1 = *(const f32x4*)(brow + 4); }
                const f32x4 v0 = b0 + *(const f32x4*)(grow + bj * HALF) * acc[ai][bj][m][0], v1 = b1 + *(const f32x4*)(grow + bj * HALF + 4) * acc[ai][bj][m][1];
                u32x4 w; w.x = cvt_pk_bf16(v0[0], v0[1]); w.y = cvt_pk_bf16(v0[2], v0[3]); w.z = cvt_pk_bf16(v1[0], v1[1]); w.w = cvt_pk_bf16(v1[2], v1[3]);
                *(u32x4*)(orow + bj * HALF) = w; } }
    }
};

template <class T, class = void> struct epi_chain { static constexpr bool value = false; };
template <class T> struct epi_chain<T, decltype((void)T::CHAIN)> { static constexpr bool value = T::CHAIN; };
template <class Epi, class Sched>
__device__ __forceinline__ void gemm_phase(LAS unsigned char* lds, const Gemm g, const Sched& S, const Epi& E) {
    const int tid = threadIdx.x, wid = __builtin_amdgcn_readfirstlane(tid >> 6), lane = tid & 63, wr = wid >> 2, wc = wid & 3, fr = lane & 15, fq = lane >> 4;
    unsigned voffA[2], voffB[2];
#pragma unroll
    for (int i = 0; i < 2; ++i) { int R, C; stage_rc(tid * 16 + i * 8192, R, C); const int Rb = Epi::PERM ? ((R & ~31) + perm32(R & 31)) : R;
        voffA[i] = (unsigned)(R * g.lda + C) * 2u; voffB[i] = (unsigned)(Rb * g.ldb + C) * 2u; }
    const size_t kstep = (size_t)(BK * 2);
    const size_t hstepA = (size_t)HALF * g.lda * 2, hstepB = (size_t)HALF * g.ldb * 2, tstepA = 2 * hstepA, tstepB = 2 * hstepB;
    const unsigned ldsw = (unsigned)wid * 1024u;
    const int aoff0 = lds_byte(wr * 64 + fr, fq * 8), aoff1 = lds_byte(wr * 64 + fr, 32 + fq * 8), boff0 = lds_byte(wc * 32 + fr, fq * 8), boff1 = lds_byte(wc * 32 + fr, 32 + fq * 8);
#define PG8_SA(b, h) (((b) * 2 + (h)) * HTB)
#define PG8_SB(b, h) ((4 + (b) * 2 + (h)) * HTB)
#define PG8_STAGE(bufoff, gbase, voff) do { _Pragma("unroll") for (int _i = 0; _i < 2; ++_i) \
        __builtin_amdgcn_global_load_lds((const unsigned*)((const char*)(gbase) + (voff)[_i]), (LAS unsigned*)(lds + (bufoff) + ldsw + _i * 8192), 16, 0, 0); } while (0)
#define PG8_LDA(dst, b, h) do { _Pragma("unroll") for (int m = 0; m < 4; ++m) _Pragma("unroll") for (int k = 0; k < 2; ++k) dst[m][k] = *(const LAS bf16x8*)(lds + PG8_SA(b, h) + (k ? aoff1 : aoff0) + m * 2048); } while (0)
#define PG8_LDB(dst, b, h) do { _Pragma("unroll") for (int n = 0; n < 2; ++n) _Pragma("unroll") for (int k = 0; k < 2; ++k) dst[n][k] = *(const LAS bf16x8*)(lds + PG8_SB(b, h) + (k ? boff1 : boff0) + n * 2048); } while (0)
#define PG8_MMA(ai, bj, At, Bt) do { __builtin_amdgcn_s_setprio(1); _Pragma("unroll") for (int m = 0; m < 4; ++m) _Pragma("unroll") for (int n = 0; n < 2; ++n) _Pragma("unroll") for (int k = 0; k < 2; ++k) \
        acc[ai][bj][m][n] = __builtin_amdgcn_mfma_f32_16x16x32_bf16(Bt[n][k], At[m][k], acc[ai][bj][m][n], 0, 0, 0); __builtin_amdgcn_s_setprio(0); } while (0)
#define PG8_WAIT_V(n) asm volatile("s_waitcnt vmcnt(" #n ")" ::: "memory")
#define PG8_WAIT_L(n) asm volatile("s_waitcnt lgkmcnt(" #n ")" ::: "memory")
#define PG8_BAR __builtin_amdgcn_s_barrier()
#define PG8_SCHED __builtin_amdgcn_sched_barrier(0)
    Unit cur, nxt; int ui = 0;
    if (!S.next(0, cur)) return;
    f32x4 acc[2][2][4][2];
#pragma unroll
    for (int a = 0; a < 2; ++a)
#pragma unroll
        for (int b = 0; b < 2; ++b)
#pragma unroll
            for (int m = 0; m < 4; ++m)
#pragma unroll
                for (int n = 0; n < 2; ++n) acc[a][b][m][n] = (f32x4){0.f, 0.f, 0.f, 0.f};
    bf16x8 At[4][2], B0[2][2], B1[2][2];
    const char* cA = (const char*)g.A + (size_t)cur.pm * tstepA + cur.koff; const char* cB = (const char*)g.Bt + (size_t)cur.pn * tstepB + cur.koff;
    PG8_STAGE(PG8_SB(0, 0), cB, voffB); PG8_STAGE(PG8_SB(0, 1), cB + hstepB, voffB); PG8_STAGE(PG8_SA(0, 0), cA, voffA); PG8_STAGE(PG8_SA(0, 1), cA + hstepA, voffA);
    if (wr == 1) PG8_BAR;
    PG8_WAIT_V(2); PG8_BAR;
    PG8_STAGE(PG8_SB(1, 0), cB + kstep, voffB); PG8_STAGE(PG8_SA(1, 0), cA + kstep, voffA); PG8_STAGE(PG8_SB(1, 1), cB + hstepB + kstep, voffB);
    PG8_WAIT_V(6); PG8_BAR;
    for (;;) {
        const bool has_next = S.next(ui + 1, nxt);
        const char* nA = has_next ? (const char*)g.A + (size_t)nxt.pm * tstepA + nxt.koff : cA; const char* nB = has_next ? (const char*)g.Bt + (size_t)nxt.pn * tstepB + nxt.koff : cB;
        const int nt = cur.nt;
        for (int t = 0; t < nt; t += 2) {
            const bool last = (t == nt - 2);
            const char* a1 = cA + (size_t)(t + 1) * kstep;
            const char* a2 = last ? nA : cA + (size_t)(t + 2) * kstep; const char* b2 = last ? nB : cB + (size_t)(t + 2) * kstep;
            const char* a3 = a2 + kstep; const char* b3 = b2 + kstep;
            PG8_LDB(B0, 0, 0); PG8_LDB(B1, 0, 1); PG8_SCHED; PG8_LDA(At, 0, 0); PG8_STAGE(PG8_SA(1, 1), a1 + hstepA, voffA);
            PG8_WAIT_V(8); PG8_WAIT_L(0); PG8_BAR; PG8_MMA(0, 0, At, B0); PG8_MMA(0, 1, At, B1); PG8_BAR; PG8_SCHED;
            PG8_LDA(At, 0, 1); PG8_STAGE(PG8_SB(0, 0), b2, voffB); PG8_STAGE(PG8_SB(0, 1), b2 + hstepB, voffB); PG8_STAGE(PG8_SA(0, 0), a2, voffA);
            PG8_WAIT_V(8); PG8_WAIT_L(0); PG8_BAR; PG8_MMA(1, 0, At, B0); PG8_MMA(1, 1, At, B1); PG8_BAR; PG8_SCHED;
            PG8_LDB(B0, 1, 0); PG8_LDB(B1, 1, 1); PG8_SCHED; PG8_LDA(At, 1, 0); PG8_STAGE(PG8_SA(0, 1), a2 + hstepA, voffA);
            PG8_WAIT_V(8); PG8_WAIT_L(0); PG8_BAR; PG8_MMA(0, 0, At, B0); PG8_MMA(0, 1, At, B1); PG8_BAR; PG8_SCHED;
            PG8_LDA(At, 1, 1); PG8_STAGE(PG8_SB(1, 0), b3, voffB); PG8_STAGE(PG8_SB(1, 1), b3 + hstepB, voffB); PG8_STAGE(PG8_SA(1, 0), a3, voffA);
            PG8_WAIT_V(8); PG8_WAIT_L(0); PG8_BAR; PG8_MMA(1, 0, At, B0); PG8_MMA(1, 1, At, B1); PG8_BAR; PG8_SCHED;
        }
        if (wr == 0) PG8_BAR;
        if constexpr (epi_chain<Epi>::value) { E.chain(acc, cur, wr, wc, fr, fq); }
        else if (cur.fin) {
            E(acc, cur, wr, wc, fr, fq);
            if (has_next) {
#pragma unroll
                for (int a = 0; a < 2; ++a)
#pragma unroll
                    for (int b = 0; b < 2; ++b)
#pragma unroll
                        for (int m = 0; m < 4; ++m)
#pragma unroll
                            for (int n = 0; n < 2; ++n) acc[a][b][m][n] = (f32x4){0.f, 0.f, 0.f, 0.f};
            }
        } else { if constexpr (Epi::HAS_MID) E.mid(acc, cur, wr, wc, fr, fq); }
        if (!has_next) break;
        cur = nxt; cA = nA; cB = nB; ++ui;
        if (wr == 1) PG8_BAR;
    }
    PG8_WAIT_V(0);
    PG8_BAR;
#undef PG8_SA
#undef PG8_SB
#undef PG8_STAGE
#undef PG8_LDA
#undef PG8_LDB
#undef PG8_MMA
#undef PG8_WAIT_V
#undef PG8_WAIT_L
#undef PG8_BAR
#undef PG8_SCHED
}
__device__ __forceinline__ void st_sc1(float* p, f32x4 v) { asm volatile("global_store_dwordx4 %0, %1, off sc1\n\ts_nop 1" :: "v"(p), "v"(v) : "memory"); }
struct EpiSlab {
    static constexpr bool PERM = false, HAS_MID = false;
    float* C;
    __device__ __forceinline__ void mid(ACC_T, const Unit&, int, int, int, int) const {}
    __device__ __forceinline__ void operator()(ACC_T, const Unit&, int wr, int wc, int fr, int fq) const {
        FOR_AIM { float* rowp = C + (size_t)(wr * 64 + fr + ai * HALF + m * 16) * 256 + wc * 32 + 4 * fq;
            FOR_BJN st_sc1(rowp + bj * HALF + n * 16, acc[ai][bj][m][n]); }
    }
};
struct TailArgs { float* slabs; unsigned* flags; const float* bp; const float* bs; const float* gate; float* outf; bf16_t* outb; int ldo; const bf16_t* P; };
template <int S, int MODE>
__device__ __forceinline__ void gemm_tail(LAS unsigned char* lds, const Gemm g, int nM, int nN, int G, int c, int R, int nt_slice, const TailArgs& a) {
    const int ntail = nM * nN - R * G, tileIdx = c % ntail, slice = c / ntail, tid = threadIdx.x;
    if (ntail * S != G) return;
    OneUnit S1; tile_of(R * G + tileIdx, nM, nN, S1.u.pm, S1.u.pn); S1.u.koff = slice * nt_slice * BK * 2; S1.u.nt = nt_slice; S1.u.fin = 1;
    float* tslab = a.slabs + (size_t)tileIdx * S * 65536;
    EpiSlab E{tslab + (size_t)slice * 65536};
    gemm_phase(lds, g, S1, E);
    unsigned* flag = a.flags + tileIdx * 64;
    if (tid == 0) { __hip_atomic_fetch_add(flag, 1u, __ATOMIC_RELAXED, __HIP_MEMORY_SCOPE_AGENT); unsigned sp = 0;
        while (__hip_atomic_load(flag, __ATOMIC_RELAXED, __HIP_MEMORY_SCOPE_AGENT) < (unsigned)S) { __builtin_amdgcn_s_sleep(1); if (++sp > (1u << 22)) break; }
        __builtin_amdgcn_fence(__ATOMIC_ACQUIRE, "agent"); asm volatile("s_waitcnt vmcnt(0)" ::: "memory"); }
    __syncthreads();
    constexpr int RPS = 256 / S;
#pragma unroll
    for (int j = 0; j < RPS / 8; ++j) { const int idx = j * 512 + tid, r = slice * RPS + (idx >> 6), c4 = (idx & 63) * 4;
        f32x4 s0 = (f32x4){0.f, 0.f, 0.f, 0.f}, s1 = s0;
#pragma unroll
        for (int q = 0; q < S; ++q) { const f32x4 v = *(const f32x4*)(tslab + (size_t)q * 65536 + r * 256 + c4); if (MODE == 2 && q >= S / 2) s1 += v; else s0 += v; }
        const int row = S1.u.pm * 256 + r, col = S1.u.pn * 256 + c4;
        if (MODE == 0 || MODE == 3) { const f32x4 gv = *(const f32x4*)(a.gate + (size_t)seq_of_row(row) * NMOD + col); f32x4 bv;
            if (MODE == 0) bv = *(const f32x4*)((row < NPROMPT ? a.bp + (size_t)row * D : a.bs + (size_t)(row - NPROMPT) * D) + col);
            else { const u32x2 bw = *(const u32x2*)((const bf16_t*)a.bp + (size_t)row * D + col); bv = (f32x4){bflo(bw.x), bfhi(bw.x), bflo(bw.y), bfhi(bw.y)}; }
            const f32x4 v = bv + gv * s0; u32x2 w; w.x = cvt_pk_bf16(v[0], v[1]); w.y = cvt_pk_bf16(v[2], v[3]); *(u32x2*)(a.outb + (size_t)row * a.ldo + col) = w; }
        else if (MODE == 1) { f32x4 v = s0;
#pragma unroll
            for (int e = 0; e < 4; ++e) { const float x = fmaxf(v[e], 0.f); v[e] = x * x; }
            u32x2 w; w.x = cvt_pk_bf16(v[0], v[1]); w.y = cvt_pk_bf16(v[2], v[3]); *(u32x2*)(a.outb + (size_t)row * a.ldo + col) = w; }
        else { const u32x2 ga = *(const u32x2*)(a.P + (size_t)row * LDP + PC_GA + col), gb = *(const u32x2*)(a.P + (size_t)row * LDP + PC_GB + col);
            const float o0 = fsig(bflo(ga.x)) * s0[0] + fsig(bflo(gb.x)) * s1[0], o1 = fsig(bfhi(ga.x)) * s0[1] + fsig(bfhi(gb.x)) * s1[1], o2 = fsig(bflo(ga.y)) * s0[2] + fsig(bflo(gb.y)) * s1[2], o3 = fsig(bfhi(ga.y)) * s0[3] + fsig(bfhi(gb.y)) * s1[3];
            u32x2 w; w.x = cvt_pk_bf16(o0, o1); w.y = cvt_pk_bf16(o2, o3); *(u32x2*)(a.outb + (size_t)row * a.ldo + col) = w; }
    }
}
}

#define XB_TMO      128
#define XB_XCNT(j)  (256  + 64 * (j))
#define XB_XSUB(j)  (1280 + 64 * (j))
#define XB_XGEN(j)  (2304 + 64 * (j))
#define XB_TOP      3328
#define XB_TOPGEN   3392
#define XCD_BAR_WORDS 3456
#define XB_SPIN_CAP (1u << 18)
__device__ __forceinline__ unsigned xb_ld(unsigned* p)              { return __hip_atomic_load(p, __ATOMIC_RELAXED, __HIP_MEMORY_SCOPE_AGENT); }
__device__ __forceinline__ unsigned xb_add(unsigned* p, unsigned v) { return __hip_atomic_fetch_add(p, v, __ATOMIC_RELAXED, __HIP_MEMORY_SCOPE_AGENT); }
__device__ __forceinline__ unsigned xb_xcc_id() { return (unsigned)__builtin_amdgcn_s_getreg((3 << 11) | 20) & 0xFu; }
#define XB_SPIN(cond, bar) do { unsigned _sp = 0; while (cond) { __builtin_amdgcn_s_sleep(1); \
    if ((++_sp & 255u) == 0u) { if (xb_ld(&(bar)[XB_TMO])) break; if (_sp > XB_SPIN_CAP) { atomicAdd(&(bar)[XB_TMO], 1u); break; } } } } while (0)
struct XcdBarrier { unsigned* bar; unsigned x; volatile LAS unsigned* st; };
__device__ __forceinline__ XcdBarrier xcd_barrier_post(unsigned* bar, volatile LAS unsigned* st) {
    XcdBarrier b; b.bar = bar; b.x = xb_xcc_id(); b.st = st;
    if (threadIdx.x == 0) (void)xb_add(&bar[XB_XCNT(b.x)], 1u);
    return b;
}
__device__ __forceinline__ void xcd_barrier_complete(unsigned* bar, unsigned x, unsigned& nloc, unsigned& nx) {
    const unsigned G = gridDim.x * gridDim.y * gridDim.z;
    unsigned sum, cnt, mine, sp = 0u;
    for (;;) {
        sum = 0u; cnt = 0u; mine = 0u;
#pragma unroll
        for (unsigned j = 0; j < 16; ++j) { const unsigned c = xb_ld(&bar[XB_XCNT(j)]); sum += c; cnt += (c > 0u) ? 1u : 0u; mine = (j == x) ? c : mine; }
        if (sum == G) break;
        __builtin_amdgcn_s_sleep(1);
        if ((++sp & 255u) == 0u) { if (xb_ld(&bar[XB_TMO])) break; if (sp > XB_SPIN_CAP) { atomicAdd(&bar[XB_TMO], 1u); break; } }
    }
    nloc = mine > 0u ? mine : 1u; nx = cnt > 0u ? cnt : 1u;
}
__device__ __forceinline__ void xcd_barrier(const XcdBarrier& b) {
    asm volatile("s_waitcnt vmcnt(0)" ::: "memory");
    __syncthreads();
    if (threadIdx.x == 0) {
        unsigned* bar = b.bar;
        __builtin_amdgcn_s_waitcnt(0);
        unsigned nloc = b.st[0], nx = b.st[1];
        if (nloc == 0u) { xcd_barrier_complete(bar, b.x, nloc, nx); b.st[0] = nloc; b.st[1] = nx; }
        const unsigned old = xb_add(&bar[XB_XSUB(b.x)], 1u);
        const unsigned gen = old / nloc;
        if (old + 1u == (gen + 1u) * nloc) {
            __builtin_amdgcn_fence(__ATOMIC_RELEASE, "agent");
            asm volatile("s_waitcnt vmcnt(0)" ::: "memory");
            const unsigned og = xb_add(&bar[XB_TOP], 1u);
            const unsigned tg = og / nx;
            if (og + 1u == (tg + 1u) * nx) xb_add(&bar[XB_TOPGEN], 1u);
            else XB_SPIN(xb_ld(&bar[XB_TOPGEN]) == tg, bar);
            __builtin_amdgcn_fence(__ATOMIC_ACQUIRE, "agent");
            xb_add(&bar[XB_XGEN(b.x)], 1u);
            asm volatile("s_waitcnt vmcnt(0)" ::: "memory");
        } else {
            XB_SPIN(xb_ld(&bar[XB_XGEN(b.x)]) == gen, bar);
            __builtin_amdgcn_fence(__ATOMIC_ACQUIRE, "agent");
            asm volatile("s_waitcnt vmcnt(0)" ::: "memory");
        }
    }
    __syncthreads();
}

constexpr int CW_BAR = 4096, CW_TAIL = 16384;
struct Args { const float* in[34]; float* out; unsigned char* ws; int ph_lo, ph_hi, sub; };
enum { I_XP = 0, I_XS, I_SWKV, I_SSHIFT, I_SGDN, I_SCONV, I_CP, I_CS, I_N1W, I_N2W, I_WADA, I_BADA, I_WIN, I_RMU, I_RW0, I_RWW2, I_RA0, I_RWA2, I_RWG2, I_RKK, I_RKA, I_RRK, I_LNXW, I_LNXB, I_CONVW, I_ALOG, I_DTB, I_GNW, I_WOA, I_WOB, I_WOUT, I_WUP, I_WDOWN, I_FNW };
constexpr int NPHASE = 16;

__device__ __forceinline__ void transpose_item(const float* W, int N, int k0, int n0, bf16_t* WT, size_t dst_row0, int dst_ld, int dst_k0, LAS float* scr, int lane) {
    float xv[32];
#pragma unroll
    for (int i = 0; i < 32; ++i) { const int kk = 2 * i + (lane >> 5); xv[i] = W[(size_t)(k0 + kk) * N + n0 + (lane & 31)]; }
    __builtin_amdgcn_sched_barrier(0);
#pragma unroll
    for (int i = 0; i < 32; ++i) { const int kk = 2 * i + (lane >> 5); scr[kk * 33 + (lane & 31)] = xv[i]; }
    asm volatile("s_waitcnt lgkmcnt(0)" ::: "memory");
    const int c = lane & 7;
#pragma unroll
    for (int j = 0; j < 4; ++j) { const int n = (lane >> 3) + 8 * j; const LAS float* s = scr + (8 * c) * 33 + n;
        u32x4 o; o.x = pk2(s[0 * 33], s[1 * 33]); o.y = pk2(s[2 * 33], s[3 * 33]); o.z = pk2(s[4 * 33], s[5 * 33]); o.w = pk2(s[6 * 33], s[7 * 33]);
        *(u32x4*)(WT + (dst_row0 + n) * (size_t)dst_ld + dst_k0 + k0 + 8 * c) = o; }
    asm volatile("s_waitcnt lgkmcnt(0)" ::: "memory");
}

template <int MODE, bool IN_BF16>
__device__ __forceinline__ void norm_rows(const float* xp, const float* xs_, const float* nw, const float* mod, int sh_off, int sc_off, bf16_t* ob, float* of, int gw, int NGW, int lane) {
    constexpr int NR = IN_BF16 ? 8 : 16;
    f32x4 rc[NR], rn[NR];
#define NR_LOAD(R, mm) do { if (IN_BF16) { const bf16_t* xr_ = (const bf16_t*)xp + (size_t)(mm) * D; _Pragma("unroll") for (int j = 0; j < NR; ++j) R[j] = *(const f32x4*)(xr_ + (j * 64 + lane) * 8); } \
        else { const float* xr_ = ((mm) < NPROMPT ? xp + (size_t)(mm) * D : xs_ + (size_t)((mm) - NPROMPT) * D); _Pragma("unroll") for (int j = 0; j < NR; ++j) R[j] = *(const f32x4*)(xr_ + (j * 64 + lane) * 4); } } while (0)
    if (gw < MTOK) NR_LOAD(rc, gw);
    for (int m = gw; m < MTOK; m += NGW) {
        { const int mn = m + NGW < MTOK ? m + NGW : m; NR_LOAD(rn, mn); }
        f32x4 v[16]; float ss = 0.f;
        if (IN_BF16) {
#pragma unroll
            for (int j = 0; j < 8; ++j) { const u32x4 w = __builtin_bit_cast(u32x4, rc[j]); v[2 * j] = (f32x4){bflo(w.x), bfhi(w.x), bflo(w.y), bfhi(w.y)}; v[2 * j + 1] = (f32x4){bflo(w.z), bfhi(w.z), bflo(w.w), bfhi(w.w)}; }
        } else {
#pragma unroll
            for (int j = 0; j < 16; ++j) v[j] = rc[j < NR ? j : 0]; }
#pragma unroll
        for (int j = 0; j < 16; ++j) ss += (v[j].x * v[j].x + v[j].y * v[j].y) + (v[j].z * v[j].z + v[j].w * v[j].w);
        const float rstd = 1.0f / sqrtf(wave_sum(ss) * (1.0f / D) + 1e-6f);
        if (MODE == 0) {
            const int s = seq_of_row(m); const float* mr = mod + (size_t)s * NMOD;
#pragma unroll
            for (int j = 0; j < 16; ++j) { const int c = IN_BF16 ? ((j >> 1) * 64 + lane) * 8 + (j & 1) * 4 : (j * 64 + lane) * 4; const f32x4 w = *(const f32x4*)(nw + c), sc = *(const f32x4*)(mr + sc_off + c), sh = *(const f32x4*)(mr + sh_off + c);
                const f32x4 y = v[j] * rstd * w * (sc + 1.0f) + sh; u32x2 o; o.x = pk2(y.x, y.y); o.y = pk2(y.z, y.w); *(u32x2*)(ob + (size_t)m * D + c) = o; }
        } else {
#pragma unroll
            for (int j = 0; j < 16; ++j) { const int c = IN_BF16 ? ((j >> 1) * 64 + lane) * 8 + (j & 1) * 4 : (j * 64 + lane) * 4; const f32x4 w = *(const f32x4*)(nw + c); *(f32x4*)(of + (size_t)m * D + c) = v[j] * rstd * w; }
        }
#pragma unroll
        for (int j = 0; j < NR; ++j) rc[j] = rn[j];
    }
#undef NR_LOAD
}

#define RWKV_STEP(S, w4, kk4, b4, kp4, r4, vv, oo) do { \
    float sa_ = S.x * kk4.x + S.y * kk4.y + S.z * kk4.z + S.w * kk4.w; sa_ = -row16_sum(sa_); \
    S.x = S.x * w4.x + sa_ * b4.x + vv * kp4.x; S.y = S.y * w4.y + sa_ * b4.y + vv * kp4.y; S.z = S.z * w4.z + sa_ * b4.z + vv * kp4.z; S.w = S.w * w4.w + sa_ * b4.w + vv * kp4.w; \
    float o_ = S.x * r4.x + S.y * r4.y + S.z * r4.z + S.w * r4.w; oo = row16_sum(o_); } while (0)

struct RwStep { f32x4 w4, kk4, b4, kp4, r4; float vv; };
#define RW_LD(d, bk, bv, off) do { \
    asm volatile("ds_read_b128 %0, %1 offset:%2" : "=v"(d.w4) : "v"(bk), "n"((off))); asm volatile("ds_read_b128 %0, %1 offset:%2" : "=v"(d.kk4) : "v"(bk), "n"((off) + 256)); \
    asm volatile("ds_read_b128 %0, %1 offset:%2" : "=v"(d.b4) : "v"(bk), "n"((off) + 512)); asm volatile("ds_read_b128 %0, %1 offset:%2" : "=v"(d.kp4) : "v"(bk), "n"((off) + 768)); \
    asm volatile("ds_read_b128 %0, %1 offset:%2" : "=v"(d.r4) : "v"(bk), "n"((off) + 1024)); asm volatile("ds_read_b32 %0, %1 offset:%2" : "=v"(d.vv) : "v"(bv), "n"((off))); } while (0)
#define RW_WAIT(d, n) do { asm volatile("s_waitcnt lgkmcnt(" #n ")" : "+v"(d.w4), "+v"(d.kk4), "+v"(d.b4), "+v"(d.kp4), "+v"(d.r4), "+v"(d.vv)); __builtin_amdgcn_sched_barrier(0); } while (0)
#define RW_STEP(d, opart) do { \
    f32x2 p_ = S01 * (f32x2){d.kk4.x, d.kk4.y}; p_ = S23 * (f32x2){d.kk4.z, d.kk4.w} + p_; const float nsa_ = -row16_sum(p_.x + p_.y); \
    f32x2 t0_ = (f32x2){d.b4.x, d.b4.y} * nsa_, t1_ = (f32x2){d.b4.z, d.b4.w} * nsa_; \
    t0_ = S01 * (f32x2){d.w4.x, d.w4.y} + t0_; t1_ = S23 * (f32x2){d.w4.z, d.w4.w} + t1_; \
    S01 = (f32x2){d.kp4.x, d.kp4.y} * d.vv + t0_; S23 = (f32x2){d.kp4.z, d.kp4.w} * d.vv + t1_; \
    f32x2 q_ = S01 * (f32x2){d.r4.x, d.r4.y}; q_ = S23 * (f32x2){d.r4.z, d.r4.w} + q_; opart = q_.x + q_.y; } while (0)
__device__ __forceinline__ float swz_xor4(float x) { return __builtin_bit_cast(float, __builtin_amdgcn_ds_swizzle(__builtin_bit_cast(int, x), 0x101F)); }
__device__ __forceinline__ float swz_xor8(float x) { return __builtin_bit_cast(float, __builtin_amdgcn_ds_swizzle(__builtin_bit_cast(int, x), 0x201F)); }
__device__ __forceinline__ float transpose_reduce16(const float (&op)[16], int kq) {
    const bool b0 = kq & 1, b1 = kq & 2, b2 = kq & 4, b3 = kq & 8; float r1[8], r2[4], r3[2];
#pragma unroll
    for (int i = 0; i < 8; ++i) { const float a = op[2 * i], b = op[2 * i + 1]; r1[i] = (b0 ? b : a) + dppf<0xB1>(b0 ? a : b); }
#pragma unroll
    for (int i = 0; i < 4; ++i) { const float a = r1[2 * i], b = r1[2 * i + 1]; r2[i] = (b1 ? b : a) + dppf<0x4E>(b1 ? a : b); }
#pragma unroll
    for (int i = 0; i < 2; ++i) { const float a = r2[2 * i], b = r2[2 * i + 1]; r3[i] = (b2 ? b : a) + swz_xor4(b2 ? a : b); }
    return (b3 ? r3[1] : r3[0]) + swz_xor8(b3 ? r3[0] : r3[1]);
}
__device__ __forceinline__ void rwkv_prompt_item(LAS unsigned char* lds, const float* RS, float* OA, float* outS, int item, int w, int lane) {
    constexpr int CH = 16, CHB = CH * RREC * 4, NB = 5, NCH = TP / CH, RB = RREC * 4;
    const int bh = item >> 1, half = item & 1, b = bh >> 5, h = bh & 31, rg = lane >> 4, kq = lane & 15, row = half * 32 + w * 4 + rg;
    const char* src = (const char*)(RS + (size_t)bh * TP * RREC);
#define RW_ISSUE(ci) do { const int cs_ = (ci) < NCH ? (ci) : NCH - 1; const int sl_ = (ci) % NB; _Pragma("unroll") for (int i_ = 0; i_ < 3; ++i_) { const int pc_ = w * 3 + i_; \
        __builtin_amdgcn_global_load_lds((const unsigned*)(src + (size_t)cs_ * CHB + pc_ * 1024 + lane * 16), (LAS unsigned*)(lds + sl_ * CHB + pc_ * 1024), 16, 0, 0); } } while (0)
    f32x2 S01 = (f32x2){0.f, 0.f}, S23 = (f32x2){0.f, 0.f};
#pragma unroll
    for (int ci = 0; ci < NB - 1; ++ci) RW_ISSUE(ci);
    asm volatile("s_waitcnt vmcnt(9)" ::: "memory"); __builtin_amdgcn_s_barrier(); asm volatile("" ::: "memory");
    const unsigned lbase = (unsigned)(size_t)lds;
    RwStep A, B; { const unsigned bk = lbase + kq * 16, bv = lbase + 1280 + row * 4; RW_LD(A, bk, bv, 0); }
    for (int ci = 0; ci < NCH; ++ci) {
        asm volatile("s_waitcnt vmcnt(6)" ::: "memory"); __builtin_amdgcn_s_barrier(); asm volatile("" ::: "memory");
        RW_ISSUE(ci + NB - 1);
        const unsigned sl = lbase + (ci % NB) * CHB, nsl = lbase + ((ci + 1) % NB) * CHB;
        const unsigned bk = sl + kq * 16, bv = sl + 1280 + row * 4, nbk = nsl + kq * 16, nbv = nsl + 1280 + row * 4;
        float op[16];
#define RW_PAIR(st) do { RW_LD(B, bk, bv, ((st) + 1) * RB); RW_WAIT(A, 6); RW_STEP(A, op[st]); RW_LD(A, bk, bv, ((st) + 2) * RB); RW_WAIT(B, 6); RW_STEP(B, op[(st) + 1]); } while (0)
        RW_PAIR(0); RW_PAIR(2); RW_PAIR(4); RW_PAIR(6); RW_PAIR(8); RW_PAIR(10); RW_PAIR(12);
        RW_LD(B, bk, bv, 15 * RB); RW_WAIT(A, 6); RW_STEP(A, op[14]); RW_LD(A, nbk, nbv, 0); RW_WAIT(B, 6); RW_STEP(B, op[15]);
#undef RW_PAIR
        OA[(size_t)(b * TP + ci * CH + kq) * RW + h * RH + row] = transpose_reduce16(op, kq);
    }
    *(f32x4*)(outS + ((size_t)bh * RH + row) * RH + 4 * kq) = (f32x4){S01.x, S01.y, S23.x, S23.y};
    asm volatile("s_waitcnt vmcnt(0) lgkmcnt(0)" ::: "memory"); __builtin_amdgcn_s_barrier(); asm volatile("" ::: "memory");
#undef RW_ISSUE
}
__device__ __forceinline__ void rwkv_sample_item(const float* RS, const float* S0, bf16_t* OA, float* outS, int item, int lane) {
    const int bh = item >> 2, q4 = item & 3, b = bh >> 5, h = bh & 31, rg = lane >> 4, kq = lane & 15;
    const float* rec = RS + ((size_t)BP * RHEADS * TP + (size_t)bh * TS) * RREC;
    f32x4 w4[4], kk4[4], b4[4], kp4[4], r4[4];
#pragma unroll
    for (int t = 0; t < 4; ++t) { const float* r = rec + t * RREC + 4 * kq; w4[t] = *(const f32x4*)(r); kk4[t] = *(const f32x4*)(r + 64); b4[t] = *(const f32x4*)(r + 128); kp4[t] = *(const f32x4*)(r + 192); r4[t] = *(const f32x4*)(r + 256); }
    f32x4 S[4]; float vv[4][4];
#pragma unroll
    for (int sub = 0; sub < 4; ++sub) { const int row = q4 * 16 + sub * 4 + rg; S[sub] = *(const f32x4*)(S0 + ((size_t)bh * RH + row) * RH + 4 * kq);
#pragma unroll
        for (int t = 0; t < 4; ++t) vv[sub][t] = rec[t * RREC + 320 + row]; }
#pragma unroll
    for (int sub = 0; sub < 4; ++sub) { const int row = q4 * 16 + sub * 4 + rg; float okeep = 0.f;
#pragma unroll
        for (int t = 0; t < 4; ++t) { float oo; RWKV_STEP(S[sub], w4[t], kk4[t], b4[t], kp4[t], r4[t], vv[sub][t], oo); okeep = (kq == t) ? oo : okeep; }
        if (kq < 4) OA[(size_t)(NPROMPT + b * TS + kq) * RW + h * RH + row] = (bf16_t)cvt2(okeep, 0.f);
        *(f32x4*)(outS + ((size_t)bh * RH + row) * RH + 4 * kq) = S[sub]; }
}
struct GdStep { f32x4 q0, q1, k0, k1, sc; float vv; };
#define GD_LD(d, bk, bv, bs, off) do { \
    asm volatile("ds_read_b128 %0, %1 offset:%2" : "=v"(d.q0) : "v"(bk), "n"((off))); asm volatile("ds_read_b128 %0, %1 offset:%2" : "=v"(d.q1) : "v"(bk), "n"((off) + 16)); \
    asm volatile("ds_read_b128 %0, %1 offset:%2" : "=v"(d.k0) : "v"(bk), "n"((off) + 512)); asm volatile("ds_read_b128 %0, %1 offset:%2" : "=v"(d.k1) : "v"(bk), "n"((off) + 528)); \
    asm volatile("ds_read_b128 %0, %1 offset:%2" : "=v"(d.sc) : "v"(bs), "n"((off) + 1536)); asm volatile("ds_read_b32 %0, %1 offset:%2" : "=v"(d.vv) : "v"(bv), "n"((off))); } while (0)
#define GD_WAIT(d, n) do { asm volatile("s_waitcnt lgkmcnt(" #n ")" : "+v"(d.q0), "+v"(d.q1), "+v"(d.k0), "+v"(d.k1), "+v"(d.sc), "+v"(d.vv)); __builtin_amdgcn_sched_barrier(0); } while (0)
#define GD_STEP(d, opart) do { \
    f32x2 p_ = S0 * (f32x2){d.k0.x, d.k0.y}; p_ = S1 * (f32x2){d.k0.z, d.k0.w} + p_; p_ = S2 * (f32x2){d.k1.x, d.k1.y} + p_; p_ = S3 * (f32x2){d.k1.z, d.k1.w} + p_; \
    f32x2 q_ = S0 * (f32x2){d.q0.x, d.q0.y}; q_ = S1 * (f32x2){d.q0.z, d.q0.w} + q_; q_ = S2 * (f32x2){d.q1.x, d.q1.y} + q_; q_ = S3 * (f32x2){d.q1.z, d.q1.w} + q_; \
    const float ks_ = row16_sum(p_.x + p_.y); const float u_ = d.sc.y * (d.vv - d.sc.x * ks_); opart = d.sc.x * (q_.x + q_.y) + d.sc.w * u_; \
    S0 = S0 * d.sc.x + (f32x2){d.k0.x, d.k0.y} * u_; S1 = S1 * d.sc.x + (f32x2){d.k0.z, d.k0.w} * u_; S2 = S2 * d.sc.x + (f32x2){d.k1.x, d.k1.y} * u_; S3 = S3 * d.sc.x + (f32x2){d.k1.z, d.k1.w} * u_; } while (0)
__device__ __forceinline__ void gdn_prompt_item(LAS unsigned char* lds, const float* GS, float* OB, float* outS, int item, int w, int lane) {
    constexpr int CH = 16, CHB = CH * GREC * 4, NB = 5, NCH = TP / CH, NPIECE = CHB / 1024, GB = GREC * 4;
    const int bh = item >> 2, qd = item & 3, b = bh >> 4, h = bh & 15, cc = lane >> 4, dq = lane & 15, col = qd * 32 + w * 4 + cc;
    const char* src = (const char*)(GS + (size_t)bh * TP * GREC);
#define GD_ISSUE(ci) do { const int cs_ = (ci) < NCH ? (ci) : NCH - 1; const int sl_ = (ci) % NB; _Pragma("unroll") for (int i_ = 0; i_ < 4; ++i_) { int pc_ = w * 4 + i_; pc_ = pc_ < NPIECE ? pc_ : NPIECE - 1; \
        __builtin_amdgcn_global_load_lds((const unsigned*)(src + (size_t)cs_ * CHB + pc_ * 1024 + lane * 16), (LAS unsigned*)(lds + sl_ * CHB + pc_ * 1024), 16, 0, 0); } } while (0)
    f32x2 S0 = (f32x2){0.f, 0.f}, S1 = S0, S2 = S0, S3 = S0;
#pragma unroll
    for (int ci = 0; ci < NB - 1; ++ci) GD_ISSUE(ci);
    asm volatile("s_waitcnt vmcnt(12)" ::: "memory"); __builtin_amdgcn_s_barrier(); asm volatile("" ::: "memory");
    const unsigned lbase = (unsigned)(size_t)lds;
    GdStep A, B; { const unsigned bk = lbase + dq * 32, bv = lbase + 1024 + col * 4; GD_LD(A, bk, bv, lbase, 0); }
    for (int ci = 0; ci < NCH; ++ci) {
        asm volatile("s_waitcnt vmcnt(8)" ::: "memory"); __builtin_amdgcn_s_barrier(); asm volatile("" ::: "memory");
        GD_ISSUE(ci + NB - 1);
        const unsigned sl = lbase + (ci % NB) * CHB, nsl = lbase + ((ci + 1) % NB) * CHB;
        const unsigned bk = sl + dq * 32, bv = sl + 1024 + col * 4, nbk = nsl + dq * 32, nbv = nsl + 1024 + col * 4;
        float op[16];
#define GD_PAIR(st) do { GD_LD(B, bk, bv, sl, ((st) + 1) * GB); GD_WAIT(A, 6); GD_STEP(A, op[st]); GD_LD(A, bk, bv, sl, ((st) + 2) * GB); GD_WAIT(B, 6); GD_STEP(B, op[(st) + 1]); } while (0)
        GD_PAIR(0); GD_PAIR(2); GD_PAIR(4); GD_PAIR(6); GD_PAIR(8); GD_PAIR(10); GD_PAIR(12);
        GD_LD(B, bk, bv, sl, 15 * GB); GD_WAIT(A, 6); GD_STEP(A, op[14]); GD_LD(A, nbk, nbv, nsl, 0); GD_WAIT(B, 6); GD_STEP(B, op[15]);
#undef GD_PAIR
        OB[(size_t)(b * TP + ci * CH + dq) * GW + h * GH + col] = transpose_reduce16(op, dq);
    }
    { const float Sv[8] = {S0.x, S0.y, S1.x, S1.y, S2.x, S2.y, S3.x, S3.y};
#pragma unroll
      for (int j = 0; j < 8; ++j) outS[((size_t)bh * GH + dq * 8 + j) * GH + col] = Sv[j]; }
    asm volatile("s_waitcnt vmcnt(0) lgkmcnt(0)" ::: "memory"); __builtin_amdgcn_s_barrier(); asm volatile("" ::: "memory");
#undef GD_ISSUE
}
struct Rw8 { f32x4 w0, w1, k0, k1, b0, b1, p0, p1, r0, r1; float vv; };
#define RW8_LD(d, bk, bv, off) do { \
    asm volatile("ds_read_b128 %0, %1 offset:%2" : "=v"(d.w0) : "v"(bk), "n"((off))); asm volatile("ds_read_b128 %0, %1 offset:%2" : "=v"(d.w1) : "v"(bk), "n"((off) + 16)); \
    asm volatile("ds_read_b128 %0, %1 offset:%2" : "=v"(d.k0) : "v"(bk), "n"((off) + 256)); asm volatile("ds_read_b128 %0, %1 offset:%2" : "=v"(d.k1) : "v"(bk), "n"((off) + 272)); \
    asm volatile("ds_read_b128 %0, %1 offset:%2" : "=v"(d.b0) : "v"(bk), "n"((off) + 512)); asm volatile("ds_read_b128 %0, %1 offset:%2" : "=v"(d.b1) : "v"(bk), "n"((off) + 528)); \
    asm volatile("ds_read_b128 %0, %1 offset:%2" : "=v"(d.p0) : "v"(bk), "n"((off) + 768)); asm volatile("ds_read_b128 %0, %1 offset:%2" : "=v"(d.p1) : "v"(bk), "n"((off) + 784)); \
    asm volatile("ds_read_b128 %0, %1 offset:%2" : "=v"(d.r0) : "v"(bk), "n"((off) + 1024)); asm volatile("ds_read_b128 %0, %1 offset:%2" : "=v"(d.r1) : "v"(bk), "n"((off) + 1040)); \
    asm volatile("ds_read_b32 %0, %1 offset:%2" : "=v"(d.vv) : "v"(bv), "n"((off))); } while (0)
#define RW8_WAIT(d) do { asm volatile("s_waitcnt lgkmcnt(11)" : "+v"(d.w0), "+v"(d.w1), "+v"(d.k0), "+v"(d.k1), "+v"(d.b0), "+v"(d.b1), "+v"(d.p0), "+v"(d.p1), "+v"(d.r0), "+v"(d.r1), "+v"(d.vv)); __builtin_amdgcn_sched_barrier(0); } while (0)
__device__ __forceinline__ float oct_sum(float x) { x += dppf<0xB1>(x); x += dppf<0x4E>(x); x += dppf<0x141>(x); return x; }
#define LO2(v) ((f32x2){(v).x, (v).y})
#define HI2(v) ((f32x2){(v).z, (v).w})
#define RW8_STEP(d, opart) do { \
    f32x2 p_ = R0 * LO2(d.k0); p_ = R1 * HI2(d.k0) + p_; p_ = R2 * LO2(d.k1) + p_; p_ = R3 * HI2(d.k1) + p_; const float nsa_ = -oct_sum(p_.x + p_.y); \
    f32x2 t0_ = LO2(d.b0) * nsa_, t1_ = HI2(d.b0) * nsa_, t2_ = LO2(d.b1) * nsa_, t3_ = HI2(d.b1) * nsa_; \
    t0_ = R0 * LO2(d.w0) + t0_; t1_ = R1 * HI2(d.w0) + t1_; t2_ = R2 * LO2(d.w1) + t2_; t3_ = R3 * HI2(d.w1) + t3_; \
    R0 = LO2(d.p0) * d.vv + t0_; R1 = HI2(d.p0) * d.vv + t1_; R2 = LO2(d.p1) * d.vv + t2_; R3 = HI2(d.p1) * d.vv + t3_; \
    f32x2 q_ = R0 * LO2(d.r0); q_ = R1 * HI2(d.r0) + q_; q_ = R2 * LO2(d.r1) + q_; q_ = R3 * HI2(d.r1) + q_; opart = q_.x + q_.y; } while (0)
struct Gd8 { f32x4 q0, q1, q2, q3, k0, k1, k2, k3, sc; float vv; };
#define GD8_LD(d, bk, bv, bs, off) do { \
    asm volatile("ds_read_b128 %0, %1 offset:%2" : "=v"(d.q0) : "v"(bk), "n"((off))); asm volatile("ds_read_b128 %0, %1 offset:%2" : "=v"(d.q1) : "v"(bk), "n"((off) + 16)); \
    asm volatile("ds_read_b128 %0, %1 offset:%2" : "=v"(d.q2) : "v"(bk), "n"((off) + 32)); asm volatile("ds_read_b128 %0, %1 offset:%2" : "=v"(d.q3) : "v"(bk), "n"((off) + 48)); \
    asm volatile("ds_read_b128 %0, %1 offset:%2" : "=v"(d.k0) : "v"(bk), "n"((off) + 512)); asm volatile("ds_read_b128 %0, %1 offset:%2" : "=v"(d.k1) : "v"(bk), "n"((off) + 528)); \
    asm volatile("ds_read_b128 %0, %1 offset:%2" : "=v"(d.k2) : "v"(bk), "n"((off) + 544)); asm volatile("ds_read_b128 %0, %1 offset:%2" : "=v"(d.k3) : "v"(bk), "n"((off) + 560)); \
    asm volatile("ds_read_b128 %0, %1 offset:%2" : "=v"(d.sc) : "v"(bs), "n"((off) + 1536)); asm volatile("ds_read_b32 %0, %1 offset:%2" : "=v"(d.vv) : "v"(bv), "n"((off))); } while (0)
#define GD8_WAIT(d) do { asm volatile("s_waitcnt lgkmcnt(10)" : "+v"(d.q0), "+v"(d.q1), "+v"(d.q2), "+v"(d.q3), "+v"(d.k0), "+v"(d.k1), "+v"(d.k2), "+v"(d.k3), "+v"(d.sc), "+v"(d.vv)); __builtin_amdgcn_sched_barrier(0); } while (0)
#define GD8_STEP(d, opart) do { \
    f32x2 p_ = G0 * LO2(d.k0); p_ = G1 * HI2(d.k0) + p_; p_ = G2 * LO2(d.k1) + p_; p_ = G3 * HI2(d.k1) + p_; p_ = G4 * LO2(d.k2) + p_; p_ = G5 * HI2(d.k2) + p_; p_ = G6 * LO2(d.k3) + p_; p_ = G7 * HI2(d.k3) + p_; \
    f32x2 q_ = G0 * LO2(d.q0); q_ = G1 * HI2(d.q0) + q_; q_ = G2 * LO2(d.q1) + q_; q_ = G3 * HI2(d.q1) + q_; q_ = G4 * LO2(d.q2) + q_; q_ = G5 * HI2(d.q2) + q_; q_ = G6 * LO2(d.q3) + q_; q_ = G7 * HI2(d.q3) + q_; \
    const float ks_ = oct_sum(p_.x + p_.y); const float u_ = d.sc.y * (d.vv - d.sc.x * ks_); opart = d.sc.x * (q_.x + q_.y) + d.sc.w * u_; \
    G0 = G0 * d.sc.x + LO2(d.k0) * u_; G1 = G1 * d.sc.x + HI2(d.k0) * u_; G2 = G2 * d.sc.x + LO2(d.k1) * u_; G3 = G3 * d.sc.x + HI2(d.k1) * u_; \
    G4 = G4 * d.sc.x + LO2(d.k2) * u_; G5 = G5 * d.sc.x + HI2(d.k2) * u_; G6 = G6 * d.sc.x + LO2(d.k3) * u_; G7 = G7 * d.sc.x + HI2(d.k3) * u_; } while (0)
__device__ __forceinline__ float transpose_reduce8(const float (&op)[8], int k8) {
    const bool b0 = k8 & 1, b1 = k8 & 2, b2 = k8 & 4; float r1[4], r2[2];
#pragma unroll
    for (int i = 0; i < 4; ++i) { const float a = op[2 * i], b = op[2 * i + 1]; r1[i] = (b0 ? b : a) + dppf<0xB1>(b0 ? a : b); }
#pragma unroll
    for (int i = 0; i < 2; ++i) { const float a = r1[2 * i], b = r1[2 * i + 1]; r2[i] = (b1 ? b : a) + dppf<0x4E>(b1 ? a : b); }
    return (b2 ? r2[1] : r2[0]) + swz_xor4(b2 ? r2[0] : r2[1]);
}
__device__ __forceinline__ void scan_prompt_split(LAS unsigned char* lds, const float* RS, const float* GS, float* OA, float* OB, float* outSR, float* outSG, int item, int w, int lane) {
    constexpr int CH = 8, RCB = CH * RREC * 4  , GCB = CH * GREC * 4  , GSL = 13312, SLB = RCB + GSL  , NB = 5, NCH = TP / CH, RB = RREC * 4, GB = GREC * 4;
    const int rbh = item >> 1, half = item & 1, gbh = item >> 2, qd = item & 3, g8 = lane >> 3, l8 = lane & 7;
    const char* rsrc = (const char*)(RS + (size_t)rbh * TP * RREC); const char* gsrc = (const char*)(GS + (size_t)gbh * TP * GREC);
#define SP_ISSUE(ci) do { const int cs_ = (ci) < NCH ? (ci) : NCH - 1; const int sl_ = (ci) % NB; _Pragma("unroll") for (int i_ = 0; i_ < 4; ++i_) { int pc_ = w * 4 + i_; pc_ = pc_ < 25 ? pc_ : 24; \
        const char* g_ = pc_ < 12 ? rsrc + (size_t)cs_ * RCB + pc_ * 1024 : gsrc + (size_t)cs_ * GCB + (pc_ - 12) * 1024; \
        __builtin_amdgcn_global_load_lds((const unsigned*)(g_ + lane * 16), (LAS unsigned*)(lds + sl_ * SLB + pc_ * 1024), 16, 0, 0); } } while (0)
#define SP_TOP() do { asm volatile("s_waitcnt vmcnt(8)" ::: "memory"); __builtin_amdgcn_s_barrier(); asm volatile("" ::: "memory"); SP_ISSUE(ci + NB - 1); } while (0)
#pragma unroll
    for (int ci = 0; ci < NB - 1; ++ci) SP_ISSUE(ci);
    asm volatile("s_waitcnt vmcnt(12)" ::: "memory"); __builtin_amdgcn_s_barrier(); asm volatile("" ::: "memory");
    const unsigned lbase = (unsigned)(size_t)lds;
    if (w < 4) {
        const int rb = rbh >> 5, rh = rbh & 31, row = half * 32 + w * 8 + g8;
        f32x2 R0 = (f32x2){0.f, 0.f}, R1 = R0, R2 = R0, R3 = R0;
        Rw8 A, B; RW8_LD(A, lbase + l8 * 32, lbase + 1280 + row * 4, 0);
        for (int ci = 0; ci < NCH; ++ci) {
            SP_TOP();
            const unsigned sl = lbase + (ci % NB) * SLB, nsl = lbase + ((ci + 1) % NB) * SLB, bk = sl + l8 * 32, bv = sl + 1280 + row * 4, nbk = nsl + l8 * 32, nbv = nsl + 1280 + row * 4;
            float op[8];
            RW8_LD(B, bk, bv, 1 * RB); RW8_WAIT(A); RW8_STEP(A, op[0]); RW8_LD(A, bk, bv, 2 * RB); RW8_WAIT(B); RW8_STEP(B, op[1]);
            RW8_LD(B, bk, bv, 3 * RB); RW8_WAIT(A); RW8_STEP(A, op[2]); RW8_LD(A, bk, bv, 4 * RB); RW8_WAIT(B); RW8_STEP(B, op[3]);
            RW8_LD(B, bk, bv, 5 * RB); RW8_WAIT(A); RW8_STEP(A, op[4]); RW8_LD(A, bk, bv, 6 * RB); RW8_WAIT(B); RW8_STEP(B, op[5]);
            RW8_LD(B, bk, bv, 7 * RB); RW8_WAIT(A); RW8_STEP(A, op[6]); RW8_LD(A, nbk, nbv, 0); RW8_WAIT(B); RW8_STEP(B, op[7]);
            OA[(size_t)(rb * TP + ci * CH + l8) * RW + rh * RH + row] = transpose_reduce8(op, l8);
        }
        float* so = outSR + ((size_t)rbh * RH + row) * RH + 8 * l8;
        *(f32x4*)so = (f32x4){R0.x, R0.y, R1.x, R1.y}; *(f32x4*)(so + 4) = (f32x4){R2.x, R2.y, R3.x, R3.y};
    } else {
        const int gb = gbh >> 4, gh = gbh & 15, col = qd * 32 + (w - 4) * 8 + g8;
        f32x2 G0 = (f32x2){0.f, 0.f}, G1 = G0, G2 = G0, G3 = G0, G4 = G0, G5 = G0, G6 = G0, G7 = G0;
        Gd8 A, B; { const unsigned gs0 = lbase + RCB; GD8_LD(A, gs0 + l8 * 64, gs0 + 1024 + col * 4, gs0, 0); }
        for (int ci = 0; ci < NCH; ++ci) {
            SP_TOP();
            const unsigned gs = lbase + (ci % NB) * SLB + RCB, ngs = lbase + ((ci + 1) % NB) * SLB + RCB, bk = gs + l8 * 64, bv = gs + 1024 + col * 4, nbk = ngs + l8 * 64, nbv = ngs + 1024 + col * 4;
            float op[8];
            GD8_LD(B, bk, bv, gs, 1 * GB); GD8_WAIT(A); GD8_STEP(A, op[0]); GD8_LD(A, bk, bv, gs, 2 * GB); GD8_WAIT(B); GD8_STEP(B, op[1]);
            GD8_LD(B, bk, bv, gs, 3 * GB); GD8_WAIT(A); GD8_STEP(A, op[2]); GD8_LD(A, bk, bv, gs, 4 * GB); GD8_WAIT(B); GD8_STEP(B, op[3]);
            GD8_LD(B, bk, bv, gs, 5 * GB); GD8_WAIT(A); GD8_STEP(A, op[4]); GD8_LD(A, bk, bv, gs, 6 * GB); GD8_WAIT(B); GD8_STEP(B, op[5]);
            GD8_LD(B, bk, bv, gs, 7 * GB); GD8_WAIT(A); GD8_STEP(A, op[6]); GD8_LD(A, nbk, nbv, ngs, 0); GD8_WAIT(B); GD8_STEP(B, op[7]);
            OB[(size_t)(gb * TP + ci * CH + l8) * GW + gh * GH + col] = transpose_reduce8(op, l8);
        }
        const float Sv[16] = {G0.x, G0.y, G1.x, G1.y, G2.x, G2.y, G3.x, G3.y, G4.x, G4.y, G5.x, G5.y, G6.x, G6.y, G7.x, G7.y};
#pragma unroll
        for (int j = 0; j < 16; ++j) outSG[((size_t)gbh * GH + l8 * 16 + j) * GH + col] = Sv[j];
    }
    asm volatile("s_waitcnt vmcnt(0) lgkmcnt(0)" ::: "memory"); __builtin_amdgcn_s_barrier(); asm volatile("" ::: "memory");
#undef SP_ISSUE
#undef SP_TOP
}
__device__ __forceinline__ void gdn_sample_item(LAS float* scr, const float* GS, const float* S0, bf16_t* OB, float* outS, int item, int lane) {
    const int bh = item >> 2, qd = item & 3, b = bh >> 4, h = bh & 15, hf = lane >> 5, col = qd * 32 + (lane & 31);
    const float* rec = GS + ((size_t)BP * GHEADS * TP + (size_t)bh * TS) * GREC;
#pragma unroll
    for (int i = 0; i < 25; ++i) scr[i * 64 + lane] = rec[i * 64 + lane];
    float S[64];
    const float* s0 = S0 + ((size_t)bh * GH + hf * 64) * GH + col;
#pragma unroll
    for (int j = 0; j < 64; ++j) S[j] = s0[(size_t)j * GH];
    asm volatile("s_waitcnt lgkmcnt(0)" ::: "memory");
#pragma unroll
    for (int t = 0; t < 4; ++t) { const LAS float* r = scr + t * GREC;
        float ks = 0.f, qs = 0.f;
#pragma unroll
        for (int j4 = 0; j4 < 16; ++j4) { const f32x4 q4 = *(const LAS f32x4*)(r + hf * 64 + j4 * 4), k4 = *(const LAS f32x4*)(r + 128 + hf * 64 + j4 * 4);
            ks += S[j4 * 4] * k4.x + S[j4 * 4 + 1] * k4.y + S[j4 * 4 + 2] * k4.z + S[j4 * 4 + 3] * k4.w; qs += S[j4 * 4] * q4.x + S[j4 * 4 + 1] * q4.y + S[j4 * 4 + 2] * q4.z + S[j4 * 4 + 3] * q4.w; }
        ks += __shfl_xor(ks, 32); qs += __shfl_xor(qs, 32);
        const float vv = r[256 + col]; const f32x4 sc = *(const LAS f32x4*)(r + 384);
        const float u = sc.y * (vv - sc.x * ks), oo = sc.x * qs + sc.z * u;
#pragma unroll
        for (int j4 = 0; j4 < 16; ++j4) { const f32x4 k4 = *(const LAS f32x4*)(r + 128 + hf * 64 + j4 * 4);
            S[j4 * 4] = sc.x * S[j4 * 4] + k4.x * u; S[j4 * 4 + 1] = sc.x * S[j4 * 4 + 1] + k4.y * u; S[j4 * 4 + 2] = sc.x * S[j4 * 4 + 2] + k4.z * u; S[j4 * 4 + 3] = sc.x * S[j4 * 4 + 3] + k4.w * u; }
        if (hf == 0) OB[(size_t)(NPROMPT + b * TS + t) * GW + h * GH + col] = (bf16_t)cvt2(oo, 0.f); }
    float* so = outS + ((size_t)bh * GH + hf * 64) * GH + col;
#pragma unroll
    for (int j = 0; j < 64; ++j) so[(size_t)j * GH] = S[j];
    asm volatile("s_waitcnt lgkmcnt(0)" ::: "memory");
}

typedef float f32x16 __attribute__((ext_vector_type(16)));
__device__ __forceinline__ int rowperm(int reg, int h) { return (reg & 3) + 8 * (reg >> 2) + 4 * h; }
typedef __bf16 bf16x2n __attribute__((ext_vector_type(2)));
__device__ __forceinline__ unsigned cvt2(float lo, float hi) { const f32x2 v = (f32x2){lo, hi}; return __builtin_bit_cast(unsigned, __builtin_convertvector(v, bf16x2n)); }
__device__ __forceinline__ bf16x8 pack8(f32x4 a, f32x4 b) { u32x4 w; w.x = cvt2(a.x, a.y); w.y = cvt2(a.z, a.w); w.z = cvt2(b.x, b.y); w.w = cvt2(b.z, b.w); return __builtin_bit_cast(bf16x8, w); }
#define MFMA32(a, b, c) __builtin_amdgcn_mfma_f32_32x32x16_bf16(a, b, c, 0, 0, 0)
constexpr int CK_WK = 0, CK_QG = 8192, CK_KT = 16384, CK_ATT = 24576, CK_FR = 26624, CK_UB = 8192, NCHUNK = BP * GHEADS * (TP / 32);
static_assert((size_t)NCHUNK * (CK_FR + CK_UB) <= (size_t)MTOK * D * 4, "chunk data fits the y region of d_out");
__device__ __forceinline__ void gdn_chunk_prep(LAS unsigned char* wl, const unsigned char* chunk, unsigned char* fr, unsigned char* ub, float* cdp, int lane) {
    const int r = lane & 31, h = lane >> 5;
    LAS bf16_t* kL = (LAS bf16_t*)wl; LAS float* Lm = (LAS float*)(wl + 8192); LAS float* gL = (LAS float*)(wl + 12288);
    const unsigned char* rec = chunk + r * GRB;
    const f32x4 scv = *(const f32x4*)(rec + 768); const float beta_r = scv.y, la_r = scv.w;
    float g = la_r;
#pragma unroll
    for (int d = 1; d < 32; d <<= 1) { const float t = __shfl_up(g, d, 32); if (r >= d) g += t; }
    const float glast = __shfl(g, 31, 32), e_r = __expf(g);
    if (h == 0) { gL[r] = g; gL[32 + r] = beta_r; gL[64 + r] = e_r * beta_r; gL[96 + r] = __expf(glast - g); }
    if (lane == 0) *cdp = __expf(glast);
    f32x16 d1;
#pragma unroll
    for (int i = 0; i < 16; ++i) d1[i] = 0.f;
#pragma unroll
    for (int blk = 0; blk < 8; ++blk) {
        const u32x2 ka = *(const u32x2*)(rec + 256 + 2 * (16 * blk + 4 * h)), kb4 = *(const u32x2*)(rec + 256 + 2 * (16 * blk + 8 + 4 * h));
        const bf16x8 kf = __builtin_bit_cast(bf16x8, (u32x4){ka.x, ka.y, kb4.x, kb4.y});
        *(LAS u32x2*)(kL + r * 128 + 16 * blk + 4 * h) = ka; *(LAS u32x2*)(kL + r * 128 + 16 * blk + 8 + 4 * h) = kb4;
        d1 = MFMA32(kf, kf, d1);
        if (blk & 1) asm volatile("" ::: "memory"); }
#pragma unroll
    for (int reg = 0; reg < 16; ++reg) { const int i = rowperm(reg, h); const float ex = (i > r) ? gL[i] - g : -1e30f; Lm[i * 32 + r] = d1[reg] * gL[32 + i] * __expf(ex); }
    for (int i = 0; i < 32; ++i) { float acc = (i == r) ? 1.f : 0.f;
        const int n4 = (i + 3) >> 2;
#pragma unroll 8
        for (int m4 = 0; m4 < n4; ++m4) { const f32x4 l4 = *(const LAS f32x4*)(Lm + i * 32 + 4 * m4);
            acc -= l4.x * Lm[(4 * m4) * 32 + r] + l4.y * Lm[(4 * m4 + 1) * 32 + r] + l4.z * Lm[(4 * m4 + 2) * 32 + r] + l4.w * Lm[(4 * m4 + 3) * 32 + r]; }
        Lm[i * 32 + r] = acc; }
    bf16x8 tmf[2];
#pragma unroll
    for (int s = 0; s < 2; ++s) tmf[s] = pack8(*(const LAS f32x4*)(Lm + r * 32 + 16 * s + 8 * h), *(const LAS f32x4*)(Lm + r * 32 + 16 * s + 8 * h + 4));
    { bf16x8 vf[4][2];
      const unsigned char* vb = chunk + (size_t)(8 * h) * GRB + 512 + 2 * r; const LAS float* bl = gL + 32 + 8 * h;
#pragma unroll
      for (int s = 0; s < 2; ++s) { float x[4][8];
#pragma unroll
          for (int jj = 0; jj < 8; ++jj) { const unsigned char* vp = vb + (16 * s + jj) * GRB; const float bt = bl[16 * s + jj];
#pragma unroll
              for (int sl = 0; sl < 4; ++sl) x[sl][jj] = bf2f(*(const unsigned short*)(vp + 64 * sl)) * bt; }
#pragma unroll
          for (int sl = 0; sl < 4; ++sl) vf[sl][s] = pack8((f32x4){x[sl][0], x[sl][1], x[sl][2], x[sl][3]}, (f32x4){x[sl][4], x[sl][5], x[sl][6], x[sl][7]});
          asm volatile("" ::: "memory"); }
#pragma unroll
      for (int sl = 0; sl < 4; ++sl) { f32x16 u;
#pragma unroll
          for (int i = 0; i < 16; ++i) u[i] = 0.f;
          u = MFMA32(tmf[0], vf[sl][0], u); u = MFMA32(tmf[1], vf[sl][1], u);
          ((bf16x8*)ub)[(sl * 64 + lane) * 2] = pack8((f32x4){u[0], u[1], u[2], u[3]}, (f32x4){u[4], u[5], u[6], u[7]});
          ((bf16x8*)ub)[(sl * 64 + lane) * 2 + 1] = pack8((f32x4){u[8], u[9], u[10], u[11]}, (f32x4){u[12], u[13], u[14], u[15]}); }
      asm volatile("" ::: "memory"); }
    f32x16 d2;
#pragma unroll
    for (int i = 0; i < 16; ++i) d2[i] = 0.f;
#pragma unroll
    for (int blk = 0; blk < 8; ++blk) {
        const u32x2 qaw = *(const u32x2*)(rec + 2 * (16 * blk + 4 * h)), qbw = *(const u32x2*)(rec + 2 * (16 * blk + 8 + 4 * h));
        const u32x2 k0 = *(const LAS u32x2*)(kL + r * 128 + 16 * blk + 4 * h), k1 = *(const LAS u32x2*)(kL + r * 128 + 16 * blk + 8 + 4 * h);
        d2 = MFMA32(__builtin_bit_cast(bf16x8, (u32x4){k0.x, k0.y, k1.x, k1.y}), __builtin_bit_cast(bf16x8, (u32x4){qaw.x, qaw.y, qbw.x, qbw.y}), d2);
        const f32x4 qa = (f32x4){bflo(qaw.x), bfhi(qaw.x), bflo(qaw.y), bfhi(qaw.y)}, qb = (f32x4){bflo(qbw.x), bfhi(qbw.x), bflo(qbw.y), bfhi(qbw.y)};
        ((bf16x8*)(fr + CK_QG))[blk * 64 + lane] = pack8(qa * e_r, qb * e_r);
        if (blk & 1) asm volatile("" ::: "memory"); }
#pragma unroll
    for (int s = 0; s < 2; ++s) { float x[8];
#pragma unroll
        for (int jj = 0; jj < 8; ++jj) { const int j = rowperm(8 * s + jj, h); const float ex = (r >= j) ? g - gL[j] : -1e30f; x[jj] = d2[8 * s + jj] * __expf(ex); }
        ((bf16x8*)(fr + CK_ATT))[s * 64 + lane] = pack8((f32x4){x[0], x[1], x[2], x[3]}, (f32x4){x[4], x[5], x[6], x[7]}); }
    asm volatile("" ::: "memory");
#pragma unroll
    for (int kb = 0; kb < 4; ++kb) { f32x16 wv;
#pragma unroll
        for (int i = 0; i < 16; ++i) wv[i] = 0.f;
#pragma unroll
        for (int s = 0; s < 2; ++s) { float x[8];
#pragma unroll
            for (int jj = 0; jj < 8; ++jj) { const int tok = 16 * s + 8 * h + jj; x[jj] = bf2f(kL[tok * 128 + 32 * kb + r]) * gL[64 + tok]; }
            wv = MFMA32(pack8((f32x4){x[0], x[1], x[2], x[3]}, (f32x4){x[4], x[5], x[6], x[7]}), tmf[s], wv); }
#pragma unroll
        for (int s = 0; s < 2; ++s) { ((bf16x8*)(fr + CK_WK))[(kb * 2 + s) * 64 + lane] = pack8((f32x4){-wv[8 * s], -wv[8 * s + 1], -wv[8 * s + 2], -wv[8 * s + 3]}, (f32x4){-wv[8 * s + 4], -wv[8 * s + 5], -wv[8 * s + 6], -wv[8 * s + 7]});
            float x[8];
#pragma unroll
            for (int jj = 0; jj < 8; ++jj) { const int tok = rowperm(8 * s + jj, h); x[jj] = bf2f(kL[tok * 128 + 32 * kb + r]) * gL[96 + tok]; }
            ((bf16x8*)(fr + CK_KT))[(kb * 2 + s) * 64 + lane] = pack8((f32x4){x[0], x[1], x[2], x[3]}, (f32x4){x[4], x[5], x[6], x[7]}); }
        asm volatile("" ::: "memory"); }
    asm volatile("s_waitcnt lgkmcnt(0)" ::: "memory");
}
__device__ __forceinline__ void gdn_mfma_wave(const unsigned char* FR, const unsigned char* UB, const float* CD, bf16_t* OB, float* outS, int witem, int lane) {
    const int bh = witem >> 2, sl = witem & 3, b = bh >> 4, hh = bh & 15, r = lane & 31, h = lane >> 5;
    f32x16 S[4];
#pragma unroll
    for (int kb = 0; kb < 4; ++kb)
#pragma unroll
        for (int i = 0; i < 16; ++i) S[kb][i] = 0.f;
    for (int cc = 0; cc < TP / 32; ++cc) {
        const int ch = bh * (TP / 32) + cc;
        const unsigned char* ck = FR + (size_t)ch * CK_FR;
        const float cd = CD[ch];
        f32x16 vn, o;
        { const u32x4 u0 = ((const u32x4*)(UB + (size_t)ch * CK_UB))[(sl * 64 + lane) * 2], u1 = ((const u32x4*)(UB + (size_t)ch * CK_UB))[(sl * 64 + lane) * 2 + 1];
          vn[0] = bflo(u0.x); vn[1] = bfhi(u0.x); vn[2] = bflo(u0.y); vn[3] = bfhi(u0.y); vn[4] = bflo(u0.z); vn[5] = bfhi(u0.z); vn[6] = bflo(u0.w); vn[7] = bfhi(u0.w);
          vn[8] = bflo(u1.x); vn[9] = bfhi(u1.x); vn[10] = bflo(u1.y); vn[11] = bfhi(u1.y); vn[12] = bflo(u1.z); vn[13] = bfhi(u1.z); vn[14] = bflo(u1.w); vn[15] = bfhi(u1.w); }
#pragma unroll
        for (int reg = 0; reg < 16; ++reg) o[reg] = 0.f;
#pragma unroll
        for (int kb = 0; kb < 4; ++kb)
#pragma unroll
            for (int s = 0; s < 2; ++s) { const bf16x8 sf = pack8((f32x4){S[kb][8 * s], S[kb][8 * s + 1], S[kb][8 * s + 2], S[kb][8 * s + 3]}, (f32x4){S[kb][8 * s + 4], S[kb][8 * s + 5], S[kb][8 * s + 6], S[kb][8 * s + 7]});
                vn = MFMA32(((const bf16x8*)(ck + CK_WK))[(kb * 2 + s) * 64 + lane], sf, vn); o = MFMA32(((const bf16x8*)(ck + CK_QG))[(kb * 2 + s) * 64 + lane], sf, o); }
        bf16x8 vf[2];
#pragma unroll
        for (int s = 0; s < 2; ++s) { vf[s] = pack8((f32x4){vn[8 * s], vn[8 * s + 1], vn[8 * s + 2], vn[8 * s + 3]}, (f32x4){vn[8 * s + 4], vn[8 * s + 5], vn[8 * s + 6], vn[8 * s + 7]});
            o = MFMA32(((const bf16x8*)(ck + CK_ATT))[s * 64 + lane], vf[s], o); }
#pragma unroll
        for (int kb = 0; kb < 4; ++kb) { S[kb] = S[kb] * cd;
#pragma unroll
            for (int s = 0; s < 2; ++s) S[kb] = MFMA32(((const bf16x8*)(ck + CK_KT))[(kb * 2 + s) * 64 + lane], vf[s], S[kb]); }
#pragma unroll
        for (int reg = 0; reg < 16; ++reg) OB[(size_t)(b * TP + cc * 32 + rowperm(reg, h)) * GW + hh * GH + sl * 32 + r] = (bf16_t)cvt2(o[reg], 0.f);
    }
#pragma unroll
    for (int kb = 0; kb < 4; ++kb)
#pragma unroll
        for (int reg = 0; reg < 16; ++reg) outS[((size_t)bh * GH + 32 * kb + rowperm(reg, h)) * GH + sl * 32 + r] = S[kb][reg];
}
constexpr int RK_WC = 0, RK_RG = 4096, RK_ARB = 8192, RK_BT = 10240, RK_ARK = 14336, RK_KPT = 16384, RK_UC = 20480, RK_BYTES = 24576, NRCHUNK = BP * RHEADS * (TP / 32);
static_assert(68 * MiB + (size_t)NRCHUNK * RK_BYTES <= (size_t)BP * RHEADS * TP * RREC * 4 && (size_t)BP * RHEADS * TP * RH * 4 <= 68 * MiB, "VCH and the RWKV chunk data fit the prompt part of the RSCAN region");
__device__ __forceinline__ bf16x8 words8(unsigned a, unsigned b, unsigned c, unsigned d) { return __builtin_bit_cast(bf16x8, (u32x4){a, b, c, d}); }
struct RwPrepIn { const bf16_t* P; const bf16_t* LWAG; const float* mu; const float* kkw; const float* kaw; const float* rkw; float* BON; unsigned char* VF; };
__device__ __forceinline__ f32x4 mix4(u32x2 c, u32x2 p, f32x4 m) { const f32x4 cv = (f32x4){bflo(c.x), bfhi(c.x), bflo(c.y), bfhi(c.y)}, pv = (f32x4){bflo(p.x), bfhi(p.x), bflo(p.y), bfhi(p.y)}; return cv + (pv - cv) * m; }
__device__ __forceinline__ void rwkv_chunk_prep(LAS unsigned char* wl, const RwPrepIn& I, int bh, int cc, unsigned char* rk, float* gc, int lane) {
    int r = lane & 31, h = lane >> 5;
    asm volatile("" : "+v"(r), "+v"(h));
    LAS bf16_t* KKgL = (LAS bf16_t*)wl; LAS bf16_t* BTL = (LAS bf16_t*)(wl + 4096); LAS bf16_t* KpTL = (LAS bf16_t*)(wl + 8192); LAS float* Lm = (LAS float*)(wl + 12288);
    const int b = bh >> 5, hh = bh & 31, t = cc * 32 + r, m = b * TP + t, cb = hh * RH; const bool hp = t > 0;
    const bf16_t* cur = I.P + (size_t)m * LDP + cb; const bf16_t* lw = I.LWAG + (size_t)m * LORA_N + cb; const bf16_t* prv = hp ? cur - LDP : cur; const unsigned pm_ = hp ? 0xffffffffu : 0u;
    float ss = 0.f;
#pragma unroll
    for (int blk = 0; blk < 4; ++blk) {
#pragma unroll
        for (int q = 0; q < 2; ++q) { const int c = 16 * blk + 4 * h + 8 * q;
            const u32x2 kc = *(const u32x2*)(cur + RW + c), kp = *(const u32x2*)(prv + RW + c) & pm_;
            const f32x4 kr = mix4(kc, kp, *(const f32x4*)(I.mu + RW + cb + c)) * *(const f32x4*)(I.kkw + cb + c); ss += kr.x * kr.x + kr.y * kr.y + kr.z * kr.z + kr.w * kr.w; } }
    asm volatile("" ::: "memory");
    ss += __shfl_xor(ss, 32);
    const float rinv = __builtin_amdgcn_rsqf(ss + 1e-6f); float bon = 0.f;
    f32x16 g1, g2, g3, g4;
#pragma unroll
    for (int i = 0; i < 16; ++i) { g1[i] = 0.f; g2[i] = 0.f; g3[i] = 0.f; g4[i] = 0.f; }
    u32x2 nw0, nw1, na0, na1, nrc0, nrp0, nrc1, nrp1, nkc0, nkp0, nkc1, nkp1;
#define RWP_LOAD(bq) do { const int c0_ = 16 * (bq) + 4 * h, c1_ = c0_ + 8; \
        nw0 = *(const u32x2*)(lw + c0_); nw1 = *(const u32x2*)(lw + c1_); na0 = *(const u32x2*)(lw + RW + c0_); na1 = *(const u32x2*)(lw + RW + c1_); \
        nrc0 = *(const u32x2*)(cur + c0_); nrp0 = *(const u32x2*)(prv + c0_) & pm_; nrc1 = *(const u32x2*)(cur + c1_); nrp1 = *(const u32x2*)(prv + c1_) & pm_; \
        nkc0 = *(const u32x2*)(cur + RW + c0_); nkp0 = *(const u32x2*)(prv + RW + c0_) & pm_; nkc1 = *(const u32x2*)(cur + RW + c1_); nkp1 = *(const u32x2*)(prv + RW + c1_) & pm_; } while (0)
    RWP_LOAD(0);
#pragma unroll 1
    for (int blk = 0; blk < 4; ++blk) {
        const int c0 = 16 * blk + 4 * h, c1 = c0 + 8;
        const u32x2 qw0 = nw0, qw1 = nw1, qa0 = na0, qa1 = na1, qrc0 = nrc0, qrp0 = nrp0, qrc1 = nrc1, qrp1 = nrp1, qkc0 = nkc0, qkp0 = nkp0, qkc1 = nkc1, qkp1 = nkp1;
        { const int bn = blk < 3 ? blk + 1 : 3; RWP_LOAD(bn); }
        const f32x4 w0 = cvt4(qw0), w1 = cvt4(qw1);
        const float wv8[8] = {w0.x, w0.y, w0.z, w0.w, w1.x, w1.y, w1.z, w1.w};
        float ep[8], en[8], eg[8], el[8], eG[8];
#pragma unroll
        for (int e = 0; e < 8; ++e) { float x = wv8[e];
            x += dppf<0x111>(x); x += dppf<0x112>(x); x += dppf<0x114>(x); x += dppf<0x118>(x);
            x += __builtin_bit_cast(float, __builtin_amdgcn_update_dpp(0, __builtin_bit_cast(int, x), 0x142, 0xa, 0xf, false));
            eg[e] = __expf(x); en[e] = __builtin_amdgcn_rcpf(eg[e]); ep[e] = eg[e] * __expf(-wv8[e]);
            eG[e] = __shfl(eg[e], 31, 32); el[e] = eG[e] * en[e]; }
        const f32x4 a0 = cvt4(qa0), a1 = cvt4(qa1);
        const f32x4 r0 = mix4(qrc0, qrp0, *(const f32x4*)(I.mu + cb + c0));
        const f32x4 r1 = mix4(qrc1, qrp1, *(const f32x4*)(I.mu + cb + c1));
        const f32x4 kx0 = mix4(qkc0, qkp0, *(const f32x4*)(I.mu + RW + cb + c0));
        const f32x4 kx1 = mix4(qkc1, qkp1, *(const f32x4*)(I.mu + RW + cb + c1));
        const f32x4 k0 = kx0 * *(const f32x4*)(I.kkw + cb + c0) * rinv, k1 = kx1 * *(const f32x4*)(I.kkw + cb + c1) * rinv;
        const f32x4 p0 = kx0 * ((a0 - 1.0f) * *(const f32x4*)(I.kaw + cb + c0) + 1.0f), p1 = kx1 * ((a1 - 1.0f) * *(const f32x4*)(I.kaw + cb + c1) + 1.0f);
        const f32x4 b0 = k0 * a0, b1 = k1 * a1;
        { const f32x4 q0 = r0 * p0 * *(const f32x4*)(I.rkw + cb + c0), q1 = r1 * p1 * *(const f32x4*)(I.rkw + cb + c1); bon += (q0.x + q0.y + q0.z + q0.w) + (q1.x + q1.y + q1.z + q1.w); }
        const bf16x8 kkg_ = pack8((f32x4){k0.x * ep[0], k0.y * ep[1], k0.z * ep[2], k0.w * ep[3]}, (f32x4){k1.x * ep[4], k1.y * ep[5], k1.z * ep[6], k1.w * ep[7]});
        const bf16x8 bi_ = pack8((f32x4){b0.x * en[0], b0.y * en[1], b0.z * en[2], b0.w * en[3]}, (f32x4){b1.x * en[4], b1.y * en[5], b1.z * en[6], b1.w * en[7]});
        const bf16x8 kpi_ = pack8((f32x4){p0.x * en[0], p0.y * en[1], p0.z * en[2], p0.w * en[3]}, (f32x4){p1.x * en[4], p1.y * en[5], p1.z * en[6], p1.w * en[7]});
        const bf16x8 rg_ = pack8((f32x4){r0.x * eg[0], r0.y * eg[1], r0.z * eg[2], r0.w * eg[3]}, (f32x4){r1.x * eg[4], r1.y * eg[5], r1.z * eg[6], r1.w * eg[7]});
        const bf16x8 btf = pack8((f32x4){-b0.x * el[0], -b0.y * el[1], -b0.z * el[2], -b0.w * el[3]}, (f32x4){-b1.x * el[4], -b1.y * el[5], -b1.z * el[6], -b1.w * el[7]});
        const bf16x8 ktf = pack8((f32x4){p0.x * el[0], p0.y * el[1], p0.z * el[2], p0.w * el[3]}, (f32x4){p1.x * el[4], p1.y * el[5], p1.z * el[6], p1.w * el[7]});
        const u32x4 kw = __builtin_bit_cast(u32x4, kkg_), bw = __builtin_bit_cast(u32x4, btf), pw = __builtin_bit_cast(u32x4, ktf);
        *(LAS u32x2*)(KKgL + r * 64 + c0) = (u32x2){kw.x, kw.y}; *(LAS u32x2*)(KKgL + r * 64 + c1) = (u32x2){kw.z, kw.w};
        *(LAS u32x2*)(BTL + r * 64 + c0) = (u32x2){bw.x, bw.y}; *(LAS u32x2*)(BTL + r * 64 + c1) = (u32x2){bw.z, bw.w};
        *(LAS u32x2*)(KpTL + r * 64 + c0) = (u32x2){pw.x, pw.y}; *(LAS u32x2*)(KpTL + r * 64 + c1) = (u32x2){pw.z, pw.w};
        ((bf16x8*)(rk + RK_RG))[blk * 64 + lane] = rg_;
        g1 = MFMA32(kkg_, bi_, g1); g2 = MFMA32(kpi_, kkg_, g2); g3 = MFMA32(bi_, rg_, g3); g4 = MFMA32(kpi_, rg_, g4);
        if (r == 31) { *(f32x4*)(gc + c0) = (f32x4){eG[0], eG[1], eG[2], eG[3]}; *(f32x4*)(gc + c1) = (f32x4){eG[4], eG[5], eG[6], eG[7]}; }
        asm volatile("" ::: "memory"); }
    bon += __shfl_xor(bon, 32);
    if (h == 0) I.BON[(size_t)m * RHEADS + hh] = bon;
#pragma unroll
    for (int reg = 0; reg < 16; ++reg) { const int t = rowperm(reg, h); Lm[t * 32 + r] = (t > r) ? g1[reg] : 0.f; }
    bf16x8 akkT[2];
#pragma unroll
    for (int s = 0; s < 2; ++s) { float x[8], y[8], z[8];
#pragma unroll
        for (int jj = 0; jj < 8; ++jj) { const int i = rowperm(8 * s + jj, h); x[jj] = (i < r) ? g2[8 * s + jj] : 0.f; y[jj] = (i <= r) ? -g3[8 * s + jj] : 0.f; z[jj] = (i <= r) ? g4[8 * s + jj] : 0.f; }
        akkT[s] = pack8((f32x4){x[0], x[1], x[2], x[3]}, (f32x4){x[4], x[5], x[6], x[7]});
        ((bf16x8*)(rk + RK_ARB))[s * 64 + lane] = pack8((f32x4){y[0], y[1], y[2], y[3]}, (f32x4){y[4], y[5], y[6], y[7]});
        ((bf16x8*)(rk + RK_ARK))[s * 64 + lane] = pack8((f32x4){z[0], z[1], z[2], z[3]}, (f32x4){z[4], z[5], z[6], z[7]}); }
    for (int i = 0; i < 32; ++i) { float acc = (i == r) ? 1.f : 0.f;
        const int n4 = (i + 3) >> 2;
#pragma unroll 8
        for (int m4 = 0; m4 < n4; ++m4) { const f32x4 l4 = *(const LAS f32x4*)(Lm + i * 32 + 4 * m4);
            acc -= l4.x * Lm[(4 * m4) * 32 + r] + l4.y * Lm[(4 * m4 + 1) * 32 + r] + l4.z * Lm[(4 * m4 + 2) * 32 + r] + l4.w * Lm[(4 * m4 + 3) * 32 + r]; }
        Lm[i * 32 + r] = acc; }
    bf16x8 tn[2], tp[2];
#pragma unroll
    for (int s = 0; s < 2; ++s) { tn[s] = pack8(*(const LAS f32x4*)(Lm + r * 32 + 16 * s + 8 * h), *(const LAS f32x4*)(Lm + r * 32 + 16 * s + 8 * h + 4));
        tp[s] = pack8(*(const LAS f32x4*)(Lm + r * 32 + 16 * s + 4 * h), *(const LAS f32x4*)(Lm + r * 32 + 16 * s + 8 + 4 * h)); }
#pragma unroll
    for (int kb = 0; kb < 2; ++kb) { f32x16 wv;
#pragma unroll
        for (int i = 0; i < 16; ++i) wv[i] = 0.f;
#pragma unroll
        for (int s = 0; s < 2; ++s) { unsigned wds[4];
#pragma unroll
            for (int j2 = 0; j2 < 4; ++j2) { const int t0 = 16 * s + 8 * h + 2 * j2; wds[j2] = (unsigned)KKgL[t0 * 64 + 32 * kb + r] | ((unsigned)KKgL[(t0 + 1) * 64 + 32 * kb + r] << 16); }
            wv = MFMA32(words8(wds[0], wds[1], wds[2], wds[3]), tn[s], wv); }
#pragma unroll
        for (int s = 0; s < 2; ++s) { ((bf16x8*)(rk + RK_WC))[(kb * 2 + s) * 64 + lane] = pack8((f32x4){wv[8 * s], wv[8 * s + 1], wv[8 * s + 2], wv[8 * s + 3]}, (f32x4){wv[8 * s + 4], wv[8 * s + 5], wv[8 * s + 6], wv[8 * s + 7]});
            unsigned bwd[4], pwd[4];
#pragma unroll
            for (int j2 = 0; j2 < 4; ++j2) { const int ta = rowperm(8 * s + 2 * j2, h), tb = rowperm(8 * s + 2 * j2 + 1, h);
                bwd[j2] = (unsigned)BTL[ta * 64 + 32 * kb + r] | ((unsigned)BTL[tb * 64 + 32 * kb + r] << 16); pwd[j2] = (unsigned)KpTL[ta * 64 + 32 * kb + r] | ((unsigned)KpTL[tb * 64 + 32 * kb + r] << 16); }
            ((bf16x8*)(rk + RK_BT))[(kb * 2 + s) * 64 + lane] = words8(bwd[0], bwd[1], bwd[2], bwd[3]);
            ((bf16x8*)(rk + RK_KPT))[(kb * 2 + s) * 64 + lane] = words8(pwd[0], pwd[1], pwd[2], pwd[3]); }
        asm volatile("" ::: "memory"); }
    { const bf16_t* vcol = I.P + (size_t)(b * TP + cc * 32 + 4 * h) * LDP + 2 * RW + cb + r; unsigned char* vfp = I.VF + ((size_t)bh * (TP / 32) + cc) * 4096;
#pragma unroll
      for (int sl = 0; sl < 2; ++sl) { f32x16 av; const float muv = I.mu[2 * RW + cb + 32 * sl + r];
#pragma unroll
          for (int i = 0; i < 16; ++i) av[i] = 0.f;
#pragma unroll
          for (int s = 0; s < 2; ++s) { float x[8];
#pragma unroll
              for (int g4 = 0; g4 < 2; ++g4) { const int tk = 8 * g4 + 16 * s;
                  float pv = (cc > 0 || 4 * h + tk > 0) ? bf2f(vcol[(ptrdiff_t)(tk - 1) * LDP + 32 * sl]) : 0.f;
#pragma unroll
                  for (int j = 0; j < 4; ++j) { const float cv = bf2f(vcol[(size_t)(tk + j) * LDP + 32 * sl]); x[4 * g4 + j] = cv + (pv - cv) * muv; pv = cv; } }
              const bf16x8 vf_ = pack8((f32x4){x[0], x[1], x[2], x[3]}, (f32x4){x[4], x[5], x[6], x[7]});
              ((bf16x8*)vfp)[(sl * 2 + s) * 64 + lane] = vf_;
              av = MFMA32(akkT[s], vf_, av); }
          f32x16 uc;
#pragma unroll
          for (int i = 0; i < 16; ++i) uc[i] = 0.f;
#pragma unroll
          for (int s = 0; s < 2; ++s) uc = MFMA32(tp[s], pack8((f32x4){av[8 * s], av[8 * s + 1], av[8 * s + 2], av[8 * s + 3]}, (f32x4){av[8 * s + 4], av[8 * s + 5], av[8 * s + 6], av[8 * s + 7]}), uc);
          ((bf16x8*)(rk + RK_UC))[(sl * 64 + lane) * 2] = pack8((f32x4){uc[0], uc[1], uc[2], uc[3]}, (f32x4){uc[4], uc[5], uc[6], uc[7]});
          ((bf16x8*)(rk + RK_UC))[(sl * 64 + lane) * 2 + 1] = pack8((f32x4){uc[8], uc[9], uc[10], uc[11]}, (f32x4){uc[12], uc[13], uc[14], uc[15]});
          asm volatile("" ::: "memory"); } }
    asm volatile("s_waitcnt lgkmcnt(0)" ::: "memory");
}
__device__ __forceinline__ void rwkv_mfma_wave(const unsigned char* RKD, const float* GC, const unsigned char* VF, bf16_t* OA, float* outSR, int witem, int lane) {
    const int bh = witem >> 1, vs = witem & 1, b = bh >> 5, hh = bh & 31, r = lane & 31, h = lane >> 5;
    f32x16 Z[2];
#pragma unroll
    for (int kb = 0; kb < 2; ++kb)
#pragma unroll
        for (int i = 0; i < 16; ++i) Z[kb][i] = 0.f;
    for (int cc = 0; cc < TP / 32; ++cc) {
        const int ch = bh * (TP / 32) + cc;
        const unsigned char* rk = RKD + (size_t)ch * RK_BYTES;
        const float* gcp = GC + (size_t)ch * 64 + 4 * h;
        f32x16 c, o;
        { const u32x4 u0 = ((const u32x4*)(rk + RK_UC))[(vs * 64 + lane) * 2], u1 = ((const u32x4*)(rk + RK_UC))[(vs * 64 + lane) * 2 + 1];
          c[0] = bflo(u0.x); c[1] = bfhi(u0.x); c[2] = bflo(u0.y); c[3] = bfhi(u0.y); c[4] = bflo(u0.z); c[5] = bfhi(u0.z); c[6] = bflo(u0.w); c[7] = bfhi(u0.w);
          c[8] = bflo(u1.x); c[9] = bfhi(u1.x); c[10] = bflo(u1.y); c[11] = bfhi(u1.y); c[12] = bflo(u1.z); c[13] = bfhi(u1.z); c[14] = bflo(u1.w); c[15] = bfhi(u1.w); }
#pragma unroll
        for (int i = 0; i < 16; ++i) o[i] = 0.f;
        bf16x8 vf[2];
#pragma unroll
        for (int s = 0; s < 2; ++s) vf[s] = ((const bf16x8*)(VF + (size_t)ch * 4096))[(vs * 2 + s) * 64 + lane];
#pragma unroll
        for (int kb = 0; kb < 2; ++kb)
#pragma unroll
            for (int s = 0; s < 2; ++s) { const bf16x8 zf = pack8((f32x4){Z[kb][8 * s], Z[kb][8 * s + 1], Z[kb][8 * s + 2], Z[kb][8 * s + 3]}, (f32x4){Z[kb][8 * s + 4], Z[kb][8 * s + 5], Z[kb][8 * s + 6], Z[kb][8 * s + 7]});
                c = MFMA32(((const bf16x8*)(rk + RK_WC))[(kb * 2 + s) * 64 + lane], zf, c); o = MFMA32(((const bf16x8*)(rk + RK_RG))[(kb * 2 + s) * 64 + lane], zf, o); }
        bf16x8 cf[2];
#pragma unroll
        for (int s = 0; s < 2; ++s) { cf[s] = pack8((f32x4){c[8 * s], c[8 * s + 1], c[8 * s + 2], c[8 * s + 3]}, (f32x4){c[8 * s + 4], c[8 * s + 5], c[8 * s + 6], c[8 * s + 7]});
            o = MFMA32(((const bf16x8*)(rk + RK_ARK))[s * 64 + lane], vf[s], o); o = MFMA32(((const bf16x8*)(rk + RK_ARB))[s * 64 + lane], cf[s], o); }
#pragma unroll
        for (int kb = 0; kb < 2; ++kb) {
#pragma unroll
            for (int reg = 0; reg < 16; ++reg) Z[kb][reg] *= gcp[32 * kb + (reg & 3) + 8 * (reg >> 2)];
#pragma unroll
            for (int s = 0; s < 2; ++s) { Z[kb] = MFMA32(((const bf16x8*)(rk + RK_KPT))[(kb * 2 + s) * 64 + lane], vf[s], Z[kb]); Z[kb] = MFMA32(((const bf16x8*)(rk + RK_BT))[(kb * 2 + s) * 64 + lane], cf[s], Z[kb]); } }
#pragma unroll
        for (int reg = 0; reg < 16; ++reg) OA[(size_t)(b * TP + cc * 32 + rowperm(reg, h)) * RW + hh * RH + vs * 32 + r] = (bf16_t)cvt2(o[reg], 0.f);
    }
#pragma unroll
    for (int kb = 0; kb < 2; ++kb)
#pragma unroll
        for (int reg = 0; reg < 16; ++reg) outSR[((size_t)bh * RH + vs * 32 + r) * RH + 32 * kb + rowperm(reg, h)] = Z[kb][reg];
}

__device__ __forceinline__ void spin_ge4(volatile LAS unsigned* p, unsigned need) {
    for (unsigned sp = 0;; ++sp) { const unsigned a = p[0], b = p[1], c = p[2], d = p[3]; if ((a >= need && b >= need && c >= need && d >= need) || sp > (1u << 24)) break; __builtin_amdgcn_s_sleep(1); }
}
struct Rw2 { f32x4 w4, kk4, b4, kp4, r4; float va, vb; };
#define RW2_LD(d, bk, bv, off) do { \
    asm volatile("ds_read_b128 %0, %1 offset:%2" : "=v"(d.w4) : "v"(bk), "n"((off))); asm volatile("ds_read_b128 %0, %1 offset:%2" : "=v"(d.kk4) : "v"(bk), "n"((off) + 256)); \
    asm volatile("ds_read_b128 %0, %1 offset:%2" : "=v"(d.b4) : "v"(bk), "n"((off) + 512)); asm volatile("ds_read_b128 %0, %1 offset:%2" : "=v"(d.kp4) : "v"(bk), "n"((off) + 768)); \
    asm volatile("ds_read_b128 %0, %1 offset:%2" : "=v"(d.r4) : "v"(bk), "n"((off) + 1024)); \
    asm volatile("ds_read_b32 %0, %1 offset:%2" : "=v"(d.va) : "v"(bv), "n"((off))); asm volatile("ds_read_b32 %0, %1 offset:%2" : "=v"(d.vb) : "v"(bv), "n"((off) + 16)); } while (0)
#define RW2_WAIT(d) do { asm volatile("s_waitcnt lgkmcnt(7)" : "+v"(d.w4), "+v"(d.kk4), "+v"(d.b4), "+v"(d.kp4), "+v"(d.r4), "+v"(d.va), "+v"(d.vb)); __builtin_amdgcn_sched_barrier(0); } while (0)
#define RW2_STEP(d, opa, opb) do { \
    f32x2 pa_ = A01 * LO2(d.kk4); pa_ = A23 * HI2(d.kk4) + pa_; f32x2 pb_ = B01 * LO2(d.kk4); pb_ = B23 * HI2(d.kk4) + pb_; \
    f32x2 ea0_ = LO2(d.kp4) * d.va, ea1_ = HI2(d.kp4) * d.va, eb0_ = LO2(d.kp4) * d.vb, eb1_ = HI2(d.kp4) * d.vb; \
    ea0_ = A01 * LO2(d.w4) + ea0_; ea1_ = A23 * HI2(d.w4) + ea1_; eb0_ = B01 * LO2(d.w4) + eb0_; eb1_ = B23 * HI2(d.w4) + eb1_; \
    const float nsa_ = -row16_sum(pa_.x + pa_.y), nsb_ = -row16_sum(pb_.x + pb_.y); \
    A01 = LO2(d.b4) * nsa_ + ea0_; A23 = HI2(d.b4) * nsa_ + ea1_; B01 = LO2(d.b4) * nsb_ + eb0_; B23 = HI2(d.b4) * nsb_ + eb1_; \
    f32x2 qa_ = A01 * LO2(d.r4); qa_ = A23 * HI2(d.r4) + qa_; f32x2 qb_ = B01 * LO2(d.r4); qb_ = B23 * HI2(d.r4) + qb_; opa = qa_.x + qa_.y; opb = qb_.x + qb_.y; } while (0)
__device__ __forceinline__ void rwkv_prompt_ring4(LAS unsigned char* ring, volatile LAS unsigned* cnt, const float* RS, float* OA, float* outSR, int item, int w, int lane) {
    constexpr int CH = 16, CHB = CH * RREC * 4  , NB = 4, NCH = TP / CH, RB = RREC * 4;
    const int rbh = item >> 1, half = item & 1, rb = rbh >> 5, rh = rbh & 31, rg = lane >> 4, kq = lane & 15, rowA = half * 32 + w * 8 + rg;
    const char* src = (const char*)(RS + (size_t)rbh * TP * RREC);
#define R4_ISSUE(ci) do { const int cs_ = (ci) < NCH ? (ci) : NCH - 1; const int sl_ = (ci) % NB; _Pragma("unroll") for (int i_ = 0; i_ < 6; ++i_) { const int pc_ = w * 6 + i_; \
        __builtin_amdgcn_global_load_lds((const unsigned*)(src + (size_t)cs_ * CHB + pc_ * 1024 + lane * 16), (LAS unsigned*)(ring + sl_ * CHB + pc_ * 1024), 16, 0, 0); } } while (0)
#pragma unroll
    for (int ci = 0; ci < NB - 1; ++ci) R4_ISSUE(ci);
    asm volatile("s_waitcnt vmcnt(12)" ::: "memory"); if (lane == 0) cnt[w] = 1u; spin_ge4(cnt, 1u);
    const unsigned lbase = (unsigned)(size_t)ring;
    f32x2 A01 = (f32x2){0.f, 0.f}, A23 = A01, B01 = A01, B23 = A01;
    Rw2 X, Y; RW2_LD(X, lbase + kq * 16, lbase + 1280 + rowA * 4, 0);
    for (int ci = 0; ci < NCH; ++ci) {
        asm volatile("s_waitcnt vmcnt(6)" ::: "memory"); if (lane == 0) cnt[w] = (unsigned)ci + 2u; spin_ge4(cnt, (unsigned)ci + 2u);
        spin_ge4(cnt + 4, (unsigned)ci);
        R4_ISSUE(ci + NB - 1);
        const unsigned sl = lbase + (ci % NB) * CHB, nsl = lbase + ((ci + 1) % NB) * CHB, bk = sl + kq * 16, bv = sl + 1280 + rowA * 4, nbk = nsl + kq * 16, nbv = nsl + 1280 + rowA * 4;
        float opa[16], opb[16];
#define R4_PAIR(st) do { RW2_LD(Y, bk, bv, ((st) + 1) * RB); RW2_WAIT(X); RW2_STEP(X, opa[st], opb[st]); RW2_LD(X, bk, bv, ((st) + 2) * RB); RW2_WAIT(Y); RW2_STEP(Y, opa[(st) + 1], opb[(st) + 1]); } while (0)
        R4_PAIR(0); R4_PAIR(2); R4_PAIR(4); R4_PAIR(6); R4_PAIR(8); R4_PAIR(10); R4_PAIR(12);
        RW2_LD(Y, bk, bv, 15 * RB); RW2_WAIT(X); RW2_STEP(X, opa[14], opb[14]); RW2_LD(X, nbk, nbv, 0); RW2_WAIT(Y); RW2_STEP(Y, opa[15], opb[15]);
#undef R4_PAIR
        float* orow = OA + (size_t)(rb * TP + ci * CH + kq) * RW + rh * RH + rowA;
        orow[0] = transpose_reduce16(opa, kq); orow[4] = transpose_reduce16(opb, kq);
        if (lane == 0) cnt[4 + w] = (unsigned)ci + 1u;
    }
    *(f32x4*)(outSR + ((size_t)rbh * RH + rowA) * RH + 4 * kq) = (f32x4){A01.x, A01.y, A23.x, A23.y};
    *(f32x4*)(outSR + ((size_t)rbh * RH + rowA + 4) * RH + 4 * kq) = (f32x4){B01.x, B01.y, B23.x, B23.y};
    asm volatile("s_waitcnt vmcnt(0) lgkmcnt(0)" ::: "memory");
#undef R4_ISSUE
}

__device__ __forceinline__ void adaln_skinny(LAS unsigned char* lds, const float* W, const bf16_t* A, const float* bias, float* MOD, int c, int w, int lane, int tid) {
    const int r = lane & 31, h = lane >> 5;
    LAS float* part = (LAS float*)lds;
    constexpr int NG = (D / 2) / 32, SLB = 160 * 80;
#define AD_BAR() do { asm volatile("s_waitcnt lgkmcnt(0)" ::: "memory"); __builtin_amdgcn_s_barrier(); asm volatile("" ::: "memory"); } while (0)
    if (w < 6) {
        const int j = w >> 1, kh = w & 1, n0 = (c * 3 + j) * 32, kb = kh * (D / 2);
        f32x16 acc[5];
#pragma unroll
        for (int sb = 0; sb < 5; ++sb)
#pragma unroll
            for (int i = 0; i < 16; ++i) acc[sb][i] = 0.f;
        const float* wp = W + (size_t)(kb + 8 * h) * NMOD + n0 + r;
        const LAS unsigned char* sl = lds + kh * 2 * SLB + r * 80 + h * 16;
        float x0[16], x1[16], x2[16], x3[16];
#define AD_LOADW(x, g) do { const float* p_ = wp + (size_t)(32 * (g)) * NMOD; _Pragma("unroll") for (int j_ = 0; j_ < 16; ++j_) x[j_] = p_[(size_t)((j_ >> 3) * 16 + (j_ & 7)) * NMOD]; } while (0)
#define AD_COMP(x, g) do { const LAS unsigned char* b_ = sl + ((g) & 1) * SLB; _Pragma("unroll") for (int q_ = 0; q_ < 2; ++q_) { \
        const bf16x8 wf_ = pack8((f32x4){x[q_ * 8], x[q_ * 8 + 1], x[q_ * 8 + 2], x[q_ * 8 + 3]}, (f32x4){x[q_ * 8 + 4], x[q_ * 8 + 5], x[q_ * 8 + 6], x[q_ * 8 + 7]}); \
        _Pragma("unroll") for (int sb_ = 0; sb_ < 5; ++sb_) acc[sb_] = MFMA32(wf_, *(const LAS bf16x8*)(b_ + sb_ * 32 * 80 + q_ * 32), acc[sb_]); } } while (0)
#define AD_SCHED() __builtin_amdgcn_sched_barrier(0)
        AD_LOADW(x0, 0); AD_LOADW(x1, 1); AD_LOADW(x2, 2);
        AD_BAR();
        for (int g = 0; g < NG; g += 4) {
            AD_LOADW(x3, g + 3); AD_SCHED(); AD_COMP(x0, g); AD_BAR(); AD_SCHED();
            { const int g2 = g + 4 < NG ? g + 4 : NG - 1; AD_LOADW(x0, g2); } AD_SCHED(); AD_COMP(x1, g + 1); AD_BAR(); AD_SCHED();
            { const int g2 = g + 5 < NG ? g + 5 : NG - 1; AD_LOADW(x1, g2); } AD_SCHED(); AD_COMP(x2, g + 2); AD_BAR(); AD_SCHED();
            { const int g2 = g + 6 < NG ? g + 6 : NG - 1; AD_LOADW(x2, g2); } AD_SCHED(); AD_COMP(x3, g + 3); AD_BAR(); AD_SCHED();
        }
#undef AD_LOADW
#undef AD_COMP
#pragma unroll
        for (int sb = 0; sb < 5; ++sb)
#pragma unroll
            for (int reg = 0; reg < 16; ++reg) part[(w * 160 + 32 * sb + r) * 33 + rowperm(reg, h)] = acc[sb][reg];
    } else {
        const int kh = w - 6;
        const bf16_t* ap = A + (size_t)(lane >> 2) * D + kh * (D / 2) + (lane & 3) * 8;
        LAS unsigned char* dst = lds + kh * 2 * SLB + (lane >> 2) * 80 + (lane & 3) * 16;
        u32x4 ra[10], rb[10];
#define AD_LOADA(rr, g) do { _Pragma("unroll") for (int i_ = 0; i_ < 10; ++i_) rr[i_] = *(const u32x4*)(ap + (size_t)(16 * i_) * D + 32 * (g)); } while (0)
#define AD_WRITEA(rr, g) do { _Pragma("unroll") for (int i_ = 0; i_ < 10; ++i_) *(LAS u32x4*)(dst + ((g) & 1) * SLB + i_ * 16 * 80) = rr[i_]; } while (0)
        AD_LOADA(ra, 0); AD_WRITEA(ra, 0); AD_LOADA(rb, 1);
        AD_BAR();
        for (int g = 0; g < NG; g += 2) {
            AD_WRITEA(rb, g + 1); { const int g2 = g + 2 < NG ? g + 2 : NG - 1; AD_LOADA(ra, g2); } AD_BAR();
            AD_WRITEA(ra, g + 2); { const int g2 = g + 3 < NG ? g + 3 : NG - 1; AD_LOADA(rb, g2); } AD_BAR();
        }
#undef AD_LOADA
#undef AD_WRITEA
    }
#undef AD_BAR
    __syncthreads();
    for (int i = tid; i < 3 * NSEQ * 32; i += NTHREADS) { const int j = i / (NSEQ * 32), q = i - j * (NSEQ * 32), sq = q >> 5, n = q & 31, col = (c * 3 + j) * 32 + n;
        MOD[(size_t)sq * NMOD + col] = part[((2 * j) * 160 + sq) * 33 + n] + part[((2 * j + 1) * 160 + sq) * 33 + n] + bias[col]; }
    __syncthreads();
}

__global__ void __launch_bounds__(NTHREADS, 2) fwd_kernel(Args args) {
    extern __shared__ __attribute__((aligned(16))) unsigned char lds_raw[];
    LAS unsigned char* lds = (LAS unsigned char*)lds_raw;
    volatile LAS unsigned* MISC = (volatile LAS unsigned*)(lds + MISC_OFF);
    const int tid = threadIdx.x, lane = tid & 63, wave = __builtin_amdgcn_readfirstlane(tid >> 6);
    const int G = gridDim.x, bx = blockIdx.x;
    const int vcu = (G % 8 == 0) ? (bx % 8) * (G / 8) + bx / 8 : bx;
    const int gw = vcu * NWAVES + wave, NGW = G * NWAVES;
    unsigned char* ws = args.ws;
    unsigned* ctl = (unsigned*)(ws + WS_CTL);
    for (int u = tid; u < (LDS_BYTES - RING_BYTES) / 4; u += NTHREADS) ((LAS unsigned*)(lds + RING_BYTES))[u] = 0u;
    __syncthreads();
    XcdBarrier bar; bar.bar = ctl + CW_BAR; bar.x = 0; bar.st = nullptr;
    if (!MK_PER_PHASE) bar = xcd_barrier_post(ctl + CW_BAR, MISC + 8);
#define GRID_BAR() do { if (!MK_PER_PHASE) xcd_barrier(bar); } while (0)
    const int lo = args.ph_lo, hi = args.ph_hi;
#ifndef PHASE_MASK
#define PHASE_MASK 0xffff
#endif
#define IN(k) (((PHASE_MASK >> (k)) & 1) && lo <= (k) && (k) < hi)
#define BOTH(k) (IN(k) && IN((k) + 1))
#ifndef PROBE_REP
#define PROBE_REP 0
#endif
#define REPS(k) (1 + ((PROBE_REP >> (k)) & 1))
    const float* const* in = args.in; float* out = args.out;
    bf16_t* WT_ADA = (bf16_t*)(ws + WS_WADA); bf16_t* A_ADA = (bf16_t*)(ws + WS_AADA); bf16_t* WT_IN = (bf16_t*)(ws + WS_WIN); bf16_t* WT_OAB = (bf16_t*)(ws + WS_WOAB); bf16_t* WT_OUT = (bf16_t*)(ws + WS_WOUT);
    bf16_t* WT_UP = (bf16_t*)(ws + WS_WUP); bf16_t* WT_DOWN = (bf16_t*)(ws + WS_WDOWN); bf16_t* WT_LORA = (bf16_t*)(ws + WS_WLORA); bf16_t* ALORA = (bf16_t*)(ws + WS_ALORA);
    float* MOD = (float*)(ws + WS_MOD); bf16_t* H = (bf16_t*)(ws + WS_H); bf16_t* P = (bf16_t*)(ws + WS_P); bf16_t* LWAG = (bf16_t*)(ws + WS_LWAG); float* RSCAN = (float*)(ws + WS_RSCAN); float* GSCAN = (float*)(ws + WS_GSCAN);
    float* BON = (float*)(ws + WS_BON); bf16_t* OA = (bf16_t*)(ws + WS_OA); bf16_t* OB = (bf16_t*)(ws + WS_OB); bf16_t* YAB = (bf16_t*)(ws + WS_YAB); bf16_t* MERGED = (bf16_t*)(ws + WS_MERGED); bf16_t* X1 = (bf16_t*)(ws + WS_X1); bf16_t* U = (bf16_t*)(ws + WS_U); bf16_t* X2 = (bf16_t*)(ws + WS_X2);

    if (IN(0)) for (int rep = 0; rep < REPS(0); ++rep) {
        LAS float* scr = (LAS float*)(lds + wave * 16384);
        constexpr int I0 = (D / 64) * (NMOD / 32), I1 = (D / 64) * (INCOLS / 32), I2 = (RW / 64) * (D / 32), I3 = I2, I4 = (D / 64) * (D / 32), I5 = (D / 64) * (DFF / 32), I6 = (DFF / 64) * (D / 32),
                      I7 = 1 * (RW / 32), I8 = I7, I9 = 4 * (RW / 32), NITEMS = I1 + I2 + I3 + I4 + I7 + I8 + I9;
        for (int it = gw; it < NITEMS; it += NGW) {
            int r = it;
            if (r < I1) { const int nb = INCOLS / 32; const int n0 = 32 * (r % nb); transpose_item(in[I_WIN], INCOLS, 64 * (r / nb), n0, WT_IN, n0 < 14752 ? n0 : n0 + 96, D, 0, scr, lane); continue; } r -= I1;
            if (r < I2) { const int nb = D / 32; transpose_item(in[I_WOA], D, 64 * (r / nb), 32 * (r % nb), WT_OAB, 32 * (r % nb), D, 0, scr, lane); continue; } r -= I2;
            if (r < I3) { const int nb = D / 32; transpose_item(in[I_WOB], D, 64 * (r / nb), 32 * (r % nb), WT_OAB, 32 * (r % nb), D, RW, scr, lane); continue; } r -= I3;
            if (r < I4) { const int nb = D / 32; transpose_item(in[I_WOUT], D, 64 * (r / nb), 32 * (r % nb), WT_OUT, 32 * (r % nb), D, 0, scr, lane); continue; } r -= I4;
            if (r < I7) { const int nb = RW / 32; transpose_item(in[I_RWW2], RW, 64 * (r / nb), 32 * (r % nb), WT_LORA, 32 * (r % nb), LORA_K, 0, scr, lane); continue; } r -= I7;
            if (r < I8) { const int nb = RW / 32; transpose_item(in[I_RWA2], RW, 64 * (r / nb), 32 * (r % nb), WT_LORA, 2048 + 32 * (r % nb), LORA_K, 64, scr, lane); continue; } r -= I8;
            { const int nb = RW / 32; transpose_item(in[I_RWG2], RW, 64 * (r / nb), 32 * (r % nb), WT_LORA, 4096 + 32 * (r % nb), LORA_K, 128, scr, lane); }
        }
        for (int i = gw * 64 + lane; i < LORA_N * 48; i += NGW * 64) { const int n = i / 48, ch = i % 48, k = ch * 8, seg = n >> 11;
            const bool diag = seg == 0 ? (k < 64) : seg == 1 ? (k >= 64 && k < 128) : (k >= 128);
            if (!diag) *(u32x4*)(WT_LORA + (size_t)n * LORA_K + k) = (u32x4){0u, 0u, 0u, 0u}; }
        for (int i = gw * 64 + lane; i < 256 * (D / 4); i += NGW * 64) { const int s = i / (D / 4), c4 = (i % (D / 4)) * 4; u32x2 o = (u32x2){0u, 0u};
            if (s < NSEQ) { const f32x4 c = *(const f32x4*)((s < BP ? in[I_CP] + (size_t)s * D : in[I_CS] + (size_t)(s - BP) * D) + c4);
                o.x = pk2(c.x * sigmoidf_(c.x), c.y * sigmoidf_(c.y)); o.y = pk2(c.z * sigmoidf_(c.z), c.w * sigmoidf_(c.w)); }
            *(u32x2*)(A_ADA + (size_t)s * D + c4) = o; }
        if (BOTH(0) || rep + 1 < REPS(0)) GRID_BAR();
    }
    if (IN(1)) for (int rep = 0; rep < REPS(1); ++rep) {
        adaln_skinny(lds, in[I_WADA], A_ADA, in[I_BADA], MOD, bx, wave, lane, tid);
        if (BOTH(1) || rep + 1 < REPS(1)) GRID_BAR();
    }
    if (IN(2)) for (int rep = 0; rep < REPS(2); ++rep) {
        norm_rows<0, false>(in[I_XP], in[I_XS], in[I_N1W], MOD, 0, D, H, nullptr, gw, NGW, lane);
        if (BOTH(2) || rep + 1 < REPS(2)) GRID_BAR();
    }
    if (IN(3)) for (int rep = 0; rep < REPS(3); ++rep) {
        pg8::Gemm g{H, WT_IN, D, D}; pg8::TileOrder<1> S; S.init(MTOK / 256, LDP / 256, G, bx, D / 64);
        pg8::EpiBf16<0> E{P, LDP};
        pg8::gemm_phase(lds, g, S, E);
        if (BOTH(3) || rep + 1 < REPS(3)) GRID_BAR();
    }
    if (IN(4)) for (int rep = 0; rep < REPS(4); ++rep) {
        const float* mu = in[I_RMU];
        for (int m = gw; m < MTOK; m += NGW) {
            const bool pr = m < NPROMPT; const int ms = m - NPROMPT; const int b = pr ? (m >> 11) : (ms >> 2), t = pr ? (m & 2047) : (ms & 3), T = pr ? TP : TS;
            const bf16_t* cur = P + (size_t)m * LDP;
#pragma unroll
            for (int i = 0; i < 6; ++i) { const int j = lane + 64 * i, col = 6144 + j; const float c = bf2f(cur[col]);
                const float p = t > 0 ? bf2f(cur[col - LDP]) : (pr ? 0.f : in[I_SSHIFT][(size_t)b * RCOLS + col]);
                const float xs = c + (p - c) * mu[col];
                const float val = j < 64 ? tanhf(xs) : j < 128 ? xs : sigmoidf_(xs);
                ALORA[(size_t)m * LORA_K + j] = (bf16_t)f2bf(val); }
            if (t == T - 1) { float* so = out + (pr ? O_PSHIFT : O_SSHIFT) + (size_t)b * RCOLS; for (int col = lane; col < RCOLS; col += 64) so[col] = bf2f(cur[col]); }
            if (t >= T - 3) { float* co = out + (pr ? O_PCONV : O_SCONV) + ((size_t)b * 3 + (t - (T - 3))) * GCONV; for (int col = lane; col < GCONV; col += 64) co[col] = bf2f(cur[PC_G + col]); }
        }
        { const int hh = lane >> 4, cq = lane & 15;
        for (int item = gw; item < BP * 4 * (TP / 16); item += NGW) {
            const int b = item >> 9, hg = (item >> 7) & 3, t0 = (item & 127) * 16, h = 4 * hg + hh, c = h * GH + 8 * cq;
            const bf16_t* base = P + (size_t)(b * TP) * LDP + PC_G + c;
            f32x4 cw[3][4][2];
#pragma unroll
            for (int q = 0; q < 3; ++q)
#pragma unroll
                for (int j = 0; j < 4; ++j) { const float* cwp = in[I_CONVW] + (size_t)(3 - j) * GCONV + q * GW + c; cw[q][j][0] = *(const f32x4*)cwp; cw[q][j][1] = *(const f32x4*)(cwp + 4); }
            u32x4 win[3][3], cu[3], nx[3], n2[3];
#pragma unroll
            for (int q = 0; q < 3; ++q) {
#pragma unroll
                for (int j = 1; j < 4; ++j) win[q][j - 1] = (t0 - j >= 0) ? *(const u32x4*)(base + (ptrdiff_t)(t0 - j) * LDP + q * GW) : (u32x4){0u, 0u, 0u, 0u};
                cu[q] = *(const u32x4*)(base + (size_t)t0 * LDP + q * GW); nx[q] = *(const u32x4*)(base + (size_t)(t0 + 1) * LDP + q * GW); }
            const float nalog = -__expf(in[I_ALOG][h]), dtb = in[I_DTB][h];
            unsigned short bt_n = 0, al_n = 0, bt_2 = 0, al_2 = 0;
            if (cq == 0) { const bf16_t* rp0 = P + (size_t)(b * TP + t0) * LDP; bt_n = rp0[PC_BETA + h]; al_n = rp0[PC_ALPHA + h]; }
#pragma unroll 1
            for (int tt = 0; tt < 16; ++tt) { const int t = t0 + tt, tn = tt < 14 ? t + 2 : t0 + 15; const bf16_t* rowp = P + (size_t)(b * TP + t) * LDP;
#pragma unroll
                for (int q = 0; q < 3; ++q) n2[q] = *(const u32x4*)(base + (size_t)tn * LDP + q * GW);
                if (cq == 0) { const bf16_t* rp1 = rowp + (tt < 15 ? LDP : 0); bt_2 = rp1[PC_BETA + h]; al_2 = rp1[PC_ALPHA + h]; }
                const float bt_raw = bf2f(bt_n), al_raw = bf2f(al_n);
                float y[3][8];
#pragma unroll
                for (int q = 0; q < 3; ++q) { float a8[8];
#pragma unroll
                    for (int e = 0; e < 8; ++e) a8[e] = 0.f;
#pragma unroll
                    for (int j = 0; j < 4; ++j) { const u32x4 w = j == 0 ? cu[q] : win[q][j - 1]; const f32x4 c0 = cw[q][j][0], c1 = cw[q][j][1];
                        a8[0] += c0.x * bflo(w.x); a8[1] += c0.y * bfhi(w.x); a8[2] += c0.z * bflo(w.y); a8[3] += c0.w * bfhi(w.y); a8[4] += c1.x * bflo(w.z); a8[5] += c1.y * bfhi(w.z); a8[6] += c1.z * bflo(w.w); a8[7] += c1.w * bfhi(w.w); }
#pragma unroll
                    for (int e = 0; e < 8; ++e) y[q][e] = a8[e] * fsig(a8[e]); }
                float sq = 0.f, sk = 0.f;
#pragma unroll
                for (int e = 0; e < 8; ++e) { sq += y[0][e] * y[0][e]; sk += y[1][e] * y[1][e]; }
                const float qn = __builtin_amdgcn_rsqf(row16_sum(sq) + 1e-6f) * 0.08838834764831845f, kn = __builtin_amdgcn_rsqf(row16_sum(sk) + 1e-6f);
                float qk = 0.f;
#pragma unroll
                for (int e = 0; e < 8; ++e) { y[0][e] *= qn; y[1][e] *= kn; qk += y[0][e] * y[1][e]; }
                qk = row16_sum(qk);
                unsigned char* recb = (unsigned char*)GSCAN + ((size_t)(b * GHEADS + h) * TP + t) * GRB;
#pragma unroll
                for (int q = 0; q < 3; ++q) *(bf16x8*)(recb + q * 256 + 16 * cq) = pack8((f32x4){y[q][0], y[q][1], y[q][2], y[q][3]}, (f32x4){y[q][4], y[q][5], y[q][6], y[q][7]});
                if (cq == 0) { const float beta = sigmoidf_(bt_raw); const float la = nalog * softplusf_(al_raw + dtb); *(f32x4*)(recb + 768) = (f32x4){__expf(la), beta, qk, la}; }
#pragma unroll
                for (int q = 0; q < 3; ++q) { win[q][2] = win[q][1]; win[q][1] = win[q][0]; win[q][0] = cu[q]; cu[q] = nx[q]; nx[q] = n2[q]; }
                bt_n = bt_2; al_n = al_2;
            }
        } }
        if (BOTH(4) || rep + 1 < REPS(4)) GRID_BAR();
    }
    if (IN(5)) for (int rep = 0; rep < REPS(5); ++rep) {
        pg8::Gemm g{ALORA, WT_LORA, LORA_K, LORA_K}; pg8::TileOrder<1> S; S.init(MTOK / 256, LORA_N / 256, G, bx, LORA_K / 64);
        pg8::EpiLora E{LWAG, in[I_RW0], in[I_RA0]};
        pg8::gemm_phase(lds, g, S, E);
        if (BOTH(5) || rep + 1 < REPS(5)) GRID_BAR();
    }
    if (IN(6)) for (int rep = 0; rep < REPS(6); ++rep) {
        const float* mu = in[I_RMU]; const int hh = lane >> 4, cq = lane & 15;
        if (args.sub & 1) for (int u = gw; u < NSAMP * 6; u += NGW) {
            const int m = NPROMPT + u / 6, gi = u - (u / 6) * 6;
            const bool pr = false; const int ms = m - NPROMPT; const int b = ms >> 2, t = ms & 3;
            const bf16_t* cur = P + (size_t)m * LDP;
            if (gi < 4) {
                if (pr) continue;
                const bf16_t* lw = LWAG + (size_t)m * LORA_N;
                u32x2 cr[2][3], pv[2][3]; f32x4 wv[2], av[2];
#pragma unroll
                for (int bi = 0; bi < 2; ++bi) { const int c = (8 * gi + 4 * bi + hh) * RH + 4 * cq;
#pragma unroll
                    for (int q = 0; q < 3; ++q) { cr[bi][q] = *(const u32x2*)(cur + q * RW + c); pv[bi][q] = t > 0 ? *(const u32x2*)(cur - LDP + q * RW + c) : (u32x2){0u, 0u}; }
                    { const f32x4 lv = cvt4(*(const u32x2*)(lw + c)); wv[bi] = (f32x4){__expf(lv.x), __expf(lv.y), __expf(lv.z), __expf(lv.w)}; } av[bi] = cvt4(*(const u32x2*)(lw + RW + c)); }
#pragma unroll
                for (int bi = 0; bi < 2; ++bi) { const int h = 8 * gi + 4 * bi + hh, c = h * RH + 4 * cq; f32x4 x[3];
#pragma unroll
                    for (int q = 0; q < 3; ++q) { const f32x4 cv = (f32x4){bflo(cr[bi][q].x), bfhi(cr[bi][q].x), bflo(cr[bi][q].y), bfhi(cr[bi][q].y)};
                        f32x4 p = (f32x4){bflo(pv[bi][q].x), bfhi(pv[bi][q].x), bflo(pv[bi][q].y), bfhi(pv[bi][q].y)};
                        if (t == 0 && !pr) p = *(const f32x4*)(in[I_SSHIFT] + (size_t)b * RCOLS + q * RW + c);
                        x[q] = cv + (p - cv) * *(const f32x4*)(mu + q * RW + c); }
                    const f32x4 kr = x[1] * *(const f32x4*)(in[I_RKK] + c);
                    const float ss = row16_sum(kr.x * kr.x + kr.y * kr.y + kr.z * kr.z + kr.w * kr.w);
                    const f32x4 kk = kr * __builtin_amdgcn_rsqf(ss + 1e-6f);
                    const f32x4 a4 = av[bi]; const f32x4 kp = x[1] * ((a4 - 1.0f) * *(const f32x4*)(in[I_RKA] + c) + 1.0f);
                    const f32x4 rk = *(const f32x4*)(in[I_RRK] + c); const f32x4 rkp = x[0] * kp * rk;
                    const float bon = row16_sum(rkp.x + rkp.y + rkp.z + rkp.w);
                    if (cq == 0) BON[(size_t)m * RHEADS + h] = bon;
                    float* rec = RSCAN + ((pr ? ((size_t)(b * RHEADS + h) * TP + t) : ((size_t)BP * RHEADS * TP + (size_t)(b * RHEADS + h) * TS + t))) * RREC + 4 * cq;
                    *(f32x4*)(rec) = wv[bi]; *(f32x4*)(rec + 64) = kk; *(f32x4*)(rec + 128) = kk * a4; *(f32x4*)(rec + 192) = kp; *(f32x4*)(rec + 256) = x[0]; *(f32x4*)(rec + 320) = x[2]; }
            } else {
                const int g8 = 8 * (gi - 4);
                u32x4 raw[2][3][4];
#pragma unroll
                for (int bi = 0; bi < 2; ++bi) { const int c = (g8 + 4 * bi + hh) * GH + 8 * cq;
#pragma unroll
                    for (int q = 0; q < 3; ++q)
#pragma unroll
                        for (int j = 0; j < 4; ++j) raw[bi][q][j] = (t - j >= 0) ? *(const u32x4*)(cur - (size_t)j * LDP + PC_G + q * GW + c) : (u32x4){0u, 0u, 0u, 0u}; }
#pragma unroll
                for (int bi = 0; bi < 2; ++bi) { const int h = g8 + 4 * bi + hh, c = h * GH + 8 * cq; float y[3][8];
#pragma unroll
                    for (int q = 0; q < 3; ++q) { float a8[8];
#pragma unroll
                        for (int e = 0; e < 8; ++e) a8[e] = 0.f;
#pragma unroll
                        for (int j = 0; j < 4; ++j) { const float* cwp = in[I_CONVW] + (size_t)(3 - j) * GCONV + q * GW + c; const f32x4 c0 = *(const f32x4*)cwp, c1 = *(const f32x4*)(cwp + 4);
                            f32x4 x0 = (f32x4){bflo(raw[bi][q][j].x), bfhi(raw[bi][q][j].x), bflo(raw[bi][q][j].y), bfhi(raw[bi][q][j].y)}, x1 = (f32x4){bflo(raw[bi][q][j].z), bfhi(raw[bi][q][j].z), bflo(raw[bi][q][j].w), bfhi(raw[bi][q][j].w)};
                            if (t - j < 0 && !pr) { const float* sp = in[I_SCONV] + ((size_t)b * 3 + (3 + t - j)) * GCONV + q * GW + c; x0 = *(const f32x4*)sp; x1 = *(const f32x4*)(sp + 4); }
                            a8[0] += c0.x * x0.x; a8[1] += c0.y * x0.y; a8[2] += c0.z * x0.z; a8[3] += c0.w * x0.w; a8[4] += c1.x * x1.x; a8[5] += c1.y * x1.y; a8[6] += c1.z * x1.z; a8[7] += c1.w * x1.w; }
#pragma unroll
                        for (int e = 0; e < 8; ++e) y[q][e] = a8[e] * fsig(a8[e]); }
                    float sq = 0.f, sk = 0.f;
#pragma unroll
                    for (int e = 0; e < 8; ++e) { sq += y[0][e] * y[0][e]; sk += y[1][e] * y[1][e]; }
                    const float qn = __builtin_amdgcn_rsqf(row16_sum(sq) + 1e-6f) * 0.08838834764831845f, kn = __builtin_amdgcn_rsqf(row16_sum(sk) + 1e-6f);
                    float qk = 0.f;
#pragma unroll
                    for (int e = 0; e < 8; ++e) { y[0][e] *= qn; y[1][e] *= kn; qk += y[0][e] * y[1][e]; }
                    qk = row16_sum(qk);
                    float* rec = GSCAN + ((size_t)BP * GHEADS * TP + (size_t)(b * GHEADS + h) * TS + t) * GREC;
                    unsigned char* recb = (unsigned char*)GSCAN + ((size_t)(b * GHEADS + h) * TP + t) * GRB;
#pragma unroll
                    for (int q = 0; q < 3; ++q) {
                        if (pr) *(bf16x8*)(recb + q * 256 + 16 * cq) = pack8((f32x4){y[q][0], y[q][1], y[q][2], y[q][3]}, (f32x4){y[q][4], y[q][5], y[q][6], y[q][7]});
                        else { *(f32x4*)(rec + q * 128 + 8 * cq) = (f32x4){y[q][0], y[q][1], y[q][2], y[q][3]}; *(f32x4*)(rec + q * 128 + 8 * cq + 4) = (f32x4){y[q][4], y[q][5], y[q][6], y[q][7]}; } }
                    if (cq == 0) { const float beta = sigmoidf_(bf2f(cur[PC_BETA + h]));
                        const float la = -__expf(in[I_ALOG][h]) * softplusf_(bf2f(cur[PC_ALPHA + h]) + in[I_DTB][h]);
                        *(f32x4*)(pr ? (float*)(recb + 768) : rec + 384) = (f32x4){__expf(la), beta, qk, la}; } }
            }
        }
        if (args.sub & 2) { LAS unsigned char* wl = lds + wave * 16384; const RwPrepIn rin{P, LWAG, in[I_RMU], in[I_RKK], in[I_RKA], in[I_RRK], BON, (unsigned char*)RSCAN}; unsigned char* RKDb = (unsigned char*)RSCAN + 68 * MiB;
          for (int ch = gw; ch < NRCHUNK; ch += NGW) rwkv_chunk_prep(wl, rin, ch >> 6, ch & 63, RKDb + (size_t)ch * RK_BYTES, (float*)(ws + WS_BON + 3 * MiB) + (size_t)ch * 64, lane); }
        if (args.sub & 4) { LAS unsigned char* wl = lds + wave * 16384;
          unsigned char* FRb = (unsigned char*)out; unsigned char* UBb = FRb + (size_t)NCHUNK * CK_FR; float* CDb = (float*)(ws + WS_BON + 2 * MiB);
          for (int ch = gw; ch < NCHUNK; ch += NGW) gdn_chunk_prep(wl, (const unsigned char*)GSCAN + (size_t)ch * 32 * GRB, FRb + (size_t)ch * CK_FR, UBb + (size_t)ch * CK_UB, CDb + ch, lane); }
        if (BOTH(6) || rep + 1 < REPS(6)) GRID_BAR();
    }
    if (IN(8)) for (int rep = 0; rep < REPS(8); ++rep) {
        const int xw = ((bx & 7) << 5) | (bx >> 3);
        if (wave == 0) gdn_mfma_wave((const unsigned char*)out, (const unsigned char*)out + (size_t)NCHUNK * CK_FR, (const float*)(ws + WS_BON + 2 * MiB), OB, out + O_PGDN, xw, lane);
        else if (wave == 1) rwkv_mfma_wave((const unsigned char*)RSCAN + 68 * MiB, (const float*)(ws + WS_BON + 3 * MiB), (const unsigned char*)RSCAN, OA, out + O_PWKV, xw, lane);
        else { const int sw = bx * 6 + (wave - 2), nsw = G * 6; LAS float* scr = (LAS float*)(lds + (wave - 2) * 8704);
            for (int it = sw; it < BS * RHEADS * 4; it += nsw) rwkv_sample_item(RSCAN, in[I_SWKV], OA, out + O_SWKV, it, lane);
            for (int it = sw; it < BS * GHEADS * 4; it += nsw) gdn_sample_item(scr, GSCAN, in[I_SGDN], OB, out + O_SGDN, it, lane);
            constexpr int J5 = (D / 64) * (DFF / 32), J6 = (DFF / 64) * (D / 32);
            for (int it = sw; it < J5 + J6; it += nsw) {
                if (it < J5) { const int nb = DFF / 32; transpose_item(in[I_WUP], DFF, 64 * (it / nb), 32 * (it % nb), WT_UP, 32 * (it % nb), D, 0, scr, lane); }
                else { const int q = it - J5, nb = D / 32; transpose_item(in[I_WDOWN], D, 64 * (q / nb), 32 * (q % nb), WT_DOWN, 32 * (q % nb), DFF, 0, scr, lane); } } }
        __syncthreads();
        if (BOTH(8) || rep + 1 < REPS(8)) GRID_BAR();
    }
    if (IN(9)) for (int rep = 0; rep < REPS(9); ++rep) {
        const float* mu = in[I_RMU]; const int hh = lane >> 4, cq = lane & 15;
        { struct RA { u32x2 o[2], g[2], cv[2], pv[2]; float bon[2]; }; RA ca, na;
#define P9_LOADA(R, uu) do { const int m_ = (uu) >> 2, gi_ = (uu) & 3; const bool pr_ = m_ < NPROMPT; const int t_ = pr_ ? (m_ & 2047) : ((m_ - NPROMPT) & 3); const bf16_t* cur_ = P + (size_t)m_ * LDP; \
            _Pragma("unroll") for (int bi = 0; bi < 2; ++bi) { const int h_ = 8 * gi_ + 4 * bi + hh, c_ = h_ * RH + 4 * cq; \
                R.o[bi] = *(const u32x2*)(OA + (size_t)m_ * RW + c_); R.g[bi] = *(const u32x2*)(LWAG + (size_t)m_ * LORA_N + 2 * RW + c_); \
                R.cv[bi] = *(const u32x2*)(cur_ + 2 * RW + c_); R.pv[bi] = t_ > 0 ? *(const u32x2*)(cur_ - LDP + 2 * RW + c_) : (u32x2){0u, 0u}; R.bon[bi] = BON[(size_t)m_ * RHEADS + h_]; } } while (0)
          constexpr int NA = MTOK * 4;
          if (gw < NA) P9_LOADA(ca, gw);
          for (int u = gw; u < NA; u += NGW) {
            { const int un = u + NGW < NA ? u + NGW : u; P9_LOADA(na, un); }
            const int m = u >> 2, gi = u & 3;
            const bool pr = m < NPROMPT; const int ms = m - NPROMPT; const int b = pr ? (m >> 11) : (ms >> 2), t = pr ? (m & 2047) : (ms & 3);
#pragma unroll
            for (int bi = 0; bi < 2; ++bi) { const int h = 8 * gi + 4 * bi + hh, c = h * RH + 4 * cq;
                const f32x4 o = cvt4(ca.o[bi]); const float mean = row16_sum(o.x + o.y + o.z + o.w) * (1.0f / 64.0f); const f32x4 d = o - mean;
                const float var = row16_sum(d.x * d.x + d.y * d.y + d.z * d.z + d.w * d.w) * (1.0f / 64.0f);
                const f32x4 vc = cvt4(ca.cv[bi]); f32x4 vp = cvt4(ca.pv[bi]);
                if (t == 0 && !pr) vp = *(const f32x4*)(in[I_SSHIFT] + (size_t)b * RCOLS + 2 * RW + c);
                const f32x4 v4 = vc + (vp - vc) * *(const f32x4*)(mu + 2 * RW + c);
                f32x4 on = d * __builtin_amdgcn_rsqf(var + 64e-5f) * *(const f32x4*)(in[I_LNXW] + c) + *(const f32x4*)(in[I_LNXB] + c);
                on = (on + v4 * ca.bon[bi]) * cvt4(ca.g[bi]);
                u32x2 w; w.x = pk2(on.x, on.y); w.y = pk2(on.z, on.w); *(u32x2*)(YAB + (size_t)m * D + c) = w; }
            ca = na; }
#undef P9_LOADA
        }
        { struct RB { u32x4 ow[2], zw[2]; }; RB cb_, nb;
#define P9_LOADB(R, uu) do { const int m_ = (uu) >> 1, g8_ = 8 * ((uu) & 1); const bf16_t* cur_ = P + (size_t)m_ * LDP; \
            _Pragma("unroll") for (int bi = 0; bi < 2; ++bi) { const int c_ = (g8_ + 4 * bi + hh) * GH + 8 * cq; R.ow[bi] = *(const u32x4*)(OB + (size_t)m_ * GW + c_); R.zw[bi] = *(const u32x4*)(cur_ + PC_Z + c_); } } while (0)
          constexpr int NB = MTOK * 2;
          const f32x4 n0 = *(const f32x4*)(in[I_GNW] + 8 * cq), n1 = *(const f32x4*)(in[I_GNW] + 8 * cq + 4);
          if (gw < NB) P9_LOADB(cb_, gw);
          for (int u = gw; u < NB; u += NGW) {
            { const int un = u + NGW < NB ? u + NGW : u; P9_LOADB(nb, un); }
            const int m = u >> 1, g8 = 8 * (u & 1);
#pragma unroll
            for (int bi = 0; bi < 2; ++bi) { const int c = (g8 + 4 * bi + hh) * GH + 8 * cq;
                const f32x4 a = cvt4((u32x2){cb_.ow[bi].x, cb_.ow[bi].y}), bq = cvt4((u32x2){cb_.ow[bi].z, cb_.ow[bi].w});
                const float rs = __builtin_amdgcn_rsqf(row16_sum(a.x * a.x + a.y * a.y + a.z * a.z + a.w * a.w + bq.x * bq.x + bq.y * bq.y + bq.z * bq.z + bq.w * bq.w) * (1.0f / 128.0f) + 1e-6f);
                const u32x4 zq = cb_.zw[bi];
                const float z[8] = {bflo(zq.x), bfhi(zq.x), bflo(zq.y), bfhi(zq.y), bflo(zq.z), bfhi(zq.z), bflo(zq.w), bfhi(zq.w)};
                u32x4 w; w.x = pk2(a.x * rs * n0.x * z[0] * fsig(z[0]), a.y * rs * n0.y * z[1] * fsig(z[1])); w.y = pk2(a.z * rs * n0.z * z[2] * fsig(z[2]), a.w * rs * n0.w * z[3] * fsig(z[3]));
                w.z = pk2(bq.x * rs * n1.x * z[4] * fsig(z[4]), bq.y * rs * n1.y * z[5] * fsig(z[5])); w.w = pk2(bq.z * rs * n1.z * z[6] * fsig(z[6]), bq.w * rs * n1.w * z[7] * fsig(z[7]));
                *(u32x4*)(YAB + (size_t)m * D + RW + c) = w; }
            cb_ = nb; }
#undef P9_LOADB
        }
        if (BOTH(9) || rep + 1 < REPS(9)) GRID_BAR();
    }
    if (IN(10)) for (int rep = 0; rep < REPS(10); ++rep) {
        pg8::Gemm g{YAB, WT_OAB, D, D}; pg8::TileOrder<2> S; S.init(MTOK / 256, D / 256, G, bx, RW / 64, G == 256 ? 2 * G : 0); S.chain = true;
        pg8::EpiMergeChain E{MERGED, P};
        pg8::gemm_phase(lds, g, S, E);
        if (G == 256) { pg8::TailArgs ta{(float*)(ws + WS_H), ctl + CW_TAIL + 0 * 8192, nullptr, nullptr, nullptr, nullptr, MERGED, D, P}; pg8::gemm_tail<8, 2>(lds, g, MTOK / 256, D / 256, G, bx, 2, 8, ta); }
        if (BOTH(10) || rep + 1 < REPS(10)) GRID_BAR();
    }
    if (IN(11)) for (int rep = 0; rep < REPS(11); ++rep) {
        pg8::Gemm g{MERGED, WT_OUT, D, D}; pg8::TileOrder<1> S; S.init(MTOK / 256, D / 256, G, bx, D / 64, G == 256 ? 2 * G : 0);
        pg8::EpiResGate<false> E{in[I_XP], in[I_XS], MOD + 2 * D, X1};
        pg8::gemm_phase(lds, g, S, E);
        if (G == 256) { pg8::TailArgs ta{(float*)(ws + WS_H), ctl + CW_TAIL + 1 * 8192, in[I_XP], in[I_XS], MOD + 2 * D, nullptr, X1, D, nullptr}; pg8::gemm_tail<8, 0>(lds, g, MTOK / 256, D / 256, G, bx, 2, 8, ta); }
        if (BOTH(11) || rep + 1 < REPS(11)) GRID_BAR();
    }
    if (IN(12)) for (int rep = 0; rep < REPS(12); ++rep) {
        norm_rows<0, true>((const float*)X1, nullptr, in[I_N2W], MOD, 3 * D, 4 * D, H, nullptr, gw, NGW, lane);
        if (BOTH(12) || rep + 1 < REPS(12)) GRID_BAR();
    }
    if (IN(13)) for (int rep = 0; rep < REPS(13); ++rep) {
        pg8::Gemm g{H, WT_UP, D, D}; pg8::TileOrder<1> S; S.init(MTOK / 256, DFF / 256, G, bx, D / 64, G == 256 ? 8 * G : 0);
        pg8::EpiBf16<1> E{U, DFF};
        pg8::gemm_phase(lds, g, S, E);
        if (G == 256) { pg8::TailArgs ta{(float*)(ws + WS_P), ctl + CW_TAIL + 2 * 8192, nullptr, nullptr, nullptr, nullptr, U, DFF, nullptr}; pg8::gemm_tail<2, 1>(lds, g, MTOK / 256, DFF / 256, G, bx, 8, 32, ta); }
        if (BOTH(13) || rep + 1 < REPS(13)) GRID_BAR();
    }
    if (IN(14)) for (int rep = 0; rep < REPS(14); ++rep) {
        pg8::Gemm g{U, WT_DOWN, DFF, DFF}; pg8::TileOrder<1> S; S.init(MTOK / 256, D / 256, G, bx, DFF / 64, G == 256 ? 2 * G : 0);
        pg8::EpiResGate<true> E{(const float*)X1, nullptr, MOD + 5 * D, X2};
        pg8::gemm_phase(lds, g, S, E);
        if (G == 256) { pg8::TailArgs ta{(float*)(ws + WS_H), ctl + CW_TAIL + 3 * 8192, (const float*)X1, nullptr, MOD + 5 * D, nullptr, X2, D, nullptr}; pg8::gemm_tail<8, 3>(lds, g, MTOK / 256, D / 256, G, bx, 2, 32, ta); }
        if (BOTH(14) || rep + 1 < REPS(14)) GRID_BAR();
    }
    if (IN(15)) for (int rep = 0; rep < REPS(15); ++rep) {
        norm_rows<1, true>((const float*)X2, nullptr, in[I_FNW], nullptr, 0, 0, nullptr, out + O_Y, gw, NGW, lane);
    }
#undef IN
#undef BOTH
#undef GRID_BAR
}

extern "C" void kernel_launch(void* const* d_in, const int* in_sizes, int n_in, void* d_out, int out_size, void* d_ws, size_t ws_size, hipStream_t stream) {
    static int grid = 0;
    if (grid == 0) {
        if (n_in != 34 || (size_t)out_size != O_END || ws_size < WS_END) { fprintf(stderr, "kernel_launch: unexpected problem: n_in %d out %d ws %zu (need %zu)\n", n_in, out_size, ws_size, (size_t)WS_END); grid = -1; return; }
        int dev = 0, cus = 0, per_cu = 0;
        if (hipGetDevice(&dev) != hipSuccess || hipDeviceGetAttribute(&cus, hipDeviceAttributeMultiprocessorCount, dev) != hipSuccess) { grid = -1; return; }
        if (hipFuncSetAttribute((const void*)fwd_kernel, hipFuncAttributeMaxDynamicSharedMemorySize, LDS_BYTES) != hipSuccess) { fprintf(stderr, "kernel_launch: hipFuncSetAttribute failed\n"); grid = -1; return; }
        if (hipOccupancyMaxActiveBlocksPerMultiprocessor(&per_cu, (const void*)fwd_kernel, NTHREADS, LDS_BYTES) != hipSuccess || per_cu < 1) fprintf(stderr, "kernel_launch: occupancy query says %d\n", per_cu);
        (void)hipGetLastError();
        grid = cus;
    }
    if (grid < 0) return;
    if (hipMemsetAsync((char*)d_ws + WS_CTL, 0, CTL_ZERO_BYTES, stream) != hipSuccess) return;
    Args a{}; a.sub = 7;
    for (int i = 0; i < 34; ++i) a.in[i] = (const float*)d_in[i];
    a.out = (float*)d_out; a.ws = (unsigned char*)d_ws;
#if MK_PER_PHASE
    for (int p = 0; p < NPHASE; ++p) { a.ph_lo = p; a.ph_hi = p + 1; hipLaunchKernelGGL(fwd_kernel, dim3(grid), dim3(NTHREADS), LDS_BYTES, stream, a); }
#else
#ifdef PROBE_PHASE
    a.ph_lo = 0; a.ph_hi = PROBE_PHASE + 1; hipLaunchKernelGGL(fwd_kernel, dim3(grid), dim3(NTHREADS), LDS_BYTES, stream, a);
    if (PROBE_TWICE) { (void)hipMemsetAsync((char*)d_ws + WS_CTL, 0, CTL_ZERO_BYTES, stream); a.ph_lo = PROBE_PHASE; a.ph_hi = PROBE_PHASE + 1; a.sub = PROBE_TWICE; hipLaunchKernelGGL(fwd_kernel, dim3(grid), dim3(NTHREADS), LDS_BYTES, stream, a); a.sub = 7; }
    if (PROBE_PHASE + 1 < NPHASE) { (void)hipMemsetAsync((char*)d_ws + WS_CTL, 0, CTL_ZERO_BYTES, stream); a.ph_lo = PROBE_PHASE + 1; a.ph_hi = NPHASE; hipLaunchKernelGGL(fwd_kernel, dim3(grid), dim3(NTHREADS), LDS_BYTES, stream, a); }
#else
    a.ph_lo = 0; a.ph_hi = NPHASE; hipLaunchKernelGGL(fwd_kernel, dim3(grid), dim3(NTHREADS), LDS_BYTES, stream, a);
#endif
#endif
    const hipError_t le = hipPeekAtLastError();
    if (le != hipSuccess) fprintf(stderr, "kernel_launch: launch failed: %s\n", hipGetErrorName(le));
}
```

```cpp
#include <hip/hip_runtime.h>
#include <cstdio>
#include <cstdint>

#ifndef MK_PER_PHASE
#define MK_PER_PHASE 0
#endif

#define GAS __attribute__((address_space(1)))
#define LAS __attribute__((address_space(3)))
typedef unsigned short bf16_t;
typedef short bf16x8 __attribute__((ext_vector_type(8)));
typedef float f32x4 __attribute__((ext_vector_type(4)));
typedef float f32x2 __attribute__((ext_vector_type(2)));
typedef unsigned u32x4 __attribute__((ext_vector_type(4)));
typedef unsigned u32x2 __attribute__((ext_vector_type(2)));

constexpr int D = 4096, NPROMPT = 8192, NSAMP = 512, MTOK = NPROMPT + NSAMP;
constexpr int TP = 2048, TS = 4, BP = 4, BS = 128, NSEQ = BP + BS;
constexpr int RW = 2048, RH = 64, RHEADS = 32, RCOLS = 6528;
constexpr int GW = 2048, GH = 128, GHEADS = 16, GCONV = 6144;
constexpr int INCOLS = 22944, LDP = 23040;
constexpr int PC_G = 6528, PC_Z = 6528 + 6144, PC_BETA = 14720, PC_ALPHA = 14736, PC_GA = 14848, PC_GB = 14848 + 4096;
constexpr int DFF = 16384, NMOD = 6 * D;
constexpr int LORA_K = 384, LORA_N = 6144;
constexpr int RREC = 384, GREC = 400, GRB = 784;
constexpr size_t O_Y = 0, O_PWKV = 35651584, O_PSHIFT = 36175872, O_PGDN = 36201984, O_PCONV = 37250560, O_SWKV = 37324288, O_SSHIFT = 54101504, O_SGDN = 54937088, O_SCONV = 88491520, O_END = 90850816;

constexpr size_t MiB = 1u << 20;
constexpr size_t WS_CTL = 0, CTL_ZERO_BYTES = 256 * 1024;
constexpr size_t WS_WOAB = 2 * MiB, WS_WOUT = 34 * MiB, WS_WUP = 66 * MiB, WS_WDOWN = 194 * MiB, WS_MOD = 322 * MiB, WS_WLORA = 346 * MiB, WS_ALORA = 351 * MiB;
constexpr size_t WS_H = 358 * MiB, WS_P = 426 * MiB, WS_X = 809 * MiB;
constexpr size_t WS_WADA = WS_X, WS_AADA = WS_X + 192 * MiB, WS_WIN = WS_X + 194 * MiB;
constexpr size_t WS_LWAG = WS_X, WS_RSCAN = WS_X + 204 * MiB, WS_GSCAN = WS_X + 612 * MiB, WS_OA = WS_X + 825 * MiB, WS_OB = WS_H;
constexpr size_t WS_BON = WS_X + 893 * MiB;
constexpr size_t WS_YAB = WS_GSCAN, WS_MERGED = WS_GSCAN + 68 * MiB, WS_X1 = WS_X, WS_U = WS_RSCAN, WS_X2 = WS_RSCAN + 272 * MiB;
constexpr size_t WS_END = 1728 * MiB;
static_assert(WS_OA + (size_t)MTOK * 2048 * 4 <= WS_END && WS_GSCAN + (size_t)MTOK * 16 * GREC * 4 <= WS_OA && WS_RSCAN + (size_t)MTOK * 32 * RREC * 4 <= WS_GSCAN && WS_LWAG + (size_t)MTOK * LORA_N * 4 <= WS_RSCAN, "ws map A");
static_assert(WS_WIN + (size_t)LDP * D * 2 <= WS_END && WS_P + (size_t)MTOK * LDP * 2 <= WS_X && WS_H + (size_t)MTOK * D * 2 <= WS_P && WS_X2 + (size_t)MTOK * D * 4 <= WS_GSCAN && WS_U + (size_t)MTOK * DFF * 2 <= WS_X2, "ws map B");

constexpr int RING_BYTES = 131072, MISC_OFF = RING_BYTES + 320, LDS_BYTES = 147456;
constexpr int NWAVES = 8, NTHREADS = 512;

__device__ __forceinline__ unsigned f2bf(float f) { unsigned u = __builtin_bit_cast(unsigned, f); return (u + 0x7fffu + ((u >> 16) & 1u)) >> 16; }
__device__ __forceinline__ float bf2f(unsigned short b) { return __builtin_bit_cast(float, ((unsigned)b) << 16); }
__device__ __forceinline__ unsigned pk2(float lo, float hi) { return f2bf(lo) | (f2bf(hi) << 16); }
__device__ __forceinline__ float bflo(unsigned w) { return __builtin_bit_cast(float, w << 16); }
__device__ __forceinline__ float bfhi(unsigned w) { return __builtin_bit_cast(float, w & 0xffff0000u); }
__device__ __forceinline__ unsigned cvt2(float lo, float hi);
__device__ __forceinline__ f32x4 cvt4(u32x2 w) { return (f32x4){bflo(w.x), bfhi(w.x), bflo(w.y), bfhi(w.y)}; }
__device__ __forceinline__ float wave_sum(float v) {
#pragma unroll
    for (int o = 1; o < 64; o <<= 1) v += __shfl_xor(v, o);
    return v;
}
template <int CTRL> __device__ __forceinline__ float dppf(float x) { return __builtin_bit_cast(float, __builtin_amdgcn_mov_dpp(__builtin_bit_cast(int, x), CTRL, 0xf, 0xf, true)); }
__device__ __forceinline__ float row16_sum(float x) { x += dppf<0x128>(x); x += dppf<0x124>(x); x += dppf<0x122>(x); x += dppf<0x121>(x); return x; }
__device__ __forceinline__ float sigmoidf_(float x) { return 1.0f / (1.0f + __expf(-x)); }
__device__ __forceinline__ float fsig(float x) { return __builtin_amdgcn_rcpf(1.0f + __builtin_amdgcn_exp2f(x * -1.4426950408889634f)); }
__device__ __forceinline__ float softplusf_(float y) { return fmaxf(y, 0.f) + log1pf(__expf(-fabsf(y))); }
__device__ __forceinline__ int seq_of_row(int m) { return m < NPROMPT ? (m >> 11) : 4 + ((m - NPROMPT) >> 2); }

namespace pg8 {
constexpr int BM = 256, BK = 64, HALF = 128, HTB = HALF * BK * 2, STAGE_BYTES = 8 * HTB, NXCD = 8, WGM = 8;
__host__ __device__ __forceinline__ int lds_byte(int r, int c) { const int st = r >> 3, rr = r & 7, ch = c >> 3; return st * 1024 + rr * 128 + ((ch ^ ((rr >> 1) << 1)) << 4) + (c & 7) * 2; }
__host__ __device__ __forceinline__ void stage_rc(int b, int& R, int& C) { const int st = b / 1024, sb = b % 1024, rr = sb / 128, chs = (sb % 128) / 16, ch = chs ^ ((rr >> 1) << 1); R = st * 8 + rr; C = ch * 8 + (sb % 16) / 2; }
__host__ __device__ __forceinline__ int perm32(int rho) { const int n = rho >> 4, i = rho & 15; return 8 * (i >> 2) + 4 * n + (i & 3); }

struct Unit { int pm, pn, koff, nt, fin; };
struct Gemm { const bf16_t* A; const bf16_t* Bt; int lda, ldb; };

__device__ __forceinline__ void tile_of(int L, int nM, int nN, int& pm, int& pn) {
    const int nwg = nM * nN; int wgid = L; { const int q = nwg / NXCD, r = nwg % NXCD, xcd = wgid % NXCD, off = wgid / NXCD; wgid = (xcd < r ? xcd * (q + 1) : r * (q + 1) + (xcd - r) * q) + off; }
    const int nig = WGM * nN, gid = wgid / nig, fm = gid * WGM, gsz = (nM - fm) < WGM ? (nM - fm) : WGM;
    pm = fm + ((wgid % nig) % gsz); pn = (wgid % nig) / gsz;
}
template <int SPLIT> struct TileOrder {
    int nM, nN, lim, G, c, nt; bool chain = false;
    __device__ void init(int nM_, int nN_, int G_, int c_, int nt_, int lim_ = 0) { nM = nM_; nN = nN_; lim = lim_ ? lim_ : nM * nN; G = G_; c = c_; nt = nt_; }
    __device__ bool next(int i, Unit& u) const {
        const int ti = i / SPLIT, hf = i % SPLIT;
        const long L = (long)ti * G + c; if (L >= lim) return false;
        tile_of((int)L, nM, nN, u.pm, u.pn); u.nt = nt; u.koff = hf * nt * BK * 2; u.fin = chain ? (hf == SPLIT - 1) : 1; return true;
    }
};
struct OneUnit { Unit u; __device__ bool next(int i, Unit& o) const { if (i) return false; o = u; return true; } };

__device__ __forceinline__ unsigned cvt_pk_bf16(float lo, float hi) { unsigned r; asm volatile("v_cvt_pk_bf16_f32 %0, %1, %2" : "=v"(r) : "v"(lo), "v"(hi)); return r; }

#define ACC_T f32x4 (&acc)[2][2][4][2]
#define FOR_AIM _Pragma("unroll") for (int ai = 0; ai < 2; ++ai) _Pragma("unroll") for (int m = 0; m < 4; ++m)
#define FOR_BJN _Pragma("unroll") for (int bj = 0; bj < 2; ++bj) _Pragma("unroll") for (int n = 0; n < 2; ++n)

struct EpiF32Bias {
    static constexpr bool PERM = false, HAS_MID = false;
    float* C; int ldc; const float* bias;
    __device__ __forceinline__ void mid(ACC_T, const Unit&, int, int, int, int) const {}
    __device__ __forceinline__ void operator()(ACC_T, const Unit& u, int wr, int wc, int fr, int fq) const {
        const int row0 = u.pm * BM + wr * 64 + fr, col0 = u.pn * BM + wc * 32 + 4 * fq;
        f32x4 bv[2][2];
        FOR_BJN bv[bj][n] = *(const f32x4*)(bias + col0 + bj * HALF + n * 16);
        FOR_AIM { float* rowp = C + (size_t)(row0 + ai * HALF + m * 16) * ldc + col0;
            FOR_BJN *(f32x4*)(rowp + bj * HALF + n * 16) = acc[ai][bj][m][n] + bv[bj][n]; }
    }
};
template <int ACT  > struct EpiBf16 {
    static constexpr bool PERM = true, HAS_MID = false;
    bf16_t* O; int ldc;
    __device__ __forceinline__ void mid(ACC_T, const Unit&, int, int, int, int) const {}
    __device__ __forceinline__ void operator()(ACC_T, const Unit& u, int wr, int wc, int fr, int fq) const {
        const int row0 = u.pm * BM + wr * 64 + fr, col0 = u.pn * BM + wc * 32 + 8 * fq;
        FOR_AIM { bf16_t* rowp = O + (size_t)(row0 + ai * HALF + m * 16) * ldc + col0;
#pragma unroll
            for (int bj = 0; bj < 2; ++bj) { f32x4 v0 = acc[ai][bj][m][0], v1 = acc[ai][bj][m][1];
                if (ACT == 1) {
#pragma unroll
                    for (int j = 0; j < 4; ++j) { const float a = fmaxf(v0[j], 0.f), b = fmaxf(v1[j], 0.f); v0[j] = a * a; v1[j] = b * b; } }
                u32x4 w; w.x = cvt_pk_bf16(v0[0], v0[1]); w.y = cvt_pk_bf16(v0[2], v0[3]); w.z = cvt_pk_bf16(v1[0], v1[1]); w.w = cvt_pk_bf16(v1[2], v1[3]);
                __builtin_nontemporal_store(w, (u32x4*)(rowp + bj * HALF)); } }
    }
};
struct EpiLora {
    static constexpr bool PERM = true, HAS_MID = false;
    bf16_t* C; const float* w0; const float* a0;
    __device__ __forceinline__ void mid(ACC_T, const Unit&, int, int, int, int) const {}
    __device__ __forceinline__ void operator()(ACC_T, const Unit& u, int wr, int wc, int fr, int fq) const {
        const int row0 = u.pm * BM + wr * 64 + fr, col0 = u.pn * BM + wc * 32 + 8 * fq, seg = u.pn >> 3, cs0 = col0 - seg * 2048;
        f32x4 bv[2][2];
        FOR_BJN bv[bj][n] = seg == 0 ? *(const f32x4*)(w0 + cs0 + bj * HALF + n * 4) : seg == 1 ? *(const f32x4*)(a0 + cs0 + bj * HALF + n * 4) : (f32x4){0.f, 0.f, 0.f, 0.f};
        FOR_AIM { bf16_t* rowp = C + (size_t)(row0 + ai * HALF + m * 16) * LORA_N + col0;
#pragma unroll
            for (int bj = 0; bj < 2; ++bj) { f32x4 vv[2];
#pragma unroll
                for (int n = 0; n < 2; ++n) { f32x4 v = acc[ai][bj][m][n] + bv[bj][n];
                    if (seg == 0) {
#pragma unroll
                        for (int j = 0; j < 4; ++j) { const float y = -v[j]; const float sp = fmaxf(y, 0.f) + 0.6931471805599453f * __builtin_amdgcn_logf(1.0f + __builtin_amdgcn_exp2f(-1.4426950408889634f * fabsf(y)));
                            v[j] = -__builtin_amdgcn_exp2f(1.4426950408889634f * (-sp - 0.5f)); } }
                    else if (seg == 1) {
#pragma unroll
                        for (int j = 0; j < 4; ++j) v[j] = fsig(v[j]); }
                    vv[n] = v; }
                u32x4 w; w.x = cvt_pk_bf16(vv[0][0], vv[0][1]); w.y = cvt_pk_bf16(vv[0][2], vv[0][3]); w.z = cvt_pk_bf16(vv[1][0], vv[1][1]); w.w = cvt_pk_bf16(vv[1][2], vv[1][3]);
                *(u32x4*)(rowp + bj * HALF) = w; } }
    }
};
struct EpiMerge {
    static constexpr bool PERM = true, HAS_MID = false;
    bf16_t* O; const bf16_t* P; float* T;
    __device__ __forceinline__ void mid(ACC_T, const Unit&, int, int, int, int) const {}
    __device__ __forceinline__ void operator()(ACC_T, const Unit& u, int wr, int wc, int fr, int fq) const {
        const int row0 = u.pm * BM + wr * 64 + fr, col0 = u.pn * BM + wc * 32 + 8 * fq; const bool second = u.koff != 0;
        FOR_AIM { const int row = row0 + ai * HALF + m * 16; bf16_t* rowp = O + (size_t)row * D + col0; float* trow = T + (size_t)row * D + col0; const bf16_t* grow = P + (size_t)row * LDP + (second ? PC_GB : PC_GA) + col0;
#pragma unroll
            for (int bj = 0; bj < 2; ++bj) { const u32x4 gw = *(const u32x4*)(grow + bj * HALF);
                f32x4 v0 = acc[ai][bj][m][0], v1 = acc[ai][bj][m][1];
                v0[0] *= fsig(bflo(gw.x)); v0[1] *= fsig(bfhi(gw.x)); v0[2] *= fsig(bflo(gw.y)); v0[3] *= fsig(bfhi(gw.y));
                v1[0] *= fsig(bflo(gw.z)); v1[1] *= fsig(bfhi(gw.z)); v1[2] *= fsig(bflo(gw.w)); v1[3] *= fsig(bfhi(gw.w));
                if (!second) { *(f32x4*)(trow + bj * HALF) = v0; *(f32x4*)(trow + bj * HALF + 4) = v1; }
                else { v0 += *(const f32x4*)(trow + bj * HALF); v1 += *(const f32x4*)(trow + bj * HALF + 4);
                    u32x4 w; w.x = cvt_pk_bf16(v0[0], v0[1]); w.y = cvt_pk_bf16(v0[2], v0[3]); w.z = cvt_pk_bf16(v1[0], v1[1]); w.w = cvt_pk_bf16(v1[2], v1[3]);
                    *(u32x4*)(rowp + bj * HALF) = w; } }
            asm volatile("" ::: "memory"); }
    }
};
struct EpiMergeChain {
    static constexpr bool PERM = true, HAS_MID = false, CHAIN = true;
    bf16_t* O; const bf16_t* P;
    __device__ __forceinline__ static float em(float x) { return __builtin_amdgcn_exp2f(fminf(x * -1.4426950408889634f, 115.f)); }
    __device__ __forceinline__ void mid(ACC_T, const Unit&, int, int, int, int) const {}
    __device__ __forceinline__ void operator()(ACC_T, const Unit&, int, int, int, int) const {}
    __device__ __forceinline__ void chain(ACC_T, const Unit& u, int wr, int wc, int fr, int fq) const {
        const int row0 = u.pm * BM + wr * 64 + fr, col0 = u.pn * BM + wc * 32 + 8 * fq; const bool fin = u.fin != 0; const float keep = fin ? 0.f : 1.f;
#pragma unroll
        for (int ai = 0; ai < 2; ++ai) {
            int rb = row0; asm volatile("" : "+v"(rb));
            u32x4 ga[4][2], gb[4][2];
#pragma unroll
            for (int m = 0; m < 4; ++m) { const bf16_t* grow = P + (size_t)(rb + ai * HALF + m * 16) * LDP + col0;
#pragma unroll
                for (int bj = 0; bj < 2; ++bj) { ga[m][bj] = (u32x4){0u, 0u, 0u, 0u}; if (!fin) ga[m][bj] = __builtin_nontemporal_load((const u32x4*)(grow + PC_GA + bj * HALF));
                    if (fin) gb[m][bj] = __builtin_nontemporal_load((const u32x4*)(grow + PC_GB + bj * HALF)); else gb[m][bj] = *(const u32x4*)(grow + PC_GB + bj * HALF); } }
            __builtin_amdgcn_sched_barrier(0);
#pragma unroll
            for (int m = 0; m < 4; ++m) { bf16_t* rowp = O + (size_t)(rb + ai * HALF + m * 16) * D + col0;
#pragma unroll
                for (int bj = 0; bj < 2; ++bj) { const u32x4 a = ga[m][bj], b = gb[m][bj];
                    const float av[8] = {bflo(a.x), bfhi(a.x), bflo(a.y), bfhi(a.y), bflo(a.z), bfhi(a.z), bflo(a.w), bfhi(a.w)}, bv[8] = {bflo(b.x), bfhi(b.x), bflo(b.y), bfhi(b.y), bflo(b.z), bfhi(b.z), bflo(b.w), bfhi(b.w)};
                    float v[8];
#pragma unroll
                    for (int e = 0; e < 8; ++e) { const float eb = 1.0f + em(bv[e]), ea = 1.0f + em(av[e]); v[e] = acc[ai][bj][m][e >> 2][e & 3] * ((fin ? 1.0f : eb) * __builtin_amdgcn_rcpf(fin ? eb : ea)); }
                    if (fin) { u32x4 w; w.x = cvt_pk_bf16(v[0], v[1]); w.y = cvt_pk_bf16(v[2], v[3]); w.z = cvt_pk_bf16(v[4], v[5]); w.w = cvt_pk_bf16(v[6], v[7]); *(u32x4*)(rowp + bj * HALF) = w; }
#pragma unroll
                    for (int e = 0; e < 8; ++e) acc[ai][bj][m][e >> 2][e & 3] = v[e] * keep;
                    asm volatile("" : "+v"(acc[ai][bj][m][0]), "+v"(acc[ai][bj][m][1])); } }
            asm volatile("" ::: "memory"); }
    }
};
template <bool BASE_BF16> struct EpiResGate {
    static constexpr bool PERM = true, HAS_MID = false;
    const float* bp; const float* bs; const float* gate; bf16_t* out;
    __device__ __forceinline__ void mid(ACC_T, const Unit&, int, int, int, int) const {}
    __device__ __forceinline__ void operator()(ACC_T, const Unit& u, int wr, int wc, int fr, int fq) const {
        const int row0 = u.pm * BM + wr * 64 + fr, col0 = u.pn * BM + wc * 32 + 8 * fq;
        const bool uni = u.pm < NPROMPT / BM;
        f32x4 gq[2][2];
        { const float* g0p = gate + (size_t)seq_of_row(u.pm * BM) * NMOD + col0;
#pragma unroll
          for (int bj = 0; bj < 2; ++bj) { gq[bj][0] = *(const f32x4*)(g0p + bj * HALF); gq[bj][1] = *(const f32x4*)(g0p + bj * HALF + 4); } }
        FOR_AIM { const int row = row0 + ai * HALF + m * 16; const int s = seq_of_row(row);
            const float* grow = gate + (size_t)s * NMOD + col0; bf16_t* orow = out + (size_t)row * D + col0;
#pragma unroll
            for (int bj = 0; bj < 2; ++bj) { f32x4 b0, b1;
                if (BASE_BF16) { const u32x4 bw = __builtin_nontemporal_load((const u32x4*)((const bf16_t*)bp + (size_t)row * D + col0 + bj * HALF));
                    b0 = (f32x4){bflo(bw.x), bfhi(bw.x), bflo(bw.y), bfhi(bw.y)}; b1 = (f32x4){bflo(bw.z), bfhi(bw.z), bflo(bw.w), bfhi(bw.w)}; }
                else { const float* brow = (row < NPROMPT ? bp + (size_t)row * D : bs + (size_t)(row - NPROMPT) * D) + col0 + bj * HALF; b0 = __builtin_nontemporal_load((const f32x4*)brow); b1 = __builtin_nontemporal_load((const f32x4*)(brow + 4)); }
                f32x4 g0 = gq[bj][0], g1 = gq[bj][1]; if (!uni) { g0 = *(const f32x4*)(grow + bj * HALF); g1 = *(const f32x4*)(grow + bj * HALF + 4); }
                const f32x4 v0 = b0 + g0 * acc[ai][bj][m][0], v1 = b1 + g1 * acc[ai][bj][m][1];
                u32x4 w; w.x = cvt_pk_bf16(v0[0], v0[1]); w.y = cvt_pk_bf16(v0[2], v0[3]); w.z = cvt_pk_bf16(v1[0], v1[1]); w.w = cvt_pk_bf16(v1[2], v1[3]);
                *(u32x4*)(orow + bj * HALF) = w; } }
    }
};

template <class T, class = void> struct epi_chain { static constexpr bool value = false; };
template <class T> struct epi_chain<T, decltype((void)T::CHAIN)> { static constexpr bool value = T::CHAIN; };
template <class Epi, class Sched>
__device__ __forceinline__ void gemm_phase(LAS unsigned char* lds, const Gemm g, const Sched& S, const Epi& E) {
    const int tid = threadIdx.x, wid = __builtin_amdgcn_readfirstlane(tid >> 6), lane = tid & 63, wr = wid >> 2, wc = wid & 3, fr = lane & 15, fq = lane >> 4;
    unsigned voffA[2], voffB[2];
#pragma unroll
    for (int i = 0; i < 2; ++i) { int R, C; stage_rc(tid * 16 + i * 8192, R, C); const int Rb = Epi::PERM ? ((R & ~31) + perm32(R & 31)) : R;
        voffA[i] = (unsigned)(R * g.lda + C) * 2u; voffB[i] = (unsigned)(Rb * g.ldb + C) * 2u; }
    const size_t kstep = (size_t)(BK * 2);
    const size_t hstepA = (size_t)HALF * g.lda * 2, hstepB = (size_t)HALF * g.ldb * 2, tstepA = 2 * hstepA, tstepB = 2 * hstepB;
    const unsigned ldsw = (unsigned)wid * 1024u;
    const int aoff0 = lds_byte(wr * 64 + fr, fq * 8), aoff1 = lds_byte(wr * 64 + fr, 32 + fq * 8), boff0 = lds_byte(wc * 32 + fr, fq * 8), boff1 = lds_byte(wc * 32 + fr, 32 + fq * 8);
#define PG8_SA(b, h) (((b) * 2 + (h)) * HTB)
#define PG8_SB(b, h) ((4 + (b) * 2 + (h)) * HTB)
#define PG8_STAGE(bufoff, gbase, voff) do { _Pragma("unroll") for (int _i = 0; _i < 2; ++_i) \
        __builtin_amdgcn_global_load_lds((const unsigned*)((const char*)(gbase) + (voff)[_i]), (LAS unsigned*)(lds + (bufoff) + ldsw + _i * 8192), 16, 0, 0); } while (0)
#define PG8_LDA(dst, b, h) do { _Pragma("unroll") for (int m = 0; m < 4; ++m) _Pragma("unroll") for (int k = 0; k < 2; ++k) dst[m][k] = *(const LAS bf16x8*)(lds + PG8_SA(b, h) + (k ? aoff1 : aoff0) + m * 2048); } while (0)
#define PG8_LDB(dst, b, h) do { _Pragma("unroll") for (int n = 0; n < 2; ++n) _Pragma("unroll") for (int k = 0; k < 2; ++k) dst[n][k] = *(const LAS bf16x8*)(lds + PG8_SB(b, h) + (k ? boff1 : boff0) + n * 2048); } while (0)
#define PG8_MMA(ai, bj, At, Bt) do { __builtin_amdgcn_s_setprio(1); _Pragma("unroll") for (int m = 0; m < 4; ++m) _Pragma("unroll") for (int n = 0; n < 2; ++n) _Pragma("unroll") for (int k = 0; k < 2; ++k) \
        acc[ai][bj][m][n] = __builtin_amdgcn_mfma_f32_16x16x32_bf16(Bt[n][k], At[m][k], acc[ai][bj][m][n], 0, 0, 0); __builtin_amdgcn_s_setprio(0); } while (0)
#define PG8_WAIT_V(n) asm volatile("s_waitcnt vmcnt(" #n ")" ::: "memory")
#define PG8_WAIT_L(n) asm volatile("s_waitcnt lgkmcnt(" #n ")" ::: "memory")
#define PG8_BAR __builtin_amdgcn_s_barrier()
#define PG8_SCHED __builtin_amdgcn_sched_barrier(0)
    Unit cur, nxt; int ui = 0;
    if (!S.next(0, cur)) return;
    f32x4 acc[2][2][4][2];
#pragma unroll
    for (int a = 0; a < 2; ++a)
#pragma unroll
        for (int b = 0; b < 2; ++b)
#pragma unroll
            for (int m = 0; m < 4; ++m)
#pragma unroll
                for (int n = 0; n < 2; ++n) acc[a][b][m][n] = (f32x4){0.f, 0.f, 0.f, 0.f};
    bf16x8 At[4][2], B0[2][2], B1[2][2];
    const char* cA = (const char*)g.A + (size_t)cur.pm * tstepA + cur.koff; const char* cB = (const char*)g.Bt + (size_t)cur.pn * tstepB + cur.koff;
    PG8_STAGE(PG8_SB(0, 0), cB, voffB); PG8_STAGE(PG8_SB(0, 1), cB + hstepB, voffB); PG8_STAGE(PG8_SA(0, 0), cA, voffA); PG8_STAGE(PG8_SA(0, 1), cA + hstepA, voffA);
    if (wr == 1) PG8_BAR;
    PG8_WAIT_V(2); PG8_BAR;
    PG8_STAGE(PG8_SB(1, 0), cB + kstep, voffB); PG8_STAGE(PG8_SA(1, 0), cA + kstep, voffA); PG8_STAGE(PG8_SB(1, 1), cB + hstepB + kstep, voffB);
    PG8_WAIT_V(6); PG8_BAR;
    for (;;) {
        const bool has_next = S.next(ui + 1, nxt);
        const char* nA = has_next ? (const char*)g.A + (size_t)nxt.pm * tstepA + nxt.koff : cA; const char* nB = has_next ? (const char*)g.Bt + (size_t)nxt.pn * tstepB + nxt.koff : cB;
        const int nt = cur.nt;
        for (int t = 0; t < nt; t += 2) {
            const bool last = (t == nt - 2);
            const char* a1 = cA + (size_t)(t + 1) * kstep;
            const char* a2 = last ? nA : cA + (size_t)(t + 2) * kstep; const char* b2 = last ? nB : cB + (size_t)(t + 2) * kstep;
            const char* a3 = a2 + kstep; const char* b3 = b2 + kstep;
            PG8_LDB(B0, 0, 0); PG8_LDB(B1, 0, 1); PG8_SCHED; PG8_LDA(At, 0, 0); PG8_STAGE(PG8_SA(1, 1), a1 + hstepA, voffA);
            PG8_WAIT_V(8); PG8_WAIT_L(0); PG8_BAR; PG8_MMA(0, 0, At, B0); PG8_MMA(0, 1, At, B1); PG8_BAR; PG8_SCHED;
            PG8_LDA(At, 0, 1); PG8_STAGE(PG8_SB(0, 0), b2, voffB); PG8_STAGE(PG8_SB(0, 1), b2 + hstepB, voffB); PG8_STAGE(PG8_SA(0, 0), a2, voffA);
            PG8_WAIT_V(8); PG8_WAIT_L(0); PG8_BAR; PG8_MMA(1, 0, At, B0); PG8_MMA(1, 1, At, B1); PG8_BAR; PG8_SCHED;
            PG8_LDB(B0, 1, 0); PG8_LDB(B1, 1, 1); PG8_SCHED; PG8_LDA(At, 1, 0); PG8_STAGE(PG8_SA(0, 1), a2 + hstepA, voffA);
            PG8_WAIT_V(8); PG8_WAIT_L(0); PG8_BAR; PG8_MMA(0, 0, At, B0); PG8_MMA(0, 1, At, B1); PG8_BAR; PG8_SCHED;
            PG8_LDA(At, 1, 1); PG8_STAGE(PG8_SB(1, 0), b3, voffB); PG8_STAGE(PG8_SB(1, 1), b3 + hstepB, voffB); PG8_STAGE(PG8_SA(1, 0), a3, voffA);
            PG8_WAIT_V(8); PG8_WAIT_L(0); PG8_BAR; PG8_MMA(1, 0, At, B0); PG8_MMA(1, 1, At, B1); PG8_BAR; PG8_SCHED;
        }
        if (wr == 0) PG8_BAR;
        if constexpr (epi_chain<Epi>::value) { E.chain(acc, cur, wr, wc, fr, fq); }
        else if (cur.fin) {
            E(acc, cur, wr, wc, fr, fq);
            if (has_next) {
#pragma unroll
                for (int a = 0; a < 2; ++a)
#pragma unroll
                    for (int b = 0; b < 2; ++b)
#pragma unroll
                        for (int m = 0; m < 4; ++m)
#pragma unroll
                            for (int n = 0; n < 2; ++n) acc[a][b][m][n] = (f32x4){0.f, 0.f, 0.f, 0.f};
            }
        } else { if constexpr (Epi::HAS_MID) E.mid(acc, cur, wr, wc, fr, fq); }
        if (!has_next) break;
        cur = nxt; cA = nA; cB = nB; ++ui;
        if (wr == 1) PG8_BAR;
    }
    PG8_WAIT_V(0);
    PG8_BAR;
#undef PG8_SA
#undef PG8_SB
#undef PG8_STAGE
#undef PG8_LDA
#undef PG8_LDB
#undef PG8_MMA
#undef PG8_WAIT_V
#undef PG8_WAIT_L
#undef PG8_BAR
#undef PG8_SCHED
}
__device__ __forceinline__ void st_sc1(float* p, f32x4 v) { asm volatile("global_store_dwordx4 %0, %1, off sc1\n\ts_nop 1" :: "v"(p), "v"(v) : "memory"); }
struct EpiSlab {
    static constexpr bool PERM = false, HAS_MID = false;
    float* C;
    __device__ __forceinline__ void mid(ACC_T, const Unit&, int, int, int, int) const {}
    __device__ __forceinline__ void operator()(ACC_T, const Unit&, int wr, int wc, int fr, int fq) const {
        FOR_AIM { float* rowp = C + (size_t)(wr * 64 + fr + ai * HALF + m * 16) * 256 + wc * 32 + 4 * fq;
            FOR_BJN st_sc1(rowp + bj * HALF + n * 16, acc[ai][bj][m][n]); }
    }
};
struct TailArgs { float* slabs; unsigned* flags; const float* bp; const float* bs; const float* gate; float* outf; bf16_t* outb; int ldo; const bf16_t* P; };
template <int S, int MODE>
__device__ __forceinline__ void gemm_tail(LAS unsigned char* lds, const Gemm g, int nM, int nN, int G, int c, int R, int nt_slice, const TailArgs& a) {
    const int ntail = nM * nN - R * G, tileIdx = c % ntail, slice = c / ntail, tid = threadIdx.x;
    if (ntail * S != G) return;
    OneUnit S1; tile_of(R * G + tileIdx, nM, nN, S1.u.pm, S1.u.pn); S1.u.koff = slice * nt_slice * BK * 2; S1.u.nt = nt_slice; S1.u.fin = 1;
    float* tslab = a.slabs + (size_t)tileIdx * S * 65536;
    EpiSlab E{tslab + (size_t)slice * 65536};
    gemm_phase(lds, g, S1, E);
    unsigned* flag = a.flags + tileIdx * 64;
    if (tid == 0) { __hip_atomic_fetch_add(flag, 1u, __ATOMIC_RELAXED, __HIP_MEMORY_SCOPE_AGENT); unsigned sp = 0;
        while (__hip_atomic_load(flag, __ATOMIC_RELAXED, __HIP_MEMORY_SCOPE_AGENT) < (unsigned)S) { __builtin_amdgcn_s_sleep(1); if (++sp > (1u << 22)) break; }
        __builtin_amdgcn_fence(__ATOMIC_ACQUIRE, "agent"); asm volatile("s_waitcnt vmcnt(0)" ::: "memory"); }
    __syncthreads();
    constexpr int RPS = 256 / S;
#pragma unroll
    for (int j = 0; j < RPS / 8; ++j) { const int idx = j * 512 + tid, r = slice * RPS + (idx >> 6), c4 = (idx & 63) * 4;
        f32x4 s0 = (f32x4){0.f, 0.f, 0.f, 0.f}, s1 = s0;
#pragma unroll
        for (int q = 0; q < S; ++q) { const f32x4 v = *(const f32x4*)(tslab + (size_t)q * 65536 + r * 256 + c4); if (MODE == 2 && q >= S / 2) s1 += v; else s0 += v; }
        const int row = S1.u.pm * 256 + r, col = S1.u.pn * 256 + c4;
        if (MODE == 0 || MODE == 3) { const f32x4 gv = *(const f32x4*)(a.gate + (size_t)seq_of_row(row) * NMOD + col); f32x4 bv;
            if (MODE == 0) bv = *(const f32x4*)((row < NPROMPT ? a.bp + (size_t)row * D : a.bs + (size_t)(row - NPROMPT) * D) + col);
            else { const u32x2 bw = *(const u32x2*)((const bf16_t*)a.bp + (size_t)row * D + col); bv = (f32x4){bflo(bw.x), bfhi(bw.x), bflo(bw.y), bfhi(bw.y)}; }
            const f32x4 v = bv + gv * s0; u32x2 w; w.x = cvt_pk_bf16(v[0], v[1]); w.y = cvt_pk_bf16(v[2], v[3]); *(u32x2*)(a.outb + (size_t)row * a.ldo + col) = w; }
        else if (MODE == 1) { f32x4 v = s0;
#pragma unroll
            for (int e = 0; e < 4; ++e) { const float x = fmaxf(v[e], 0.f); v[e] = x * x; }
            u32x2 w; w.x = cvt_pk_bf16(v[0], v[1]); w.y = cvt_pk_bf16(v[2], v[3]); *(u32x2*)(a.outb + (size_t)row * a.ldo + col) = w; }
        else { const u32x2 ga = *(const u32x2*)(a.P + (size_t)row * LDP + PC_GA + col), gb = *(const u32x2*)(a.P + (size_t)row * LDP + PC_GB + col);
            const float o0 = fsig(bflo(ga.x)) * s0[0] + fsig(bflo(gb.x)) * s1[0], o1 = fsig(bfhi(ga.x)) * s0[1] + fsig(bfhi(gb.x)) * s1[1], o2 = fsig(bflo(ga.y)) * s0[2] + fsig(bflo(gb.y)) * s1[2], o3 = fsig(bfhi(ga.y)) * s0[3] + fsig(bfhi(gb.y)) * s1[3];
            u32x2 w; w.x = cvt_pk_bf16(o0, o1); w.y = cvt_pk_bf16(o2, o3); *(u32x2*)(a.outb + (size_t)row * a.ldo + col) = w; }
    }
}
}

#define XB_TMO      128
#define XB_XCNT(j)  (256  + 64 * (j))
#define XB_XSUB(j)  (1280 + 64 * (j))
#define XB_XGEN(j)  (2304 + 64 * (j))
#define XB_TOP      3328
#define XB_TOPGEN   3392
#define XCD_BAR_WORDS 3456
#define XB_SPIN_CAP (1u << 18)
__device__ __forceinline__ unsigned xb_ld(unsigned* p)              { return __hip_atomic_load(p, __ATOMIC_RELAXED, __HIP_MEMORY_SCOPE_AGENT); }
__device__ __forceinline__ unsigned xb_add(unsigned* p, unsigned v) { return __hip_atomic_fetch_add(p, v, __ATOMIC_RELAXED, __HIP_MEMORY_SCOPE_AGENT); }
__device__ __forceinline__ unsigned xb_xcc_id() { return (unsigned)__builtin_amdgcn_s_getreg((3 << 11) | 20) & 0xFu; }
#define XB_SPIN(cond, bar) do { unsigned _sp = 0; while (cond) { __builtin_amdgcn_s_sleep(1); \
    if ((++_sp & 255u) == 0u) { if (xb_ld(&(bar)[XB_TMO])) break; if (_sp > XB_SPIN_CAP) { atomicAdd(&(bar)[XB_TMO], 1u); break; } } } } while (0)
struct XcdBarrier { unsigned* bar; unsigned x; volatile LAS unsigned* st; };
__device__ __forceinline__ XcdBarrier xcd_barrier_post(unsigned* bar, volatile LAS unsigned* st) {
    XcdBarrier b; b.bar = bar; b.x = xb_xcc_id(); b.st = st;
    if (threadIdx.x == 0) (void)xb_add(&bar[XB_XCNT(b.x)], 1u);
    return b;
}
__device__ __forceinline__ void xcd_barrier_complete(unsigned* bar, unsigned x, unsigned& nloc, unsigned& nx) {
    const unsigned G = gridDim.x * gridDim.y * gridDim.z;
    unsigned sum, cnt, mine, sp = 0u;
    for (;;) {
        sum = 0u; cnt = 0u; mine = 0u;
#pragma unroll
        for (unsigned j = 0; j < 16; ++j) { const unsigned c = xb_ld(&bar[XB_XCNT(j)]); sum += c; cnt += (c > 0u) ? 1u : 0u; mine = (j == x) ? c : mine; }
        if (sum == G) break;
        __builtin_amdgcn_s_sleep(1);
        if ((++sp & 255u) == 0u) { if (xb_ld(&bar[XB_TMO])) break; if (sp > XB_SPIN_CAP) { atomicAdd(&bar[XB_TMO], 1u); break; } }
    }
    nloc = mine > 0u ? mine : 1u; nx = cnt > 0u ? cnt : 1u;
}
__device__ __forceinline__ void xcd_barrier(const XcdBarrier& b) {
    asm volatile("s_waitcnt vmcnt(0)" ::: "memory");
    __syncthreads();
    if (threadIdx.x == 0) {
        unsigned* bar = b.bar;
        __builtin_amdgcn_s_waitcnt(0);
        unsigned nloc = b.st[0], nx = b.st[1];
        if (nloc == 0u) { xcd_barrier_complete(bar, b.x, nloc, nx); b.st[0] = nloc; b.st[1] = nx; }
        const unsigned old = xb_add(&bar[XB_XSUB(b.x)], 1u);
        const unsigned gen = old / nloc;
        if (old + 1u == (gen + 1u) * nloc) {
            __builtin_amdgcn_fence(__ATOMIC_RELEASE, "agent");
            asm volatile("s_waitcnt vmcnt(0)" ::: "memory");
            const unsigned og = xb_add(&bar[XB_TOP], 1u);
            const unsigned tg = og / nx;
            if (og + 1u == (tg + 1u) * nx) xb_add(&bar[XB_TOPGEN], 1u);
            else XB_SPIN(xb_ld(&bar[XB_TOPGEN]) == tg, bar);
            __builtin_amdgcn_fence(__ATOMIC_ACQUIRE, "agent");
            xb_add(&bar[XB_XGEN(b.x)], 1u);
            asm volatile("s_waitcnt vmcnt(0)" ::: "memory");
        } else {
            XB_SPIN(xb_ld(&bar[XB_XGEN(b.x)]) == gen, bar);
            __builtin_amdgcn_fence(__ATOMIC_ACQUIRE, "agent");
            asm volatile("s_waitcnt vmcnt(0)" ::: "memory");
        }
    }
    __syncthreads();
}

constexpr int CW_BAR = 4096, CW_TAIL = 16384;
static_assert((size_t)(CW_TAIL + 4 * 8192) * 4 <= CTL_ZERO_BYTES && CW_BAR + XCD_BAR_WORDS <= CW_TAIL, "control words inside the zeroed area");
struct Args { const float* in[34]; float* out; unsigned char* ws; int ph_lo, ph_hi, sub; };
enum { I_XP = 0, I_XS, I_SWKV, I_SSHIFT, I_SGDN, I_SCONV, I_CP, I_CS, I_N1W, I_N2W, I_WADA, I_BADA, I_WIN, I_RMU, I_RW0, I_RWW2, I_RA0, I_RWA2, I_RWG2, I_RKK, I_RKA, I_RRK, I_LNXW, I_LNXB, I_CONVW, I_ALOG, I_DTB, I_GNW, I_WOA, I_WOB, I_WOUT, I_WUP, I_WDOWN, I_FNW };
constexpr int NPHASE = 16;

__device__ __forceinline__ void transpose_item(const float* W, int N, int k0, int n0, bf16_t* WT, size_t dst_row0, int dst_ld, int dst_k0, LAS float* scr, int lane) {
    float xv[32];
#pragma unroll
    for (int i = 0; i < 32; ++i) { const int kk = 2 * i + (lane >> 5); xv[i] = __builtin_nontemporal_load(W + (size_t)(k0 + kk) * N + n0 + (lane & 31)); }
    __builtin_amdgcn_sched_barrier(0);
#pragma unroll
    for (int i = 0; i < 32; ++i) { const int kk = 2 * i + (lane >> 5); scr[kk * 33 + (lane & 31)] = xv[i]; }
    asm volatile("s_waitcnt lgkmcnt(0)" ::: "memory");
    const int c = lane & 7;
#pragma unroll
    for (int j = 0; j < 4; ++j) { const int n = (lane >> 3) + 8 * j; const LAS float* s = scr + (8 * c) * 33 + n;
        u32x4 o; o.x = pk2(s[0 * 33], s[1 * 33]); o.y = pk2(s[2 * 33], s[3 * 33]); o.z = pk2(s[4 * 33], s[5 * 33]); o.w = pk2(s[6 * 33], s[7 * 33]);
        *(u32x4*)(WT + (dst_row0 + n) * (size_t)dst_ld + dst_k0 + k0 + 8 * c) = o; }
    asm volatile("s_waitcnt lgkmcnt(0)" ::: "memory");
}

template <int MODE, bool IN_BF16>
__device__ __forceinline__ void norm_rows(const float* xp, const float* xs_, const float* nw, const float* mod, int sh_off, int sc_off, bf16_t* ob, float* of, int gw, int NGW, int lane) {
    constexpr int NR = IN_BF16 ? 8 : 16;
    f32x4 rc[NR], rn[NR];
#define NR_LOAD(R, mm) do { if (IN_BF16) { const bf16_t* xr_ = (const bf16_t*)xp + (size_t)(mm) * D; _Pragma("unroll") for (int j = 0; j < NR; ++j) R[j] = __builtin_nontemporal_load((const f32x4*)(xr_ + (j * 64 + lane) * 8)); } \
        else { const float* xr_ = ((mm) < NPROMPT ? xp + (size_t)(mm) * D : xs_ + (size_t)((mm) - NPROMPT) * D); _Pragma("unroll") for (int j = 0; j < NR; ++j) R[j] = __builtin_nontemporal_load((const f32x4*)(xr_ + (j * 64 + lane) * 4)); } } while (0)
    f32x4 nwv[16];
    if (MODE == 1) {
#pragma unroll
        for (int j = 0; j < 16; ++j) { const int c = IN_BF16 ? ((j >> 1) * 64 + lane) * 8 + (j & 1) * 4 : (j * 64 + lane) * 4; nwv[j] = *(const f32x4*)(nw + c); } }
    if (gw < MTOK) NR_LOAD(rc, gw);
    for (int m = gw; m < MTOK; m += NGW) {
        { const int mn = m + NGW < MTOK ? m + NGW : m; NR_LOAD(rn, mn); }
        f32x4 v[16]; float ss = 0.f;
        if (IN_BF16) {
#pragma unroll
            for (int j = 0; j < 8; ++j) { const u32x4 w = __builtin_bit_cast(u32x4, rc[j]); v[2 * j] = (f32x4){bflo(w.x), bfhi(w.x), bflo(w.y), bfhi(w.y)}; v[2 * j + 1] = (f32x4){bflo(w.z), bfhi(w.z), bflo(w.w), bfhi(w.w)}; }
        } else {
#pragma unroll
            for (int j = 0; j < 16; ++j) v[j] = rc[j < NR ? j : 0]; }
#pragma unroll
        for (int j = 0; j < 16; ++j) ss += (v[j].x * v[j].x + v[j].y * v[j].y) + (v[j].z * v[j].z + v[j].w * v[j].w);
        const float rstd = 1.0f / sqrtf(wave_sum(ss) * (1.0f / D) + 1e-6f);
        if (MODE == 0) {
            const int s = seq_of_row(m); const float* mr = mod + (size_t)s * NMOD;
#pragma unroll
            for (int j = 0; j < 16; ++j) { const int c = IN_BF16 ? ((j >> 1) * 64 + lane) * 8 + (j & 1) * 4 : (j * 64 + lane) * 4; const f32x4 w = *(const f32x4*)(nw + c), sc = *(const f32x4*)(mr + sc_off + c), sh = *(const f32x4*)(mr + sh_off + c);
                const f32x4 y = v[j] * rstd * w * (sc + 1.0f) + sh; u32x2 o; o.x = pk2(y.x, y.y); o.y = pk2(y.z, y.w); *(u32x2*)(ob + (size_t)m * D + c) = o; }
        } else {
#pragma unroll
            for (int j = 0; j < 16; ++j) { const int c = IN_BF16 ? ((j >> 1) * 64 + lane) * 8 + (j & 1) * 4 : (j * 64 + lane) * 4; *(f32x4*)(of + (size_t)m * D + c) = v[j] * rstd * nwv[j]; }
        }
#pragma unroll
        for (int j = 0; j < NR; ++j) rc[j] = rn[j];
    }
#undef NR_LOAD
}

template <bool IN_BF16>
__device__ __forceinline__ void norm_rows_blk(LAS unsigned char* lds, const float* xp, const float* xs_, const float* nw, const float* mod, int sh_off, int sc_off, bf16_t* ob, int bx, int G, int wave, int lane, int tid) {
    constexpr int NR = IN_BF16 ? 8 : 16;
    const int r0 = (int)(((long)MTOK * bx) / G), r1 = (int)(((long)MTOK * (bx + 1)) / G), seqc = seq_of_row(r0);
    LAS f32x4* gS = (LAS f32x4*)lds; LAS f32x4* hS = (LAS f32x4*)(lds + 16384);
    { const float* mr = mod + (size_t)seqc * NMOD;
      for (int i = tid; i < D / 4; i += NTHREADS) { const f32x4 w = *(const f32x4*)(nw + 4 * i), sc = *(const f32x4*)(mr + sc_off + 4 * i); gS[i] = w * (sc + 1.0f); hS[i] = *(const f32x4*)(mr + sh_off + 4 * i); } }
    __syncthreads();
    f32x4 rc[NR], rn[NR];
#define NRB_LOAD(R, mm) do { if (IN_BF16) { const bf16_t* xr_ = (const bf16_t*)xp + (size_t)(mm) * D; _Pragma("unroll") for (int j = 0; j < NR; ++j) R[j] = __builtin_nontemporal_load((const f32x4*)(xr_ + (j * 64 + lane) * 8)); } \
        else { const float* xr_ = ((mm) < NPROMPT ? xp + (size_t)(mm) * D : xs_ + (size_t)((mm) - NPROMPT) * D); _Pragma("unroll") for (int j = 0; j < NR; ++j) R[j] = __builtin_nontemporal_load((const f32x4*)(xr_ + (j * 64 + lane) * 4)); } } while (0)
    if (r0 + wave < r1) NRB_LOAD(rc, r0 + wave);
    for (int m = r0 + wave; m < r1; m += NWAVES) {
        { const int mn = m + NWAVES < r1 ? m + NWAVES : m; NRB_LOAD(rn, mn); }
        f32x4 v[16]; float ss = 0.f;
        if (IN_BF16) {
#pragma unroll
            for (int j = 0; j < 8; ++j) { const u32x4 w = __builtin_bit_cast(u32x4, rc[j]); v[2 * j] = (f32x4){bflo(w.x), bfhi(w.x), bflo(w.y), bfhi(w.y)}; v[2 * j + 1] = (f32x4){bflo(w.z), bfhi(w.z), bflo(w.w), bfhi(w.w)}; }
        } else {
#pragma unroll
            for (int j = 0; j < 16; ++j) v[j] = rc[j < NR ? j : 0]; }
#pragma unroll
        for (int j = 0; j < 16; ++j) ss += (v[j].x * v[j].x + v[j].y * v[j].y) + (v[j].z * v[j].z + v[j].w * v[j].w);
        const float rstd = 1.0f / sqrtf(wave_sum(ss) * (1.0f / D) + 1e-6f);
        const int s = seq_of_row(m);
        if (s == seqc) {
#pragma unroll
            for (int j = 0; j < 16; ++j) { const int c = IN_BF16 ? ((j >> 1) * 64 + lane) * 8 + (j & 1) * 4 : (j * 64 + lane) * 4;
                const f32x4 y = v[j] * rstd * gS[c >> 2] + hS[c >> 2]; u32x2 o; o.x = pk2(y.x, y.y); o.y = pk2(y.z, y.w); *(u32x2*)(ob + (size_t)m * D + c) = o; }
        } else { const float* mr = mod + (size_t)s * NMOD;
#pragma unroll
            for (int j = 0; j < 16; ++j) { const int c = IN_BF16 ? ((j >> 1) * 64 + lane) * 8 + (j & 1) * 4 : (j * 64 + lane) * 4; const f32x4 w = *(const f32x4*)(nw + c), sc = *(const f32x4*)(mr + sc_off + c), sh = *(const f32x4*)(mr + sh_off + c);
                const f32x4 y = v[j] * rstd * (w * (sc + 1.0f)) + sh; u32x2 o; o.x = pk2(y.x, y.y); o.y = pk2(y.z, y.w); *(u32x2*)(ob + (size_t)m * D + c) = o; }
        }
#pragma unroll
        for (int j = 0; j < NR; ++j) rc[j] = rn[j];
    }
#undef NRB_LOAD
    __syncthreads();
}

#define RWKV_STEP(S, w4, kk4, b4, kp4, r4, vv, oo) do { \
    float sa_ = S.x * kk4.x + S.y * kk4.y + S.z * kk4.z + S.w * kk4.w; sa_ = -row16_sum(sa_); \
    S.x = S.x * w4.x + sa_ * b4.x + vv * kp4.x; S.y = S.y * w4.y + sa_ * b4.y + vv * kp4.y; S.z = S.z * w4.z + sa_ * b4.z + vv * kp4.z; S.w = S.w * w4.w + sa_ * b4.w + vv * kp4.w; \
    float o_ = S.x * r4.x + S.y * r4.y + S.z * r4.z + S.w * r4.w; oo = row16_sum(o_); } while (0)

struct RwStep { f32x4 w4, kk4, b4, kp4, r4; float vv; };
#define RW_LD(d, bk, bv, off) do { \
    asm volatile("ds_read_b128 %0, %1 offset:%2" : "=v"(d.w4) : "v"(bk), "n"((off))); asm volatile("ds_read_b128 %0, %1 offset:%2" : "=v"(d.kk4) : "v"(bk), "n"((off) + 256)); \
    asm volatile("ds_read_b128 %0, %1 offset:%2" : "=v"(d.b4) : "v"(bk), "n"((off) + 512)); asm volatile("ds_read_b128 %0, %1 offset:%2" : "=v"(d.kp4) : "v"(bk), "n"((off) + 768)); \
    asm volatile("ds_read_b128 %0, %1 offset:%2" : "=v"(d.r4) : "v"(bk), "n"((off) + 1024)); asm volatile("ds_read_b32 %0, %1 offset:%2" : "=v"(d.vv) : "v"(bv), "n"((off))); } while (0)
#define RW_WAIT(d, n) do { asm volatile("s_waitcnt lgkmcnt(" #n ")" : "+v"(d.w4), "+v"(d.kk4), "+v"(d.b4), "+v"(d.kp4), "+v"(d.r4), "+v"(d.vv)); __builtin_amdgcn_sched_barrier(0); } while (0)
#define RW_STEP(d, opart) do { \
    f32x2 p_ = S01 * (f32x2){d.kk4.x, d.kk4.y}; p_ = S23 * (f32x2){d.kk4.z, d.kk4.w} + p_; const float nsa_ = -row16_sum(p_.x + p_.y); \
    f32x2 t0_ = (f32x2){d.b4.x, d.b4.y} * nsa_, t1_ = (f32x2){d.b4.z, d.b4.w} * nsa_; \
    t0_ = S01 * (f32x2){d.w4.x, d.w4.y} + t0_; t1_ = S23 * (f32x2){d.w4.z, d.w4.w} + t1_; \
    S01 = (f32x2){d.kp4.x, d.kp4.y} * d.vv + t0_; S23 = (f32x2){d.kp4.z, d.kp4.w} * d.vv + t1_; \
    f32x2 q_ = S01 * (f32x2){d.r4.x, d.r4.y}; q_ = S23 * (f32x2){d.r4.z, d.r4.w} + q_; opart = q_.x + q_.y; } while (0)
__device__ __forceinline__ float swz_xor4(float x) { return __builtin_bit_cast(float, __builtin_amdgcn_ds_swizzle(__builtin_bit_cast(int, x), 0x101F)); }
__device__ __forceinline__ float swz_xor8(float x) { return __builtin_bit_cast(float, __builtin_amdgcn_ds_swizzle(__builtin_bit_cast(int, x), 0x201F)); }
__device__ __forceinline__ float transpose_reduce16(const float (&op)[16], int kq) {
    const bool b0 = kq & 1, b1 = kq & 2, b2 = kq & 4, b3 = kq & 8; float r1[8], r2[4], r3[2];
#pragma unroll
    for (int i = 0; i < 8; ++i) { const float a = op[2 * i], b = op[2 * i + 1]; r1[i] = (b0 ? b : a) + dppf<0xB1>(b0 ? a : b); }
#pragma unroll
    for (int i = 0; i < 4; ++i) { const float a = r1[2 * i], b = r1[2 * i + 1]; r2[i] = (b1 ? b : a) + dppf<0x4E>(b1 ? a : b); }
#pragma unroll
    for (int i = 0; i < 2; ++i) { const float a = r2[2 * i], b = r2[2 * i + 1]; r3[i] = (b2 ? b : a) + swz_xor4(b2 ? a : b); }
    return (b3 ? r3[1] : r3[0]) + swz_xor8(b3 ? r3[0] : r3[1]);
}
__device__ __forceinline__ void rwkv_prompt_item(LAS unsigned char* lds, const float* RS, float* OA, float* outS, int item, int w, int lane) {
    constexpr int CH = 16, CHB = CH * RREC * 4, NB = 5, NCH = TP / CH, RB = RREC * 4;
    const int bh = item >> 1, half = item & 1, b = bh >> 5, h = bh & 31, rg = lane >> 4, kq = lane & 15, row = half * 32 + w * 4 + rg;
    const char* src = (const char*)(RS + (size_t)bh * TP * RREC);
#define RW_ISSUE(ci) do { const int cs_ = (ci) < NCH ? (ci) : NCH - 1; const int sl_ = (ci) % NB; _Pragma("unroll") for (int i_ = 0; i_ < 3; ++i_) { const int pc_ = w * 3 + i_; \
        __builtin_amdgcn_global_load_lds((const unsigned*)(src + (size_t)cs_ * CHB + pc_ * 1024 + lane * 16), (LAS unsigned*)(lds + sl_ * CHB + pc_ * 1024), 16, 0, 0); } } while (0)
    f32x2 S01 = (f32x2){0.f, 0.f}, S23 = (f32x2){0.f, 0.f};
#pragma unroll
    for (int ci = 0; ci < NB - 1; ++ci) RW_ISSUE(ci);
    asm volatile("s_waitcnt vmcnt(9)" ::: "memory"); __builtin_amdgcn_s_barrier(); asm volatile("" ::: "memory");
    const unsigned lbase = (unsigned)(size_t)lds;
    RwStep A, B; { const unsigned bk = lbase + kq * 16, bv = lbase + 1280 + row * 4; RW_LD(A, bk, bv, 0); }
    for (int ci = 0; ci < NCH; ++ci) {
        asm volatile("s_waitcnt vmcnt(6)" ::: "memory"); __builtin_amdgcn_s_barrier(); asm volatile("" ::: "memory");
        RW_ISSUE(ci + NB - 1);
        const unsigned sl = lbase + (ci % NB) * CHB, nsl = lbase + ((ci + 1) % NB) * CHB;
        const unsigned bk = sl + kq * 16, bv = sl + 1280 + row * 4, nbk = nsl + kq * 16, nbv = nsl + 1280 + row * 4;
        float op[16];
#define RW_PAIR(st) do { RW_LD(B, bk, bv, ((st) + 1) * RB); RW_WAIT(A, 6); RW_STEP(A, op[st]); RW_LD(A, bk, bv, ((st) + 2) * RB); RW_WAIT(B, 6); RW_STEP(B, op[(st) + 1]); } while (0)
        RW_PAIR(0); RW_PAIR(2); RW_PAIR(4); RW_PAIR(6); RW_PAIR(8); RW_PAIR(10); RW_PAIR(12);
        RW_LD(B, bk, bv, 15 * RB); RW_WAIT(A, 6); RW_STEP(A, op[14]); RW_LD(A, nbk, nbv, 0); RW_WAIT(B, 6); RW_STEP(B, op[15]);
#undef RW_PAIR
        OA[(size_t)(b * TP + ci * CH + kq) * RW + h * RH + row] = transpose_reduce16(op, kq);
    }
    *(f32x4*)(outS + ((size_t)bh * RH + row) * RH + 4 * kq) = (f32x4){S01.x, S01.y, S23.x, S23.y};
    asm volatile("s_waitcnt vmcnt(0) lgkmcnt(0)" ::: "memory"); __builtin_amdgcn_s_barrier(); asm volatile("" ::: "memory");
#undef RW_ISSUE
}
__device__ __forceinline__ void rwkv_sample_item(const float* RS, const float* S0, bf16_t* OA, float* outS, int item, int lane) {
    const int bh = item >> 2, q4 = item & 3, b = bh >> 5, h = bh & 31, rg = lane >> 4, kq = lane & 15;
    const float* rec = RS + ((size_t)BP * RHEADS * TP + (size_t)bh * TS) * RREC;
    f32x4 w4[4], kk4[4], b4[4], kp4[4], r4[4];
#pragma unroll
    for (int t = 0; t < 4; ++t) { const float* r = rec + t * RREC + 4 * kq; w4[t] = *(const f32x4*)(r); kk4[t] = *(const f32x4*)(r + 64); b4[t] = *(const f32x4*)(r + 128); kp4[t] = *(const f32x4*)(r + 192); r4[t] = *(const f32x4*)(r + 256); }
    f32x4 S[4]; float vv[4][4];
#pragma unroll
    for (int sub = 0; sub < 4; ++sub) { const int row = q4 * 16 + sub * 4 + rg; S[sub] = *(const f32x4*)(S0 + ((size_t)bh * RH + row) * RH + 4 * kq);
#pragma unroll
        for (int t = 0; t < 4; ++t) vv[sub][t] = rec[t * RREC + 320 + row]; }
#pragma unroll
    for (int sub = 0; sub < 4; ++sub) { const int row = q4 * 16 + sub * 4 + rg; float okeep = 0.f;
#pragma unroll
        for (int t = 0; t < 4; ++t) { float oo; RWKV_STEP(S[sub], w4[t], kk4[t], b4[t], kp4[t], r4[t], vv[sub][t], oo); okeep = (kq == t) ? oo : okeep; }
        if (kq < 4) OA[(size_t)(NPROMPT + b * TS + kq) * RW + h * RH + row] = (bf16_t)cvt2(okeep, 0.f);
        *(f32x4*)(outS + ((size_t)bh * RH + row) * RH + 4 * kq) = S[sub]; }
}
struct GdStep { f32x4 q0, q1, k0, k1, sc; float vv; };
#define GD_LD(d, bk, bv, bs, off) do { \
    asm volatile("ds_read_b128 %0, %1 offset:%2" : "=v"(d.q0) : "v"(bk), "n"((off))); asm volatile("ds_read_b128 %0, %1 offset:%2" : "=v"(d.q1) : "v"(bk), "n"((off) + 16)); \
    asm volatile("ds_read_b128 %0, %1 offset:%2" : "=v"(d.k0) : "v"(bk), "n"((off) + 512)); asm volatile("ds_read_b128 %0, %1 offset:%2" : "=v"(d.k1) : "v"(bk), "n"((off) + 528)); \
    asm volatile("ds_read_b128 %0, %1 offset:%2" : "=v"(d.sc) : "v"(bs), "n"((off) + 1536)); asm volatile("ds_read_b32 %0, %1 offset:%2" : "=v"(d.vv) : "v"(bv), "n"((off))); } while (0)
#define GD_WAIT(d, n) do { asm volatile("s_waitcnt lgkmcnt(" #n ")" : "+v"(d.q0), "+v"(d.q1), "+v"(d.k0), "+v"(d.k1), "+v"(d.sc), "+v"(d.vv)); __builtin_amdgcn_sched_barrier(0); } while (0)
#define GD_STEP(d, opart) do { \
    f32x2 p_ = S0 * (f32x2){d.k0.x, d.k0.y}; p_ = S1 * (f32x2){d.k0.z, d.k0.w} + p_; p_ = S2 * (f32x2){d.k1.x, d.k1.y} + p_; p_ = S3 * (f32x2){d.k1.z, d.k1.w} + p_; \
    f32x2 q_ = S0 * (f32x2){d.q0.x, d.q0.y}; q_ = S1 * (f32x2){d.q0.z, d.q0.w} + q_; q_ = S2 * (f32x2){d.q1.x, d.q1.y} + q_; q_ = S3 * (f32x2){d.q1.z, d.q1.w} + q_; \
    const float ks_ = row16_sum(p_.x + p_.y); const float u_ = d.sc.y * (d.vv - d.sc.x * ks_); opart = d.sc.x * (q_.x + q_.y) + d.sc.w * u_; \
    S0 = S0 * d.sc.x + (f32x2){d.k0.x, d.k0.y} * u_; S1 = S1 * d.sc.x + (f32x2){d.k0.z, d.k0.w} * u_; S2 = S2 * d.sc.x + (f32x2){d.k1.x, d.k1.y} * u_; S3 = S3 * d.sc.x + (f32x2){d.k1.z, d.k1.w} * u_; } while (0)
__device__ __forceinline__ void gdn_prompt_item(LAS unsigned char* lds, const float* GS, float* OB, float* outS, int item, int w, int lane) {
    constexpr int CH = 16, CHB = CH * GREC * 4, NB = 5, NCH = TP / CH, NPIECE = CHB / 1024, GB = GREC * 4;
    const int bh = item >> 2, qd = item & 3, b = bh >> 4, h = bh & 15, cc = lane >> 4, dq = lane & 15, col = qd * 32 + w * 4 + cc;
    const char* src = (const char*)(GS + (size_t)bh * TP * GREC);
#define GD_ISSUE(ci) do { const int cs_ = (ci) < NCH ? (ci) : NCH - 1; const int sl_ = (ci) % NB; _Pragma("unroll") for (int i_ = 0; i_ < 4; ++i_) { int pc_ = w * 4 + i_; pc_ = pc_ < NPIECE ? pc_ : NPIECE - 1; \
        __builtin_amdgcn_global_load_lds((const unsigned*)(src + (size_t)cs_ * CHB + pc_ * 1024 + lane * 16), (LAS unsigned*)(lds + sl_ * CHB + pc_ * 1024), 16, 0, 0); } } while (0)
    f32x2 S0 = (f32x2){0.f, 0.f}, S1 = S0, S2 = S0, S3 = S0;
#pragma unroll
    for (int ci = 0; ci < NB - 1; ++ci) GD_ISSUE(ci);
    asm volatile("s_waitcnt vmcnt(12)" ::: "memory"); __builtin_amdgcn_s_barrier(); asm volatile("" ::: "memory");
    const unsigned lbase = (unsigned)(size_t)lds;
    GdStep A, B; { const unsigned bk = lbase + dq * 32, bv = lbase + 1024 + col * 4; GD_LD(A, bk, bv, lbase, 0); }
    for (int ci = 0; ci < NCH; ++ci) {
        asm volatile("s_waitcnt vmcnt(8)" ::: "memory"); __builtin_amdgcn_s_barrier(); asm volatile("" ::: "memory");
        GD_ISSUE(ci + NB - 1);
        const unsigned sl = lbase + (ci % NB) * CHB, nsl = lbase + ((ci + 1) % NB) * CHB;
        const unsigned bk = sl + dq * 32, bv = sl + 1024 + col * 4, nbk = nsl + dq * 32, nbv = nsl + 1024 + col * 4;
        float op[16];
#define GD_PAIR(st) do { GD_LD(B, bk, bv, sl, ((st) + 1) * GB); GD_WAIT(A, 6); GD_STEP(A, op[st]); GD_LD(A, bk, bv, sl, ((st) + 2) * GB); GD_WAIT(B, 6); GD_STEP(B, op[(st) + 1]); } while (0)
        GD_PAIR(0); GD_PAIR(2); GD_PAIR(4); GD_PAIR(6); GD_PAIR(8); GD_PAIR(10); GD_PAIR(12);
        GD_LD(B, bk, bv, sl, 15 * GB); GD_WAIT(A, 6); GD_STEP(A, op[14]); GD_LD(A, nbk, nbv, nsl, 0); GD_WAIT(B, 6); GD_STEP(B, op[15]);
#undef GD_PAIR
        OB[(size_t)(b * TP + ci * CH + dq) * GW + h * GH + col] = transpose_reduce16(op, dq);
    }
    { const float Sv[8] = {S0.x, S0.y, S1.x, S1.y, S2.x, S2.y, S3.x, S3.y};
#pragma unroll
      for (int j = 0; j < 8; ++j) outS[((size_t)bh * GH + dq * 8 + j) * GH + col] = Sv[j]; }
    asm volatile("s_waitcnt vmcnt(0) lgkmcnt(0)" ::: "memory"); __builtin_amdgcn_s_barrier(); asm volatile("" ::: "memory");
#undef GD_ISSUE
}
struct Rw8 { f32x4 w0, w1, k0, k1, b0, b1, p0, p1, r0, r1; float vv; };
#define RW8_LD(d, bk, bv, off) do { \
    asm volatile("ds_read_b128 %0, %1 offset:%2" : "=v"(d.w0) : "v"(bk), "n"((off))); asm volatile("ds_read_b128 %0, %1 offset:%2" : "=v"(d.w1) : "v"(bk), "n"((off) + 16)); \
    asm volatile("ds_read_b128 %0, %1 offset:%2" : "=v"(d.k0) : "v"(bk), "n"((off) + 256)); asm volatile("ds_read_b128 %0, %1 offset:%2" : "=v"(d.k1) : "v"(bk), "n"((off) + 272)); \
    asm volatile("ds_read_b128 %0, %1 offset:%2" : "=v"(d.b0) : "v"(bk), "n"((off) + 512)); asm volatile("ds_read_b128 %0, %1 offset:%2" : "=v"(d.b1) : "v"(bk), "n"((off) + 528)); \
    asm volatile("ds_read_b128 %0, %1 offset:%2" : "=v"(d.p0) : "v"(bk), "n"((off) + 768)); asm volatile("ds_read_b128 %0, %1 offset:%2" : "=v"(d.p1) : "v"(bk), "n"((off) + 784)); \
    asm volatile("ds_read_b128 %0, %1 offset:%2" : "=v"(d.r0) : "v"(bk), "n"((off) + 1024)); asm volatile("ds_read_b128 %0, %1 offset:%2" : "=v"(d.r1) : "v"(bk), "n"((off) + 1040)); \
    asm volatile("ds_read_b32 %0, %1 offset:%2" : "=v"(d.vv) : "v"(bv), "n"((off))); } while (0)
#define RW8_WAIT(d) do { asm volatile("s_waitcnt lgkmcnt(11)" : "+v"(d.w0), "+v"(d.w1), "+v"(d.k0), "+v"(d.k1), "+v"(d.b0), "+v"(d.b1), "+v"(d.p0), "+v"(d.p1), "+v"(d.r0), "+v"(d.r1), "+v"(d.vv)); __builtin_amdgcn_sched_barrier(0); } while (0)
__device__ __forceinline__ float oct_sum(float x) { x += dppf<0xB1>(x); x += dppf<0x4E>(x); x += dppf<0x141>(x); return x; }
#define LO2(v) ((f32x2){(v).x, (v).y})
#define HI2(v) ((f32x2){(v).z, (v).w})
#define RW8_STEP(d, opart) do { \
    f32x2 p_ = R0 * LO2(d.k0); p_ = R1 * HI2(d.k0) + p_; p_ = R2 * LO2(d.k1) + p_; p_ = R3 * HI2(d.k1) + p_; const float nsa_ = -oct_sum(p_.x + p_.y); \
    f32x2 t0_ = LO2(d.b0) * nsa_, t1_ = HI2(d.b0) * nsa_, t2_ = LO2(d.b1) * nsa_, t3_ = HI2(d.b1) * nsa_; \
    t0_ = R0 * LO2(d.w0) + t0_; t1_ = R1 * HI2(d.w0) + t1_; t2_ = R2 * LO2(d.w1) + t2_; t3_ = R3 * HI2(d.w1) + t3_; \
    R0 = LO2(d.p0) * d.vv + t0_; R1 = HI2(d.p0) * d.vv + t1_; R2 = LO2(d.p1) * d.vv + t2_; R3 = HI2(d.p1) * d.vv + t3_; \
    f32x2 q_ = R0 * LO2(d.r0); q_ = R1 * HI2(d.r0) + q_; q_ = R2 * LO2(d.r1) + q_; q_ = R3 * HI2(d.r1) + q_; opart = q_.x + q_.y; } while (0)
struct Gd8 { f32x4 q0, q1, q2, q3, k0, k1, k2, k3, sc; float vv; };
#define GD8_LD(d, bk, bv, bs, off) do { \
    asm volatile("ds_read_b128 %0, %1 offset:%2" : "=v"(d.q0) : "v"(bk), "n"((off))); asm volatile("ds_read_b128 %0, %1 offset:%2" : "=v"(d.q1) : "v"(bk), "n"((off) + 16)); \
    asm volatile("ds_read_b128 %0, %1 offset:%2" : "=v"(d.q2) : "v"(bk), "n"((off) + 32)); asm volatile("ds_read_b128 %0, %1 offset:%2" : "=v"(d.q3) : "v"(bk), "n"((off) + 48)); \
    asm volatile("ds_read_b128 %0, %1 offset:%2" : "=v"(d.k0) : "v"(bk), "n"((off) + 512)); asm volatile("ds_read_b128 %0, %1 offset:%2" : "=v"(d.k1) : "v"(bk), "n"((off) + 528)); \
    asm volatile("ds_read_b128 %0, %1 offset:%2" : "=v"(d.k2) : "v"(bk), "n"((off) + 544)); asm volatile("ds_read_b128 %0, %1 offset:%2" : "=v"(d.k3) : "v"(bk), "n"((off) + 560)); \
    asm volatile("ds_read_b128 %0, %1 offset:%2" : "=v"(d.sc) : "v"(bs), "n"((off) + 1536)); asm volatile("ds_read_b32 %0, %1 offset:%2" : "=v"(d.vv) : "v"(bv), "n"((off))); } while (0)
#define GD8_WAIT(d) do { asm volatile("s_waitcnt lgkmcnt(10)" : "+v"(d.q0), "+v"(d.q1), "+v"(d.q2), "+v"(d.q3), "+v"(d.k0), "+v"(d.k1), "+v"(d.k2), "+v"(d.k3), "+v"(d.sc), "+v"(d.vv)); __builtin_amdgcn_sched_barrier(0); } while (0)
#define GD8_STEP(d, opart) do { \
    f32x2 p_ = G0 * LO2(d.k0); p_ = G1 * HI2(d.k0) + p_; p_ = G2 * LO2(d.k1) + p_; p_ = G3 * HI2(d.k1) + p_; p_ = G4 * LO2(d.k2) + p_; p_ = G5 * HI2(d.k2) + p_; p_ = G6 * LO2(d.k3) + p_; p_ = G7 * HI2(d.k3) + p_; \
    f32x2 q_ = G0 * LO2(d.q0); q_ = G1 * HI2(d.q0) + q_; q_ = G2 * LO2(d.q1) + q_; q_ = G3 * HI2(d.q1) + q_; q_ = G4 * LO2(d.q2) + q_; q_ = G5 * HI2(d.q2) + q_; q_ = G6 * LO2(d.q3) + q_; q_ = G7 * HI2(d.q3) + q_; \
    const float ks_ = oct_sum(p_.x + p_.y); const float u_ = d.sc.y * (d.vv - d.sc.x * ks_); opart = d.sc.x * (q_.x + q_.y) + d.sc.w * u_; \
    G0 = G0 * d.sc.x + LO2(d.k0) * u_; G1 = G1 * d.sc.x + HI2(d.k0) * u_; G2 = G2 * d.sc.x + LO2(d.k1) * u_; G3 = G3 * d.sc.x + HI2(d.k1) * u_; \
    G4 = G4 * d.sc.x + LO2(d.k2) * u_; G5 = G5 * d.sc.x + HI2(d.k2) * u_; G6 = G6 * d.sc.x + LO2(d.k3) * u_; G7 = G7 * d.sc.x + HI2(d.k3) * u_; } while (0)
__device__ __forceinline__ float transpose_reduce8(const float (&op)[8], int k8) {
    const bool b0 = k8 & 1, b1 = k8 & 2, b2 = k8 & 4; float r1[4], r2[2];
#pragma unroll
    for (int i = 0; i < 4; ++i) { const float a = op[2 * i], b = op[2 * i + 1]; r1[i] = (b0 ? b : a) + dppf<0xB1>(b0 ? a : b); }
#pragma unroll
    for (int i = 0; i < 2; ++i) { const float a = r1[2 * i], b = r1[2 * i + 1]; r2[i] = (b1 ? b : a) + dppf<0x4E>(b1 ? a : b); }
    return (b2 ? r2[1] : r2[0]) + swz_xor4(b2 ? r2[0] : r2[1]);
}
__device__ __forceinline__ void scan_prompt_split(LAS unsigned char* lds, const float* RS, const float* GS, float* OA, float* OB, float* outSR, float* outSG, int item, int w, int lane) {
    constexpr int CH = 8, RCB = CH * RREC * 4  , GCB = CH * GREC * 4  , GSL = 13312, SLB = RCB + GSL  , NB = 5, NCH = TP / CH, RB = RREC * 4, GB = GREC * 4;
    const int rbh = item >> 1, half = item & 1, gbh = item >> 2, qd = item & 3, g8 = lane >> 3, l8 = lane & 7;
    const char* rsrc = (const char*)(RS + (size_t)rbh * TP * RREC); const char* gsrc = (const char*)(GS + (size_t)gbh * TP * GREC);
#define SP_ISSUE(ci) do { const int cs_ = (ci) < NCH ? (ci) : NCH - 1; const int sl_ = (ci) % NB; _Pragma("unroll") for (int i_ = 0; i_ < 4; ++i_) { int pc_ = w * 4 + i_; pc_ = pc_ < 25 ? pc_ : 24; \
        const char* g_ = pc_ < 12 ? rsrc + (size_t)cs_ * RCB + pc_ * 1024 : gsrc + (size_t)cs_ * GCB + (pc_ - 12) * 1024; \
        __builtin_amdgcn_global_load_lds((const unsigned*)(g_ + lane * 16), (LAS unsigned*)(lds + sl_ * SLB + pc_ * 1024), 16, 0, 0); } } while (0)
#define SP_TOP() do { asm volatile("s_waitcnt vmcnt(8)" ::: "memory"); __builtin_amdgcn_s_barrier(); asm volatile("" ::: "memory"); SP_ISSUE(ci + NB - 1); } while (0)
#pragma unroll
    for (int ci = 0; ci < NB - 1; ++ci) SP_ISSUE(ci);
    asm volatile("s_waitcnt vmcnt(12)" ::: "memory"); __builtin_amdgcn_s_barrier(); asm volatile("" ::: "memory");
    const unsigned lbase = (unsigned)(size_t)lds;
    if (w < 4) {
        const int rb = rbh >> 5, rh = rbh & 31, row = half * 32 + w * 8 + g8;
        f32x2 R0 = (f32x2){0.f, 0.f}, R1 = R0, R2 = R0, R3 = R0;
        Rw8 A, B; RW8_LD(A, lbase + l8 * 32, lbase + 1280 + row * 4, 0);
        for (int ci = 0; ci < NCH; ++ci) {
            SP_TOP();
            const unsigned sl = lbase + (ci % NB) * SLB, nsl = lbase + ((ci + 1) % NB) * SLB, bk = sl + l8 * 32, bv = sl + 1280 + row * 4, nbk = nsl + l8 * 32, nbv = nsl + 1280 + row * 4;
            float op[8];
            RW8_LD(B, bk, bv, 1 * RB); RW8_WAIT(A); RW8_STEP(A, op[0]); RW8_LD(A, bk, bv, 2 * RB); RW8_WAIT(B); RW8_STEP(B, op[1]);
            RW8_LD(B, bk, bv, 3 * RB); RW8_WAIT(A); RW8_STEP(A, op[2]); RW8_LD(A, bk, bv, 4 * RB); RW8_WAIT(B); RW8_STEP(B, op[3]);
            RW8_LD(B, bk, bv, 5 * RB); RW8_WAIT(A); RW8_STEP(A, op[4]); RW8_LD(A, bk, bv, 6 * RB); RW8_WAIT(B); RW8_STEP(B, op[5]);
            RW8_LD(B, bk, bv, 7 * RB); RW8_WAIT(A); RW8_STEP(A, op[6]); RW8_LD(A, nbk, nbv, 0); RW8_WAIT(B); RW8_STEP(B, op[7]);
            OA[(size_t)(rb * TP + ci * CH + l8) * RW + rh * RH + row] = transpose_reduce8(op, l8);
        }
        float* so = outSR + ((size_t)rbh * RH + row) * RH + 8 * l8;
        *(f32x4*)so = (f32x4){R0.x, R0.y, R1.x, R1.y}; *(f32x4*)(so + 4) = (f32x4){R2.x, R2.y, R3.x, R3.y};
    } else {
        const int gb = gbh >> 4, gh = gbh & 15, col = qd * 32 + (w - 4) * 8 + g8;
        f32x2 G0 = (f32x2){0.f, 0.f}, G1 = G0, G2 = G0, G3 = G0, G4 = G0, G5 = G0, G6 = G0, G7 = G0;
        Gd8 A, B; { const unsigned gs0 = lbase + RCB; GD8_LD(A, gs0 + l8 * 64, gs0 + 1024 + col * 4, gs0, 0); }
        for (int ci = 0; ci < NCH; ++ci) {
            SP_TOP();
            const unsigned gs = lbase + (ci % NB) * SLB + RCB, ngs = lbase + ((ci + 1) % NB) * SLB + RCB, bk = gs + l8 * 64, bv = gs + 1024 + col * 4, nbk = ngs + l8 * 64, nbv = ngs + 1024 + col * 4;
            float op[8];
            GD8_LD(B, bk, bv, gs, 1 * GB); GD8_WAIT(A); GD8_STEP(A, op[0]); GD8_LD(A, bk, bv, gs, 2 * GB); GD8_WAIT(B); GD8_STEP(B, op[1]);
            GD8_LD(B, bk, bv, gs, 3 * GB); GD8_WAIT(A); GD8_STEP(A, op[2]); GD8_LD(A, bk, bv, gs, 4 * GB); GD8_WAIT(B); GD8_STEP(B, op[3]);
            GD8_LD(B, bk, bv, gs, 5 * GB); GD8_WAIT(A); GD8_STEP(A, op[4]); GD8_LD(A, bk, bv, gs, 6 * GB); GD8_WAIT(B); GD8_STEP(B, op[5]);
            GD8_LD(B, bk, bv, gs, 7 * GB); GD8_WAIT(A); GD8_STEP(A, op[6]); GD8_LD(A, nbk, nbv, ngs, 0); GD8_WAIT(B); GD8_STEP(B, op[7]);
            OB[(size_t)(gb * TP + ci * CH + l8) * GW + gh * GH + col] = transpose_reduce8(op, l8);
        }
        const float Sv[16] = {G0.x, G0.y, G1.x, G1.y, G2.x, G2.y, G3.x, G3.y, G4.x, G4.y, G5.x, G5.y, G6.x, G6.y, G7.x, G7.y};
#pragma unroll
        for (int j = 0; j < 16; ++j) outSG[((size_t)gbh * GH + l8 * 16 + j) * GH + col] = Sv[j];
    }
    asm volatile("s_waitcnt vmcnt(0) lgkmcnt(0)" ::: "memory"); __builtin_amdgcn_s_barrier(); asm volatile("" ::: "memory");
#undef SP_ISSUE
#undef SP_TOP
}
__device__ __forceinline__ void gdn_sample_item(LAS float* scr, const float* GS, const float* S0, bf16_t* OB, float* outS, int item, int lane) {
    const int bh = item >> 2, qd = item & 3, b = bh >> 4, h = bh & 15, hf = lane >> 5, col = qd * 32 + (lane & 31);
    const float* rec = GS + ((size_t)BP * GHEADS * TP + (size_t)bh * TS) * GREC;
#pragma unroll
    for (int i = 0; i < 25; ++i) scr[i * 64 + lane] = rec[i * 64 + lane];
    float S[64];
    const float* s0 = S0 + ((size_t)bh * GH + hf * 64) * GH + col;
#pragma unroll
    for (int j = 0; j < 64; ++j) S[j] = s0[(size_t)j * GH];
    asm volatile("s_waitcnt lgkmcnt(0)" ::: "memory");
#pragma unroll
    for (int t = 0; t < 4; ++t) { const LAS float* r = scr + t * GREC;
        float ks = 0.f, qs = 0.f;
#pragma unroll
        for (int j4 = 0; j4 < 16; ++j4) { const f32x4 q4 = *(const LAS f32x4*)(r + hf * 64 + j4 * 4), k4 = *(const LAS f32x4*)(r + 128 + hf * 64 + j4 * 4);
            ks += S[j4 * 4] * k4.x + S[j4 * 4 + 1] * k4.y + S[j4 * 4 + 2] * k4.z + S[j4 * 4 + 3] * k4.w; qs += S[j4 * 4] * q4.x + S[j4 * 4 + 1] * q4.y + S[j4 * 4 + 2] * q4.z + S[j4 * 4 + 3] * q4.w; }
        ks += __shfl_xor(ks, 32); qs += __shfl_xor(qs, 32);
        const float vv = r[256 + col]; const f32x4 sc = *(const LAS f32x4*)(r + 384);
        const float u = sc.y * (vv - sc.x * ks), oo = sc.x * qs + sc.z * u;
#pragma unroll
        for (int j4 = 0; j4 < 16; ++j4) { const f32x4 k4 = *(const LAS f32x4*)(r + 128 + hf * 64 + j4 * 4);
            S[j4 * 4] = sc.x * S[j4 * 4] + k4.x * u; S[j4 * 4 + 1] = sc.x * S[j4 * 4 + 1] + k4.y * u; S[j4 * 4 + 2] = sc.x * S[j4 * 4 + 2] + k4.z * u; S[j4 * 4 + 3] = sc.x * S[j4 * 4 + 3] + k4.w * u; }
        if (hf == 0) OB[(size_t)(NPROMPT + b * TS + t) * GW + h * GH + col] = (bf16_t)cvt2(oo, 0.f); }
    float* so = outS + ((size_t)bh * GH + hf * 64) * GH + col;
#pragma unroll
    for (int j = 0; j < 64; ++j) so[(size_t)j * GH] = S[j];
    asm volatile("s_waitcnt lgkmcnt(0)" ::: "memory");
}

typedef float f32x16 __attribute__((ext_vector_type(16)));
__device__ __forceinline__ int rowperm(int reg, int h) { return (reg & 3) + 8 * (reg >> 2) + 4 * h; }
typedef __bf16 bf16x2n __attribute__((ext_vector_type(2)));
__device__ __forceinline__ unsigned cvt2(float lo, float hi) { const f32x2 v = (f32x2){lo, hi}; return __builtin_bit_cast(unsigned, __builtin_convertvector(v, bf16x2n)); }
__device__ __forceinline__ bf16x8 pack8(f32x4 a, f32x4 b) { u32x4 w; w.x = cvt2(a.x, a.y); w.y = cvt2(a.z, a.w); w.z = cvt2(b.x, b.y); w.w = cvt2(b.z, b.w); return __builtin_bit_cast(bf16x8, w); }
#define MFMA32(a, b, c) __builtin_amdgcn_mfma_f32_32x32x16_bf16(a, b, c, 0, 0, 0)
constexpr int CK_WK = 0, CK_QG = 8192, CK_KT = 16384, CK_ATT = 24576, CK_FR = 26624, CK_UB = 8192, NCHUNK = BP * GHEADS * (TP / 32);
static_assert((size_t)NCHUNK * (CK_FR + CK_UB) <= (size_t)MTOK * D * 4, "chunk data fits the y region of d_out");
__device__ __forceinline__ void gdn_chunk_prep(LAS unsigned char* wl, const unsigned char* chunk, unsigned char* fr, unsigned char* ub, float* cdp, int lane) {
    const int r = lane & 31, h = lane >> 5;
    LAS bf16_t* kL = (LAS bf16_t*)wl; LAS float* Lm = (LAS float*)(wl + 8192); LAS float* gL = (LAS float*)(wl + 12288);
    const unsigned char* rec = chunk + r * GRB;
    const f32x4 scv = *(const f32x4*)(rec + 768); const float beta_r = scv.y, la_r = scv.w;
    float g = la_r;
#pragma unroll
    for (int d = 1; d < 32; d <<= 1) { const float t = __shfl_up(g, d, 32); if (r >= d) g += t; }
    const float glast = __shfl(g, 31, 32), e_r = __expf(g);
    if (h == 0) { gL[r] = g; gL[32 + r] = beta_r; gL[64 + r] = e_r * beta_r; gL[96 + r] = __expf(glast - g); }
    if (lane == 0) *cdp = __expf(glast);
    f32x16 d1;
#pragma unroll
    for (int i = 0; i < 16; ++i) d1[i] = 0.f;
#pragma unroll
    for (int blk = 0; blk < 8; ++blk) {
        const u32x2 ka = *(const u32x2*)(rec + 256 + 2 * (16 * blk + 4 * h)), kb4 = *(const u32x2*)(rec + 256 + 2 * (16 * blk + 8 + 4 * h));
        const bf16x8 kf = __builtin_bit_cast(bf16x8, (u32x4){ka.x, ka.y, kb4.x, kb4.y});
        *(LAS u32x2*)(kL + r * 128 + 16 * blk + 4 * h) = ka; *(LAS u32x2*)(kL + r * 128 + 16 * blk + 8 + 4 * h) = kb4;
        d1 = MFMA32(kf, kf, d1);
        if (blk & 1) asm volatile("" ::: "memory"); }
#pragma unroll
    for (int reg = 0; reg < 16; ++reg) { const int i = rowperm(reg, h); const float ex = (i > r) ? gL[i] - g : -1e30f; Lm[i * 32 + r] = d1[reg] * gL[32 + i] * __expf(ex); }
    for (int i = 0; i < 32; ++i) { float acc = (i == r) ? 1.f : 0.f;
        const int n4 = (i + 3) >> 2;
#pragma unroll 8
        for (int m4 = 0; m4 < n4; ++m4) { const f32x4 l4 = *(const LAS f32x4*)(Lm + i * 32 + 4 * m4);
            acc -= l4.x * Lm[(4 * m4) * 32 + r] + l4.y * Lm[(4 * m4 + 1) * 32 + r] + l4.z * Lm[(4 * m4 + 2) * 32 + r] + l4.w * Lm[(4 * m4 + 3) * 32 + r]; }
        Lm[i * 32 + r] = acc; }
    bf16x8 tmf[2];
#pragma unroll
    for (int s = 0; s < 2; ++s) tmf[s] = pack8(*(const LAS f32x4*)(Lm + r * 32 + 16 * s + 8 * h), *(const LAS f32x4*)(Lm + r * 32 + 16 * s + 8 * h + 4));
    { bf16x8 vf[4][2];
      const unsigned char* vb = chunk + (size_t)(8 * h) * GRB + 512 + 2 * r; const LAS float* bl = gL + 32 + 8 * h;
#pragma unroll
      for (int s = 0; s < 2; ++s) { float x[4][8];
#pragma unroll
          for (int jj = 0; jj < 8; ++jj) { const unsigned char* vp = vb + (16 * s + jj) * GRB; const float bt = bl[16 * s + jj];
#pragma unroll
              for (int sl = 0; sl < 4; ++sl) x[sl][jj] = bf2f(*(const unsigned short*)(vp + 64 * sl)) * bt; }
#pragma unroll
          for (int sl = 0; sl < 4; ++sl) vf[sl][s] = pack8((f32x4){x[sl][0], x[sl][1], x[sl][2], x[sl][3]}, (f32x4){x[sl][4], x[sl][5], x[sl][6], x[sl][7]});
          asm volatile("" ::: "memory"); }
#pragma unroll
      for (int sl = 0; sl < 4; ++sl) { f32x16 u;
#pragma unroll
          for (int i = 0; i < 16; ++i) u[i] = 0.f;
          u = MFMA32(tmf[0], vf[sl][0], u); u = MFMA32(tmf[1], vf[sl][1], u);
          ((bf16x8*)ub)[(sl * 64 + lane) * 2] = pack8((f32x4){u[0], u[1], u[2], u[3]}, (f32x4){u[4], u[5], u[6], u[7]});
          ((bf16x8*)ub)[(sl * 64 + lane) * 2 + 1] = pack8((f32x4){u[8], u[9], u[10], u[11]}, (f32x4){u[12], u[13], u[14], u[15]}); }
      asm volatile("" ::: "memory"); }
    f32x16 d2;
#pragma unroll
    for (int i = 0; i < 16; ++i) d2[i] = 0.f;
#pragma unroll
    for (int blk = 0; blk < 8; ++blk) {
        const u32x2 qaw = *(const u32x2*)(rec + 2 * (16 * blk + 4 * h)), qbw = *(const u32x2*)(rec + 2 * (16 * blk + 8 + 4 * h));
        const u32x2 k0 = *(const LAS u32x2*)(kL + r * 128 + 16 * blk + 4 * h), k1 = *(const LAS u32x2*)(kL + r * 128 + 16 * blk + 8 + 4 * h);
        d2 = MFMA32(__builtin_bit_cast(bf16x8, (u32x4){k0.x, k0.y, k1.x, k1.y}), __builtin_bit_cast(bf16x8, (u32x4){qaw.x, qaw.y, qbw.x, qbw.y}), d2);
        const f32x4 qa = (f32x4){bflo(qaw.x), bfhi(qaw.x), bflo(qaw.y), bfhi(qaw.y)}, qb = (f32x4){bflo(qbw.x), bfhi(qbw.x), bflo(qbw.y), bfhi(qbw.y)};
        ((bf16x8*)(fr + CK_QG))[blk * 64 + lane] = pack8(qa * e_r, qb * e_r);
        if (blk & 1) asm volatile("" ::: "memory"); }
#pragma unroll
    for (int s = 0; s < 2; ++s) { float x[8];
#pragma unroll
        for (int jj = 0; jj < 8; ++jj) { const int j = rowperm(8 * s + jj, h); const float ex = (r >= j) ? g - gL[j] : -1e30f; x[jj] = d2[8 * s + jj] * __expf(ex); }
        ((bf16x8*)(fr + CK_ATT))[s * 64 + lane] = pack8((f32x4){x[0], x[1], x[2], x[3]}, (f32x4){x[4], x[5], x[6], x[7]}); }
    asm volatile("" ::: "memory");
#pragma unroll
    for (int kb = 0; kb < 4; ++kb) { f32x16 wv;
#pragma unroll
        for (int i = 0; i < 16; ++i) wv[i] = 0.f;
#pragma unroll
        for (int s = 0; s < 2; ++s) { float x[8];
#pragma unroll
            for (int jj = 0; jj < 8; ++jj) { const int tok = 16 * s + 8 * h + jj; x[jj] = bf2f(kL[tok * 128 + 32 * kb + r]) * gL[64 + tok]; }
            wv = MFMA32(pack8((f32x4){x[0], x[1], x[2], x[3]}, (f32x4){x[4], x[5], x[6], x[7]}), tmf[s], wv); }
#pragma unroll
        for (int s = 0; s < 2; ++s) { ((bf16x8*)(fr + CK_WK))[(kb * 2 + s) * 64 + lane] = pack8((f32x4){-wv[8 * s], -wv[8 * s + 1], -wv[8 * s + 2], -wv[8 * s + 3]}, (f32x4){-wv[8 * s + 4], -wv[8 * s + 5], -wv[8 * s + 6], -wv[8 * s + 7]});
            float x[8];
#pragma unroll
            for (int jj = 0; jj < 8; ++jj) { const int tok = rowperm(8 * s + jj, h); x[jj] = bf2f(kL[tok * 128 + 32 * kb + r]) * gL[96 + tok]; }
            ((bf16x8*)(fr + CK_KT))[(kb * 2 + s) * 64 + lane] = pack8((f32x4){x[0], x[1], x[2], x[3]}, (f32x4){x[4], x[5], x[6], x[7]}); }
        asm volatile("" ::: "memory"); }
    asm volatile("s_waitcnt lgkmcnt(0)" ::: "memory");
}
__device__ __forceinline__ void gdn_mfma_wave(const unsigned char* FR, const unsigned char* UB, const float* CD, bf16_t* OB, float* outS, int witem, int lane) {
    const int bh = witem >> 2, sl = witem & 3, b = bh >> 4, hh = bh & 15, r = lane & 31, h = lane >> 5;
    f32x16 S[4];
#pragma unroll
    for (int kb = 0; kb < 4; ++kb)
#pragma unroll
        for (int i = 0; i < 16; ++i) S[kb][i] = 0.f;
    for (int cc = 0; cc < TP / 32; ++cc) {
        const int ch = bh * (TP / 32) + cc;
        const unsigned char* ck = FR + (size_t)ch * CK_FR;
        const float cd = CD[ch];
        f32x16 vn, o;
        { const u32x4 u0 = __builtin_nontemporal_load((const u32x4*)(UB + (size_t)ch * CK_UB) + (sl * 64 + lane) * 2), u1 = __builtin_nontemporal_load((const u32x4*)(UB + (size_t)ch * CK_UB) + (sl * 64 + lane) * 2 + 1);
          vn[0] = bflo(u0.x); vn[1] = bfhi(u0.x); vn[2] = bflo(u0.y); vn[3] = bfhi(u0.y); vn[4] = bflo(u0.z); vn[5] = bfhi(u0.z); vn[6] = bflo(u0.w); vn[7] = bfhi(u0.w);
          vn[8] = bflo(u1.x); vn[9] = bfhi(u1.x); vn[10] = bflo(u1.y); vn[11] = bfhi(u1.y); vn[12] = bflo(u1.z); vn[13] = bfhi(u1.z); vn[14] = bflo(u1.w); vn[15] = bfhi(u1.w); }
#pragma unroll
        for (int reg = 0; reg < 16; ++reg) o[reg] = 0.f;
#pragma unroll
        for (int kb = 0; kb < 4; ++kb)
#pragma unroll
            for (int s = 0; s < 2; ++s) { const bf16x8 sf = pack8((f32x4){S[kb][8 * s], S[kb][8 * s + 1], S[kb][8 * s + 2], S[kb][8 * s + 3]}, (f32x4){S[kb][8 * s + 4], S[kb][8 * s + 5], S[kb][8 * s + 6], S[kb][8 * s + 7]});
                vn = MFMA32(((const bf16x8*)(ck + CK_WK))[(kb * 2 + s) * 64 + lane], sf, vn); o = MFMA32(((const bf16x8*)(ck + CK_QG))[(kb * 2 + s) * 64 + lane], sf, o); }
        bf16x8 vf[2];
#pragma unroll
        for (int s = 0; s < 2; ++s) { vf[s] = pack8((f32x4){vn[8 * s], vn[8 * s + 1], vn[8 * s + 2], vn[8 * s + 3]}, (f32x4){vn[8 * s + 4], vn[8 * s + 5], vn[8 * s + 6], vn[8 * s + 7]});
            o = MFMA32(((const bf16x8*)(ck + CK_ATT))[s * 64 + lane], vf[s], o); }
#pragma unroll
        for (int kb = 0; kb < 4; ++kb) { S[kb] = S[kb] * cd;
#pragma unroll
            for (int s = 0; s < 2; ++s) S[kb] = MFMA32(((const bf16x8*)(ck + CK_KT))[(kb * 2 + s) * 64 + lane], vf[s], S[kb]); }
#pragma unroll
        for (int reg = 0; reg < 16; ++reg) OB[(size_t)(b * TP + cc * 32 + rowperm(reg, h)) * GW + hh * GH + sl * 32 + r] = (bf16_t)cvt2(o[reg], 0.f);
    }
#pragma unroll
    for (int kb = 0; kb < 4; ++kb)
#pragma unroll
        for (int reg = 0; reg < 16; ++reg) outS[((size_t)bh * GH + 32 * kb + rowperm(reg, h)) * GH + sl * 32 + r] = S[kb][reg];
}
constexpr int RK_WC = 0, RK_RG = 4096, RK_ARB = 8192, RK_BT = 10240, RK_ARK = 14336, RK_KPT = 16384, RK_UC = 20480, RK_BYTES = 24576, NRCHUNK = BP * RHEADS * (TP / 32);
static_assert(68 * MiB + (size_t)NRCHUNK * RK_BYTES <= (size_t)BP * RHEADS * TP * RREC * 4 && (size_t)BP * RHEADS * TP * RH * 4 <= 68 * MiB, "VCH and the RWKV chunk data fit the prompt part of the RSCAN region");
__device__ __forceinline__ bf16x8 words8(unsigned a, unsigned b, unsigned c, unsigned d) { return __builtin_bit_cast(bf16x8, (u32x4){a, b, c, d}); }
struct RwPrepIn { const bf16_t* P; const bf16_t* LWAG; const float* mu; const float* kkw; const float* kaw; const float* rkw; float* BON; unsigned char* VF; const LAS float* kc; };
__device__ __forceinline__ f32x4 mix4(u32x2 c, u32x2 p, f32x4 m) { const f32x4 cv = (f32x4){bflo(c.x), bfhi(c.x), bflo(c.y), bfhi(c.y)}, pv = (f32x4){bflo(p.x), bfhi(p.x), bflo(p.y), bfhi(p.y)}; return cv + (pv - cv) * m; }
__device__ __forceinline__ void rwkv_chunk_prep(LAS unsigned char* wl, const RwPrepIn& I, int bh, int cc, unsigned char* rk, float* gc, int lane) {
    int r = lane & 31, h = lane >> 5;
    asm volatile("" : "+v"(r), "+v"(h));
    LAS bf16_t* KKgL = (LAS bf16_t*)wl; LAS bf16_t* BTL = (LAS bf16_t*)(wl + 4096); LAS bf16_t* KpTL = (LAS bf16_t*)(wl + 8192); LAS float* Lm = (LAS float*)(wl + 12288);
    const int b = bh >> 5, hh = bh & 31, t = cc * 32 + r, m = b * TP + t, cb = hh * RH; const bool hp = t > 0;
    const bf16_t* cur = I.P + (size_t)m * LDP + cb; const bf16_t* lw = I.LWAG + (size_t)m * LORA_N + cb; const bf16_t* prv = hp ? cur - LDP : cur; const unsigned pm_ = hp ? 0xffffffffu : 0u;
    float ss = 0.f;
#pragma unroll
    for (int blk = 0; blk < 4; ++blk) {
#pragma unroll
        for (int q = 0; q < 2; ++q) { const int c = 16 * blk + 4 * h + 8 * q;
            const u32x2 kc = *(const u32x2*)(cur + RW + c), kp = *(const u32x2*)(prv + RW + c) & pm_;
            const f32x4 kr = mix4(kc, kp, *(const LAS f32x4*)(I.kc + 64 + c)) * *(const LAS f32x4*)(I.kc + 128 + c); ss += kr.x * kr.x + kr.y * kr.y + kr.z * kr.z + kr.w * kr.w; } }
    asm volatile("" ::: "memory");
    ss += __shfl_xor(ss, 32);
    const float rinv = __builtin_amdgcn_rsqf(ss + 1e-6f); float bon = 0.f;
    f32x16 g1, g2, g3, g4;
#pragma unroll
    for (int i = 0; i < 16; ++i) { g1[i] = 0.f; g2[i] = 0.f; g3[i] = 0.f; g4[i] = 0.f; }
    u32x2 nw0, nw1, na0, na1, nrc0, nrp0, nrc1, nrp1, nkc0, nkp0, nkc1, nkp1;
#define RWP_LOAD(bq) do { const int c0_ = 16 * (bq) + 4 * h, c1_ = c0_ + 8; \
        nw0 = *(const u32x2*)(lw + c0_); nw1 = *(const u32x2*)(lw + c1_); na0 = *(const u32x2*)(lw + RW + c0_); na1 = *(const u32x2*)(lw + RW + c1_); \
        nrc0 = *(const u32x2*)(cur + c0_); nrp0 = *(const u32x2*)(prv + c0_) & pm_; nrc1 = *(const u32x2*)(cur + c1_); nrp1 = *(const u32x2*)(prv + c1_) & pm_; \
        nkc0 = *(const u32x2*)(cur + RW + c0_); nkp0 = *(const u32x2*)(prv + RW + c0_) & pm_; nkc1 = *(const u32x2*)(cur + RW + c1_); nkp1 = *(const u32x2*)(prv + RW + c1_) & pm_; } while (0)
    RWP_LOAD(0);
#pragma unroll 1
    for (int blk = 0; blk < 4; ++blk) {
        const int c0 = 16 * blk + 4 * h, c1 = c0 + 8;
        const u32x2 qw0 = nw0, qw1 = nw1, qa0 = na0, qa1 = na1, qrc0 = nrc0, qrp0 = nrp0, qrc1 = nrc1, qrp1 = nrp1, qkc0 = nkc0, qkp0 = nkp0, qkc1 = nkc1, qkp1 = nkp1;
        { const int bn = blk < 3 ? blk + 1 : 3; RWP_LOAD(bn); }
        const f32x4 w0 = cvt4(qw0), w1 = cvt4(qw1);
        const float wv8[8] = {w0.x, w0.y, w0.z, w0.w, w1.x, w1.y, w1.z, w1.w};
        float ep[8], en[8], eg[8], el[8], eG[8];
#pragma unroll
        for (int e = 0; e < 8; ++e) { float x = wv8[e];
            x += dppf<0x111>(x); x += dppf<0x112>(x); x += dppf<0x114>(x); x += dppf<0x118>(x);
            x += __builtin_bit_cast(float, __builtin_amdgcn_update_dpp(0, __builtin_bit_cast(int, x), 0x142, 0xa, 0xf, false));
            eg[e] = __expf(x); en[e] = __builtin_amdgcn_rcpf(eg[e]); ep[e] = eg[e] * __expf(-wv8[e]);
            eG[e] = __shfl(eg[e], 31, 32); el[e] = eG[e] * en[e]; }
        const f32x4 a0 = cvt4(qa0), a1 = cvt4(qa1);
        const f32x4 r0 = mix4(qrc0, qrp0, *(const LAS f32x4*)(I.kc + c0));
        const f32x4 r1 = mix4(qrc1, qrp1, *(const LAS f32x4*)(I.kc + c1));
        const f32x4 kx0 = mix4(qkc0, qkp0, *(const LAS f32x4*)(I.kc + 64 + c0));
        const f32x4 kx1 = mix4(qkc1, qkp1, *(const LAS f32x4*)(I.kc + 64 + c1));
        const f32x4 k0 = kx0 * *(const LAS f32x4*)(I.kc + 128 + c0) * rinv, k1 = kx1 * *(const LAS f32x4*)(I.kc + 128 + c1) * rinv;
        const f32x4 p0 = kx0 * ((a0 - 1.0f) * *(const LAS f32x4*)(I.kc + 192 + c0) + 1.0f), p1 = kx1 * ((a1 - 1.0f) * *(const LAS f32x4*)(I.kc + 192 + c1) + 1.0f);
        const f32x4 b0 = k0 * a0, b1 = k1 * a1;
        { const f32x4 q0 = r0 * p0 * *(const LAS f32x4*)(I.kc + 256 + c0), q1 = r1 * p1 * *(const LAS f32x4*)(I.kc + 256 + c1); bon += (q0.x + q0.y + q0.z + q0.w) + (q1.x + q1.y + q1.z + q1.w); }
        const bf16x8 kkg_ = pack8((f32x4){k0.x * ep[0], k0.y * ep[1], k0.z * ep[2], k0.w * ep[3]}, (f32x4){k1.x * ep[4], k1.y * ep[5], k1.z * ep[6], k1.w * ep[7]});
        const bf16x8 bi_ = pack8((f32x4){b0.x * en[0], b0.y * en[1], b0.z * en[2], b0.w * en[3]}, (f32x4){b1.x * en[4], b1.y * en[5], b1.z * en[6], b1.w * en[7]});
        const bf16x8 kpi_ = pack8((f32x4){p0.x * en[0], p0.y * en[1], p0.z * en[2], p0.w * en[3]}, (f32x4){p1.x * en[4], p1.y * en[5], p1.z * en[6], p1.w * en[7]});
        const bf16x8 rg_ = pack8((f32x4){r0.x * eg[0], r0.y * eg[1], r0.z * eg[2], r0.w * eg[3]}, (f32x4){r1.x * eg[4], r1.y * eg[5], r1.z * eg[6], r1.w * eg[7]});
        const bf16x8 btf = pack8((f32x4){-b0.x * el[0], -b0.y * el[1], -b0.z * el[2], -b0.w * el[3]}, (f32x4){-b1.x * el[4], -b1.y * el[5], -b1.z * el[6], -b1.w * el[7]});
        const bf16x8 ktf = pack8((f32x4){p0.x * el[0], p0.y * el[1], p0.z * el[2], p0.w * el[3]}, (f32x4){p1.x * el[4], p1.y * el[5], p1.z * el[6], p1.w * el[7]});
        const u32x4 kw = __builtin_bit_cast(u32x4, kkg_), bw = __builtin_bit_cast(u32x4, btf), pw = __builtin_bit_cast(u32x4, ktf);
        *(LAS u32x2*)(KKgL + r * 64 + c0) = (u32x2){kw.x, kw.y}; *(LAS u32x2*)(KKgL + r * 64 + c1) = (u32x2){kw.z, kw.w};
        *(LAS u32x2*)(BTL + r * 64 + c0) = (u32x2){bw.x, bw.y}; *(LAS u32x2*)(BTL + r * 64 + c1) = (u32x2){bw.z, bw.w};
        *(LAS u32x2*)(KpTL + r * 64 + c0) = (u32x2){pw.x, pw.y}; *(LAS u32x2*)(KpTL + r * 64 + c1) = (u32x2){pw.z, pw.w};
        ((bf16x8*)(rk + RK_RG))[blk * 64 + lane] = rg_;
        g1 = MFMA32(kkg_, bi_, g1); g2 = MFMA32(kpi_, kkg_, g2); g3 = MFMA32(bi_, rg_, g3); g4 = MFMA32(kpi_, rg_, g4);
        if (r == 31) { *(f32x4*)(gc + c0) = (f32x4){eG[0], eG[1], eG[2], eG[3]}; *(f32x4*)(gc + c1) = (f32x4){eG[4], eG[5], eG[6], eG[7]}; }
        asm volatile("" ::: "memory"); }
    bon += __shfl_xor(bon, 32);
    if (h == 0) I.BON[(size_t)m * RHEADS + hh] = bon;
#pragma unroll
    for (int reg = 0; reg < 16; ++reg) { const int t = rowperm(reg, h); Lm[t * 32 + r] = (t > r) ? g1[reg] : 0.f; }
    bf16x8 akkT[2];
#pragma unroll
    for (int s = 0; s < 2; ++s) { float x[8], y[8], z[8];
#pragma unroll
        for (int jj = 0; jj < 8; ++jj) { const int i = rowperm(8 * s + jj, h); x[jj] = (i < r) ? g2[8 * s + jj] : 0.f; y[jj] = (i <= r) ? -g3[8 * s + jj] : 0.f; z[jj] = (i <= r) ? g4[8 * s + jj] : 0.f; }
        akkT[s] = pack8((f32x4){x[0], x[1], x[2], x[3]}, (f32x4){x[4], x[5], x[6], x[7]});
        ((bf16x8*)(rk + RK_ARB))[s * 64 + lane] = pack8((f32x4){y[0], y[1], y[2], y[3]}, (f32x4){y[4], y[5], y[6], y[7]});
        ((bf16x8*)(rk + RK_ARK))[s * 64 + lane] = pack8((f32x4){z[0], z[1], z[2], z[3]}, (f32x4){z[4], z[5], z[6], z[7]}); }
    for (int i = 0; i < 32; ++i) { float acc = (i == r) ? 1.f : 0.f;
        const int n4 = (i + 3) >> 2;
#pragma unroll 8
        for (int m4 = 0; m4 < n4; ++m4) { const f32x4 l4 = *(const LAS f32x4*)(Lm + i * 32 + 4 * m4);
            acc -= l4.x * Lm[(4 * m4) * 32 + r] + l4.y * Lm[(4 * m4 + 1) * 32 + r] + l4.z * Lm[(4 * m4 + 2) * 32 + r] + l4.w * Lm[(4 * m4 + 3) * 32 + r]; }
        Lm[i * 32 + r] = acc; }
    bf16x8 tn[2], tp[2];
#pragma unroll
    for (int s = 0; s < 2; ++s) { tn[s] = pack8(*(const LAS f32x4*)(Lm + r * 32 + 16 * s + 8 * h), *(const LAS f32x4*)(Lm + r * 32 + 16 * s + 8 * h + 4));
        tp[s] = pack8(*(const LAS f32x4*)(Lm + r * 32 + 16 * s + 4 * h), *(const LAS f32x4*)(Lm + r * 32 + 16 * s + 8 + 4 * h)); }
#pragma unroll
    for (int kb = 0; kb < 2; ++kb) { f32x16 wv;
#pragma unroll
        for (int i = 0; i < 16; ++i) wv[i] = 0.f;
#pragma unroll
        for (int s = 0; s < 2; ++s) { unsigned wds[4];
#pragma unroll
            for (int j2 = 0; j2 < 4; ++j2) { const int t0 = 16 * s + 8 * h + 2 * j2; wds[j2] = (unsigned)KKgL[t0 * 64 + 32 * kb + r] | ((unsigned)KKgL[(t0 + 1) * 64 + 32 * kb + r] << 16); }
            wv = MFMA32(words8(wds[0], wds[1], wds[2], wds[3]), tn[s], wv); }
#pragma unroll
        for (int s = 0; s < 2; ++s) { ((bf16x8*)(rk + RK_WC))[(kb * 2 + s) * 64 + lane] = pack8((f32x4){wv[8 * s], wv[8 * s + 1], wv[8 * s + 2], wv[8 * s + 3]}, (f32x4){wv[8 * s + 4], wv[8 * s + 5], wv[8 * s + 6], wv[8 * s + 7]});
            unsigned bwd[4], pwd[4];
#pragma unroll
            for (int j2 = 0; j2 < 4; ++j2) { const int ta = rowperm(8 * s + 2 * j2, h), tb = rowperm(8 * s + 2 * j2 + 1, h);
                bwd[j2] = (unsigned)BTL[ta * 64 + 32 * kb + r] | ((unsigned)BTL[tb * 64 + 32 * kb + r] << 16); pwd[j2] = (unsigned)KpTL[ta * 64 + 32 * kb + r] | ((unsigned)KpTL[tb * 64 + 32 * kb + r] << 16); }
            ((bf16x8*)(rk + RK_BT))[(kb * 2 + s) * 64 + lane] = words8(bwd[0], bwd[1], bwd[2], bwd[3]);
            ((bf16x8*)(rk + RK_KPT))[(kb * 2 + s) * 64 + lane] = words8(pwd[0], pwd[1], pwd[2], pwd[3]); }
        asm volatile("" ::: "memory"); }
    { const bf16_t* vcol = I.P + (size_t)(b * TP + cc * 32 + 4 * h) * LDP + 2 * RW + cb + r; unsigned char* vfp = I.VF + ((size_t)bh * (TP / 32) + cc) * 4096;
#pragma unroll
      for (int sl = 0; sl < 2; ++sl) { f32x16 av; const float muv = I.mu[2 * RW + cb + 32 * sl + r];
#pragma unroll
          for (int i = 0; i < 16; ++i) av[i] = 0.f;
#pragma unroll
          for (int s = 0; s < 2; ++s) { float x[8];
#pragma unroll
              for (int g4 = 0; g4 < 2; ++g4) { const int tk = 8 * g4 + 16 * s;
                  float pv = (cc > 0 || 4 * h + tk > 0) ? bf2f(vcol[(ptrdiff_t)(tk - 1) * LDP + 32 * sl]) : 0.f;
#pragma unroll
                  for (int j = 0; j < 4; ++j) { const float cv = bf2f(vcol[(size_t)(tk + j) * LDP + 32 * sl]); x[4 * g4 + j] = cv + (pv - cv) * muv; pv = cv; } }
              const bf16x8 vf_ = pack8((f32x4){x[0], x[1], x[2], x[3]}, (f32x4){x[4], x[5], x[6], x[7]});
              ((bf16x8*)vfp)[(sl * 2 + s) * 64 + lane] = vf_;
              av = MFMA32(akkT[s], vf_, av); }
          f32x16 uc;
#pragma unroll
          for (int i = 0; i < 16; ++i) uc[i] = 0.f;
#pragma unroll
          for (int s = 0; s < 2; ++s) uc = MFMA32(tp[s], pack8((f32x4){av[8 * s], av[8 * s + 1], av[8 * s + 2], av[8 * s + 3]}, (f32x4){av[8 * s + 4], av[8 * s + 5], av[8 * s + 6], av[8 * s + 7]}), uc);
          ((bf16x8*)(rk + RK_UC))[(sl * 64 + lane) * 2] = pack8((f32x4){uc[0], uc[1], uc[2], uc[3]}, (f32x4){uc[4], uc[5], uc[6], uc[7]});
          ((bf16x8*)(rk + RK_UC))[(sl * 64 + lane) * 2 + 1] = pack8((f32x4){uc[8], uc[9], uc[10], uc[11]}, (f32x4){uc[12], uc[13], uc[14], uc[15]});
          asm volatile("" ::: "memory"); } }
    asm volatile("s_waitcnt lgkmcnt(0)" ::: "memory");
}
__device__ __forceinline__ void rwkv_mfma_wave(const unsigned char* RKD, const float* GC, const unsigned char* VF, bf16_t* OA, float* outSR, int witem, int lane) {
    const int bh = witem >> 1, vs = witem & 1, b = bh >> 5, hh = bh & 31, r = lane & 31, h = lane >> 5;
    f32x16 Z[2];
#pragma unroll
    for (int kb = 0; kb < 2; ++kb)
#pragma unroll
        for (int i = 0; i < 16; ++i) Z[kb][i] = 0.f;
    for (int cc = 0; cc < TP / 32; ++cc) {
        const int ch = bh * (TP / 32) + cc;
        const unsigned char* rk = RKD + (size_t)ch * RK_BYTES;
        const float* gcp = GC + (size_t)ch * 64 + 4 * h;
        f32x16 c, o;
        { const u32x4 u0 = __builtin_nontemporal_load((const u32x4*)(rk + RK_UC) + (vs * 64 + lane) * 2), u1 = __builtin_nontemporal_load((const u32x4*)(rk + RK_UC) + (vs * 64 + lane) * 2 + 1);
          c[0] = bflo(u0.x); c[1] = bfhi(u0.x); c[2] = bflo(u0.y); c[3] = bfhi(u0.y); c[4] = bflo(u0.z); c[5] = bfhi(u0.z); c[6] = bflo(u0.w); c[7] = bfhi(u0.w);
          c[8] = bflo(u1.x); c[9] = bfhi(u1.x); c[10] = bflo(u1.y); c[11] = bfhi(u1.y); c[12] = bflo(u1.z); c[13] = bfhi(u1.z); c[14] = bflo(u1.w); c[15] = bfhi(u1.w); }
#pragma unroll
        for (int i = 0; i < 16; ++i) o[i] = 0.f;
        bf16x8 vf[2];
#pragma unroll
        for (int s = 0; s < 2; ++s) vf[s] = __builtin_nontemporal_load((const bf16x8*)(VF + (size_t)ch * 4096) + (vs * 2 + s) * 64 + lane);
#pragma unroll
        for (int kb = 0; kb < 2; ++kb)
#pragma unroll
            for (int s = 0; s < 2; ++s) { const bf16x8 zf = pack8((f32x4){Z[kb][8 * s], Z[kb][8 * s + 1], Z[kb][8 * s + 2], Z[kb][8 * s + 3]}, (f32x4){Z[kb][8 * s + 4], Z[kb][8 * s + 5], Z[kb][8 * s + 6], Z[kb][8 * s + 7]});
                c = MFMA32(((const bf16x8*)(rk + RK_WC))[(kb * 2 + s) * 64 + lane], zf, c); o = MFMA32(((const bf16x8*)(rk + RK_RG))[(kb * 2 + s) * 64 + lane], zf, o); }
        bf16x8 cf[2];
#pragma unroll
        for (int s = 0; s < 2; ++s) { cf[s] = pack8((f32x4){c[8 * s], c[8 * s + 1], c[8 * s + 2], c[8 * s + 3]}, (f32x4){c[8 * s + 4], c[8 * s + 5], c[8 * s + 6], c[8 * s + 7]});
            o = MFMA32(((const bf16x8*)(rk + RK_ARK))[s * 64 + lane], vf[s], o); o = MFMA32(((const bf16x8*)(rk + RK_ARB))[s * 64 + lane], cf[s], o); }
#pragma unroll
        for (int kb = 0; kb < 2; ++kb) {
#pragma unroll
            for (int reg = 0; reg < 16; ++reg) Z[kb][reg] *= gcp[32 * kb + (reg & 3) + 8 * (reg >> 2)];
#pragma unroll
            for (int s = 0; s < 2; ++s) { Z[kb] = MFMA32(((const bf16x8*)(rk + RK_KPT))[(kb * 2 + s) * 64 + lane], vf[s], Z[kb]); Z[kb] = MFMA32(((const bf16x8*)(rk + RK_BT))[(kb * 2 + s) * 64 + lane], cf[s], Z[kb]); } }
#pragma unroll
        for (int reg = 0; reg < 16; ++reg) OA[(size_t)(b * TP + cc * 32 + rowperm(reg, h)) * RW + hh * RH + vs * 32 + r] = (bf16_t)cvt2(o[reg], 0.f);
    }
#pragma unroll
    for (int kb = 0; kb < 2; ++kb)
#pragma unroll
        for (int reg = 0; reg < 16; ++reg) outSR[((size_t)bh * RH + vs * 32 + r) * RH + 32 * kb + rowperm(reg, h)] = Z[kb][reg];
}

__device__ __forceinline__ void spin_ge4(volatile LAS unsigned* p, unsigned need) {
    for (unsigned sp = 0;; ++sp) { const unsigned a = p[0], b = p[1], c = p[2], d = p[3]; if ((a >= need && b >= need && c >= need && d >= need) || sp > (1u << 24)) break; __builtin_amdgcn_s_sleep(1); }
}
struct Rw2 { f32x4 w4, kk4, b4, kp4, r4; float va, vb; };
#define RW2_LD(d, bk, bv, off) do { \
    asm volatile("ds_read_b128 %0, %1 offset:%2" : "=v"(d.w4) : "v"(bk), "n"((off))); asm volatile("ds_read_b128 %0, %1 offset:%2" : "=v"(d.kk4) : "v"(bk), "n"((off) + 256)); \
    asm volatile("ds_read_b128 %0, %1 offset:%2" : "=v"(d.b4) : "v"(bk), "n"((off) + 512)); asm volatile("ds_read_b128 %0, %1 offset:%2" : "=v"(d.kp4) : "v"(bk), "n"((off) + 768)); \
    asm volatile("ds_read_b128 %0, %1 offset:%2" : "=v"(d.r4) : "v"(bk), "n"((off) + 1024)); \
    asm volatile("ds_read_b32 %0, %1 offset:%2" : "=v"(d.va) : "v"(bv), "n"((off))); asm volatile("ds_read_b32 %0, %1 offset:%2" : "=v"(d.vb) : "v"(bv), "n"((off) + 16)); } while (0)
#define RW2_WAIT(d) do { asm volatile("s_waitcnt lgkmcnt(7)" : "+v"(d.w4), "+v"(d.kk4), "+v"(d.b4), "+v"(d.kp4), "+v"(d.r4), "+v"(d.va), "+v"(d.vb)); __builtin_amdgcn_sched_barrier(0); } while (0)
#define RW2_STEP(d, opa, opb) do { \
    f32x2 pa_ = A01 * LO2(d.kk4); pa_ = A23 * HI2(d.kk4) + pa_; f32x2 pb_ = B01 * LO2(d.kk4); pb_ = B23 * HI2(d.kk4) + pb_; \
    f32x2 ea0_ = LO2(d.kp4) * d.va, ea1_ = HI2(d.kp4) * d.va, eb0_ = LO2(d.kp4) * d.vb, eb1_ = HI2(d.kp4) * d.vb; \
    ea0_ = A01 * LO2(d.w4) + ea0_; ea1_ = A23 * HI2(d.w4) + ea1_; eb0_ = B01 * LO2(d.w4) + eb0_; eb1_ = B23 * HI2(d.w4) + eb1_; \
    const float nsa_ = -row16_sum(pa_.x + pa_.y), nsb_ = -row16_sum(pb_.x + pb_.y); \
    A01 = LO2(d.b4) * nsa_ + ea0_; A23 = HI2(d.b4) * nsa_ + ea1_; B01 = LO2(d.b4) * nsb_ + eb0_; B23 = HI2(d.b4) * nsb_ + eb1_; \
    f32x2 qa_ = A01 * LO2(d.r4); qa_ = A23 * HI2(d.r4) + qa_; f32x2 qb_ = B01 * LO2(d.r4); qb_ = B23 * HI2(d.r4) + qb_; opa = qa_.x + qa_.y; opb = qb_.x + qb_.y; } while (0)
__device__ __forceinline__ void rwkv_prompt_ring4(LAS unsigned char* ring, volatile LAS unsigned* cnt, const float* RS, float* OA, float* outSR, int item, int w, int lane) {
    constexpr int CH = 16, CHB = CH * RREC * 4  , NB = 4, NCH = TP / CH, RB = RREC * 4;
    const int rbh = item >> 1, half = item & 1, rb = rbh >> 5, rh = rbh & 31, rg = lane >> 4, kq = lane & 15, rowA = half * 32 + w * 8 + rg;
    const char* src = (const char*)(RS + (size_t)rbh * TP * RREC);
#define R4_ISSUE(ci) do { const int cs_ = (ci) < NCH ? (ci) : NCH - 1; const int sl_ = (ci) % NB; _Pragma("unroll") for (int i_ = 0; i_ < 6; ++i_) { const int pc_ = w * 6 + i_; \
        __builtin_amdgcn_global_load_lds((const unsigned*)(src + (size_t)cs_ * CHB + pc_ * 1024 + lane * 16), (LAS unsigned*)(ring + sl_ * CHB + pc_ * 1024), 16, 0, 0); } } while (0)
#pragma unroll
    for (int ci = 0; ci < NB - 1; ++ci) R4_ISSUE(ci);
    asm volatile("s_waitcnt vmcnt(12)" ::: "memory"); if (lane == 0) cnt[w] = 1u; spin_ge4(cnt, 1u);
    const unsigned lbase = (unsigned)(size_t)ring;
    f32x2 A01 = (f32x2){0.f, 0.f}, A23 = A01, B01 = A01, B23 = A01;
    Rw2 X, Y; RW2_LD(X, lbase + kq * 16, lbase + 1280 + rowA * 4, 0);
    for (int ci = 0; ci < NCH; ++ci) {
        asm volatile("s_waitcnt vmcnt(6)" ::: "memory"); if (lane == 0) cnt[w] = (unsigned)ci + 2u; spin_ge4(cnt, (unsigned)ci + 2u);
        spin_ge4(cnt + 4, (unsigned)ci);
        R4_ISSUE(ci + NB - 1);
        const unsigned sl = lbase + (ci % NB) * CHB, nsl = lbase + ((ci + 1) % NB) * CHB, bk = sl + kq * 16, bv = sl + 1280 + rowA * 4, nbk = nsl + kq * 16, nbv = nsl + 1280 + rowA * 4;
        float opa[16], opb[16];
#define R4_PAIR(st) do { RW2_LD(Y, bk, bv, ((st) + 1) * RB); RW2_WAIT(X); RW2_STEP(X, opa[st], opb[st]); RW2_LD(X, bk, bv, ((st) + 2) * RB); RW2_WAIT(Y); RW2_STEP(Y, opa[(st) + 1], opb[(st) + 1]); } while (0)
        R4_PAIR(0); R4_PAIR(2); R4_PAIR(4); R4_PAIR(6); R4_PAIR(8); R4_PAIR(10); R4_PAIR(12);
        RW2_LD(Y, bk, bv, 15 * RB); RW2_WAIT(X); RW2_STEP(X, opa[14], opb[14]); RW2_LD(X, nbk, nbv, 0); RW2_WAIT(Y); RW2_STEP(Y, opa[15], opb[15]);
#undef R4_PAIR
        float* orow = OA + (size_t)(rb * TP + ci * CH + kq) * RW + rh * RH + rowA;
        orow[0] = transpose_reduce16(opa, kq); orow[4] = transpose_reduce16(opb, kq);
        if (lane == 0) cnt[4 + w] = (unsigned)ci + 1u;
    }
    *(f32x4*)(outSR + ((size_t)rbh * RH + rowA) * RH + 4 * kq) = (f32x4){A01.x, A01.y, A23.x, A23.y};
    *(f32x4*)(outSR + ((size_t)rbh * RH + rowA + 4) * RH + 4 * kq) = (f32x4){B01.x, B01.y, B23.x, B23.y};
    asm volatile("s_waitcnt vmcnt(0) lgkmcnt(0)" ::: "memory");
#undef R4_ISSUE
}

__device__ __forceinline__ void adaln_skinny(LAS unsigned char* lds, const float* W, const bf16_t* A, const float* bias, float* MOD, int c, int w, int lane, int tid) {
    const int r = lane & 31, h = lane >> 5;
    LAS float* part = (LAS float*)lds;
    constexpr int NG = (D / 2) / 32, SLB = 160 * 80;
#define AD_BAR() do { asm volatile("s_waitcnt lgkmcnt(0)" ::: "memory"); __builtin_amdgcn_s_barrier(); asm volatile("" ::: "memory"); } while (0)
    if (w < 6) {
        const int j = w >> 1, kh = w & 1, n0 = (c * 3 + j) * 32, kb = kh * (D / 2);
        f32x16 acc[5];
#pragma unroll
        for (int sb = 0; sb < 5; ++sb)
#pragma unroll
            for (int i = 0; i < 16; ++i) acc[sb][i] = 0.f;
        const float* wp = W + (size_t)(kb + 8 * h) * NMOD + n0 + r;
        const LAS unsigned char* sl = lds + kh * 2 * SLB + r * 80 + h * 16;
        float x0[16], x1[16], x2[16], x3[16];
#define AD_LOADW(x, g) do { const float* p_ = wp + (size_t)(32 * (g)) * NMOD; _Pragma("unroll") for (int j_ = 0; j_ < 16; ++j_) x[j_] = __builtin_nontemporal_load(p_ + (size_t)((j_ >> 3) * 16 + (j_ & 7)) * NMOD); } while (0)
#define AD_COMP(x, g) do { const LAS unsigned char* b_ = sl + ((g) & 1) * SLB; _Pragma("unroll") for (int q_ = 0; q_ < 2; ++q_) { \
        const bf16x8 wf_ = pack8((f32x4){x[q_ * 8], x[q_ * 8 + 1], x[q_ * 8 + 2], x[q_ * 8 + 3]}, (f32x4){x[q_ * 8 + 4], x[q_ * 8 + 5], x[q_ * 8 + 6], x[q_ * 8 + 7]}); \
        _Pragma("unroll") for (int sb_ = 0; sb_ < 5; ++sb_) acc[sb_] = MFMA32(wf_, *(const LAS bf16x8*)(b_ + sb_ * 32 * 80 + q_ * 32), acc[sb_]); } } while (0)
#define AD_SCHED() __builtin_amdgcn_sched_barrier(0)
        AD_LOADW(x0, 0); AD_LOADW(x1, 1); AD_LOADW(x2, 2);
        AD_BAR();
        for (int g = 0; g < NG; g += 4) {
            AD_LOADW(x3, g + 3); AD_SCHED(); AD_COMP(x0, g); AD_BAR(); AD_SCHED();
            { const int g2 = g + 4 < NG ? g + 4 : NG - 1; AD_LOADW(x0, g2); } AD_SCHED(); AD_COMP(x1, g + 1); AD_BAR(); AD_SCHED();
            { const int g2 = g + 5 < NG ? g + 5 : NG - 1; AD_LOADW(x1, g2); } AD_SCHED(); AD_COMP(x2, g + 2); AD_BAR(); AD_SCHED();
            { const int g2 = g + 6 < NG ? g + 6 : NG - 1; AD_LOADW(x2, g2); } AD_SCHED(); AD_COMP(x3, g + 3); AD_BAR(); AD_SCHED();
        }
#undef AD_LOADW
#undef AD_COMP
#pragma unroll
        for (int sb = 0; sb < 5; ++sb)
#pragma unroll
            for (int reg = 0; reg < 16; ++reg) part[(w * 160 + 32 * sb + r) * 33 + rowperm(reg, h)] = acc[sb][reg];
    } else {
        const int kh = w - 6;
        const bf16_t* ap = A + (size_t)(lane >> 2) * D + kh * (D / 2) + (lane & 3) * 8;
        LAS unsigned char* dst = lds + kh * 2 * SLB + (lane >> 2) * 80 + (lane & 3) * 16;
        u32x4 ra[10], rb[10];
#define AD_LOADA(rr, g) do { _Pragma("unroll") for (int i_ = 0; i_ < 10; ++i_) rr[i_] = *(const u32x4*)(ap + (size_t)(16 * i_) * D + 32 * (g)); } while (0)
#define AD_WRITEA(rr, g) do { _Pragma("unroll") for (int i_ = 0; i_ < 10; ++i_) *(LAS u32x4*)(dst + ((g) & 1) * SLB + i_ * 16 * 80) = rr[i_]; } while (0)
        AD_LOADA(ra, 0); AD_WRITEA(ra, 0); AD_LOADA(rb, 1);
        AD_BAR();
        for (int g = 0; g < NG; g += 2) {
            AD_WRITEA(rb, g + 1); { const int g2 = g + 2 < NG ? g + 2 : NG - 1; AD_LOADA(ra, g2); } AD_BAR();
            AD_WRITEA(ra, g + 2); { const int g2 = g + 3 < NG ? g + 3 : NG - 1; AD_LOADA(rb, g2); } AD_BAR();
        }
#undef AD_LOADA
#undef AD_WRITEA
    }
#undef AD_BAR
    __syncthreads();
    for (int i = tid; i < 3 * NSEQ * 32; i += NTHREADS) { const int j = i / (NSEQ * 32), q = i - j * (NSEQ * 32), sq = q >> 5, n = q & 31, col = (c * 3 + j) * 32 + n;
        MOD[(size_t)sq * NMOD + col] = part[((2 * j) * 160 + sq) * 33 + n] + part[((2 * j + 1) * 160 + sq) * 33 + n] + bias[col]; }
    __syncthreads();
}

__global__ void __launch_bounds__(NTHREADS, 2) fwd_kernel(Args args) {
    extern __shared__ __attribute__((aligned(16))) unsigned char lds_raw[];
    LAS unsigned char* lds = (LAS unsigned char*)lds_raw;
    volatile LAS unsigned* MISC = (volatile LAS unsigned*)(lds + MISC_OFF);
    const int tid = threadIdx.x, lane = tid & 63, wave = __builtin_amdgcn_readfirstlane(tid >> 6);
    const int G = gridDim.x, bx = blockIdx.x;
    const int vcu = (G % 8 == 0) ? (bx % 8) * (G / 8) + bx / 8 : bx;
    const int gw = vcu * NWAVES + wave, NGW = G * NWAVES;
    unsigned char* ws = args.ws;
    unsigned* ctl = (unsigned*)(ws + WS_CTL);
    for (int u = tid; u < (LDS_BYTES - RING_BYTES) / 4; u += NTHREADS) ((LAS unsigned*)(lds + RING_BYTES))[u] = 0u;
    __syncthreads();
    XcdBarrier bar; bar.bar = ctl + CW_BAR; bar.x = 0; bar.st = nullptr;
    if (!MK_PER_PHASE) bar = xcd_barrier_post(ctl + CW_BAR, MISC + 8);
#define GRID_BAR() do { if (!MK_PER_PHASE) xcd_barrier(bar); } while (0)
    const int lo = args.ph_lo, hi = args.ph_hi;
#ifndef PHASE_MASK
#define PHASE_MASK 0xffff
#endif
#define IN(k) (((PHASE_MASK >> (k)) & 1) && lo <= (k) && (k) < hi)
#define BOTH(k) (IN(k) && IN((k) + 1))
#ifndef PROBE_REP
#define PROBE_REP 0
#endif
#define REPS(k) (1 + ((PROBE_REP >> (k)) & 1))
    const float* const* in = args.in; float* out = args.out;
    bf16_t* WT_ADA = (bf16_t*)(ws + WS_WADA); bf16_t* A_ADA = (bf16_t*)(ws + WS_AADA); bf16_t* WT_IN = (bf16_t*)(ws + WS_WIN); bf16_t* WT_OAB = (bf16_t*)(ws + WS_WOAB); bf16_t* WT_OUT = (bf16_t*)(ws + WS_WOUT);
    bf16_t* WT_UP = (bf16_t*)(ws + WS_WUP); bf16_t* WT_DOWN = (bf16_t*)(ws + WS_WDOWN); bf16_t* WT_LORA = (bf16_t*)(ws + WS_WLORA); bf16_t* ALORA = (bf16_t*)(ws + WS_ALORA);
    float* MOD = (float*)(ws + WS_MOD); bf16_t* H = (bf16_t*)(ws + WS_H); bf16_t* P = (bf16_t*)(ws + WS_P); bf16_t* LWAG = (bf16_t*)(ws + WS_LWAG); float* RSCAN = (float*)(ws + WS_RSCAN); float* GSCAN = (float*)(ws + WS_GSCAN);
    float* BON = (float*)(ws + WS_BON); bf16_t* OA = (bf16_t*)(ws + WS_OA); bf16_t* OB = (bf16_t*)(ws + WS_OB); bf16_t* YAB = (bf16_t*)(ws + WS_YAB); bf16_t* MERGED = (bf16_t*)(ws + WS_MERGED); bf16_t* X1 = (bf16_t*)(ws + WS_X1); bf16_t* U = (bf16_t*)(ws + WS_U); bf16_t* X2 = (bf16_t*)(ws + WS_X2);

    if (IN(0)) for (int rep = 0; rep < REPS(0); ++rep) {
        LAS float* scr = (LAS float*)(lds + wave * 16384);
        constexpr int I0 = (D / 64) * (NMOD / 32), I1 = (D / 64) * (INCOLS / 32), I2 = (RW / 64) * (D / 32), I3 = I2, I4 = (D / 64) * (D / 32), I5 = (D / 64) * (DFF / 32), I6 = (DFF / 64) * (D / 32),
                      I7 = 1 * (RW / 32), I8 = I7, I9 = 4 * (RW / 32), NITEMS = I1 + I2 + I3 + I4 + I7 + I8 + I9;
        for (int it = gw; it < NITEMS; it += NGW) {
            int r = it + I1; if (r >= NITEMS) r -= NITEMS;
            if (r < I1) { const int nb = INCOLS / 32; const int n0 = 32 * (r % nb); transpose_item(in[I_WIN], INCOLS, 64 * (r / nb), n0, WT_IN, n0 < 14752 ? n0 : n0 + 96, D, 0, scr, lane); continue; } r -= I1;
            if (r < I2) { const int nb = D / 32; transpose_item(in[I_WOA], D, 64 * (r / nb), 32 * (r % nb), WT_OAB, 32 * (r % nb), D, 0, scr, lane); continue; } r -= I2;
            if (r < I3) { const int nb = D / 32; transpose_item(in[I_WOB], D, 64 * (r / nb), 32 * (r % nb), WT_OAB, 32 * (r % nb), D, RW, scr, lane); continue; } r -= I3;
            if (r < I4) { const int nb = D / 32; transpose_item(in[I_WOUT], D, 64 * (r / nb), 32 * (r % nb), WT_OUT, 32 * (r % nb), D, 0, scr, lane); continue; } r -= I4;
            if (r < I7) { const int nb = RW / 32; transpose_item(in[I_RWW2], RW, 64 * (r / nb), 32 * (r % nb), WT_LORA, 32 * (r % nb), LORA_K, 0, scr, lane); continue; } r -= I7;
            if (r < I8) { const int nb = RW / 32; transpose_item(in[I_RWA2], RW, 64 * (r / nb), 32 * (r % nb), WT_LORA, 2048 + 32 * (r % nb), LORA_K, 64, scr, lane); continue; } r -= I8;
            { const int nb = RW / 32; transpose_item(in[I_RWG2], RW, 64 * (r / nb), 32 * (r % nb), WT_LORA, 4096 + 32 * (r % nb), LORA_K, 128, scr, lane); }
        }
        for (int i = gw * 64 + lane; i < LORA_N * 48; i += NGW * 64) { const int n = i / 48, ch = i % 48, k = ch * 8, seg = n >> 11;
            const bool diag = seg == 0 ? (k < 64) : seg == 1 ? (k >= 64 && k < 128) : (k >= 128);
            if (!diag) *(u32x4*)(WT_LORA + (size_t)n * LORA_K + k) = (u32x4){0u, 0u, 0u, 0u}; }
        for (int i = gw * 64 + lane; i < 256 * (D / 4); i += NGW * 64) { const int s = i / (D / 4), c4 = (i % (D / 4)) * 4; u32x2 o = (u32x2){0u, 0u};
            if (s < NSEQ) { const f32x4 c = *(const f32x4*)((s < BP ? in[I_CP] + (size_t)s * D : in[I_CS] + (size_t)(s - BP) * D) + c4);
                o.x = pk2(c.x * sigmoidf_(c.x), c.y * sigmoidf_(c.y)); o.y = pk2(c.z * sigmoidf_(c.z), c.w * sigmoidf_(c.w)); }
            *(u32x2*)(A_ADA + (size_t)s * D + c4) = o; }
        if (BOTH(0) || rep + 1 < REPS(0)) GRID_BAR();
    }
    if (IN(1)) for (int rep = 0; rep < REPS(1); ++rep) {
        adaln_skinny(lds, in[I_WADA], A_ADA, in[I_BADA], MOD, bx, wave, lane, tid);
        if (BOTH(1) || rep + 1 < REPS(1)) GRID_BAR();
    }
    if (IN(2)) for (int rep = 0; rep < REPS(2); ++rep) {
        norm_rows_blk<false>(lds, in[I_XP], in[I_XS], in[I_N1W], MOD, 0, D, H, bx, G, wave, lane, tid);
        if (BOTH(2) || rep + 1 < REPS(2)) GRID_BAR();
    }
    if (IN(3)) for (int rep = 0; rep < REPS(3); ++rep) {
        pg8::Gemm g{H, WT_IN, D, D}; pg8::TileOrder<1> S; S.init(MTOK / 256, LDP / 256, G, bx, D / 64);
        pg8::EpiBf16<0> E{P, LDP};
        pg8::gemm_phase(lds, g, S, E);
        if (BOTH(3) || rep + 1 < REPS(3)) GRID_BAR();
    }
    if (IN(4)) for (int rep = 0; rep < REPS(4); ++rep) {
        const float* mu = in[I_RMU];
        for (int m = gw; m < MTOK; m += NGW) {
            const bool pr = m < NPROMPT; const int ms = m - NPROMPT; const int b = pr ? (m >> 11) : (ms >> 2), t = pr ? (m & 2047) : (ms & 3), T = pr ? TP : TS;
            const bf16_t* cur = P + (size_t)m * LDP;
#pragma unroll
            for (int i = 0; i < 6; ++i) { const int j = lane + 64 * i, col = 6144 + j; const float c = bf2f(cur[col]);
                const float p = t > 0 ? bf2f(cur[col - LDP]) : (pr ? 0.f : in[I_SSHIFT][(size_t)b * RCOLS + col]);
                const float xs = c + (p - c) * mu[col];
                const float val = j < 64 ? tanhf(xs) : j < 128 ? xs : sigmoidf_(xs);
                ALORA[(size_t)m * LORA_K + j] = (bf16_t)f2bf(val); }
            if (t == T - 1) { float* so = out + (pr ? O_PSHIFT : O_SSHIFT) + (size_t)b * RCOLS; for (int col = lane; col < RCOLS; col += 64) so[col] = bf2f(cur[col]); }
            if (t >= T - 3) { float* co = out + (pr ? O_PCONV : O_SCONV) + ((size_t)b * 3 + (t - (T - 3))) * GCONV; for (int col = lane; col < GCONV; col += 64) co[col] = bf2f(cur[PC_G + col]); }
        }
        { const int hh = lane >> 4, cq = lane & 15;
        for (int item = gw; item < BP * 4 * (TP / 16); item += NGW) {
            const int b = item >> 9, hg = (item >> 7) & 3, t0 = (item & 127) * 16, h = 4 * hg + hh, c = h * GH + 8 * cq;
            const bf16_t* base = P + (size_t)(b * TP) * LDP + PC_G + c;
            f32x4 cw[3][4][2];
#pragma unroll
            for (int q = 0; q < 3; ++q)
#pragma unroll
                for (int j = 0; j < 4; ++j) { const float* cwp = in[I_CONVW] + (size_t)(3 - j) * GCONV + q * GW + c; cw[q][j][0] = *(const f32x4*)cwp; cw[q][j][1] = *(const f32x4*)(cwp + 4); }
            u32x4 win[3][3], cu[3], nx[3], n2[3];
#pragma unroll
            for (int q = 0; q < 3; ++q) {
#pragma unroll
                for (int j = 1; j < 4; ++j) win[q][j - 1] = (t0 - j >= 0) ? *(const u32x4*)(base + (ptrdiff_t)(t0 - j) * LDP + q * GW) : (u32x4){0u, 0u, 0u, 0u};
                cu[q] = *(const u32x4*)(base + (size_t)t0 * LDP + q * GW); nx[q] = *(const u32x4*)(base + (size_t)(t0 + 1) * LDP + q * GW); }
            const float nalog = -__expf(in[I_ALOG][h]), dtb = in[I_DTB][h];
            unsigned short bt_n = 0, al_n = 0, bt_2 = 0, al_2 = 0;
            if (cq == 0) { const bf16_t* rp0 = P + (size_t)(b * TP + t0) * LDP; bt_n = rp0[PC_BETA + h]; al_n = rp0[PC_ALPHA + h]; }
#pragma unroll 1
            for (int tt = 0; tt < 16; ++tt) { const int t = t0 + tt, tn = tt < 14 ? t + 2 : t0 + 15; const bf16_t* rowp = P + (size_t)(b * TP + t) * LDP;
#pragma unroll
                for (int q = 0; q < 3; ++q) n2[q] = *(const u32x4*)(base + (size_t)tn * LDP + q * GW);
                if (cq == 0) { const bf16_t* rp1 = rowp + (tt < 15 ? LDP : 0); bt_2 = rp1[PC_BETA + h]; al_2 = rp1[PC_ALPHA + h]; }
                const float bt_raw = bf2f(bt_n), al_raw = bf2f(al_n);
                float y[3][8];
#pragma unroll
                for (int q = 0; q < 3; ++q) { float a8[8];
#pragma unroll
                    for (int e = 0; e < 8; ++e) a8[e] = 0.f;
#pragma unroll
                    for (int j = 0; j < 4; ++j) { const u32x4 w = j == 0 ? cu[q] : win[q][j - 1]; const f32x4 c0 = cw[q][j][0], c1 = cw[q][j][1];
                        a8[0] += c0.x * bflo(w.x); a8[1] += c0.y * bfhi(w.x); a8[2] += c0.z * bflo(w.y); a8[3] += c0.w * bfhi(w.y); a8[4] += c1.x * bflo(w.z); a8[5] += c1.y * bfhi(w.z); a8[6] += c1.z * bflo(w.w); a8[7] += c1.w * bfhi(w.w); }
#pragma unroll
                    for (int e = 0; e < 8; ++e) y[q][e] = a8[e] * fsig(a8[e]); }
                float sq = 0.f, sk = 0.f;
#pragma unroll
                for (int e = 0; e < 8; ++e) { sq += y[0][e] * y[0][e]; sk += y[1][e] * y[1][e]; }
                const float qn = __builtin_amdgcn_rsqf(row16_sum(sq) + 1e-6f) * 0.08838834764831845f, kn = __builtin_amdgcn_rsqf(row16_sum(sk) + 1e-6f);
                float qk = 0.f;
#pragma unroll
                for (int e = 0; e < 8; ++e) { y[0][e] *= qn; y[1][e] *= kn; qk += y[0][e] * y[1][e]; }
                qk = row16_sum(qk);
                unsigned char* recb = (unsigned char*)GSCAN + ((size_t)(b * GHEADS + h) * TP + t) * GRB;
#pragma unroll
                for (int q = 0; q < 3; ++q) *(bf16x8*)(recb + q * 256 + 16 * cq) = pack8((f32x4){y[q][0], y[q][1], y[q][2], y[q][3]}, (f32x4){y[q][4], y[q][5], y[q][6], y[q][7]});
                if (cq == 0) { const float beta = sigmoidf_(bt_raw); const float la = nalog * softplusf_(al_raw + dtb); *(f32x4*)(recb + 768) = (f32x4){__expf(la), beta, qk, la}; }
#pragma unroll
                for (int q = 0; q < 3; ++q) { win[q][2] = win[q][1]; win[q][1] = win[q][0]; win[q][0] = cu[q]; cu[q] = nx[q]; nx[q] = n2[q]; }
                bt_n = bt_2; al_n = al_2;
            }
        } }
        if (BOTH(4) || rep + 1 < REPS(4)) GRID_BAR();
    }
    if (IN(5)) for (int rep = 0; rep < REPS(5); ++rep) {
        pg8::Gemm g{ALORA, WT_LORA, LORA_K, LORA_K}; pg8::TileOrder<1> S; S.init(MTOK / 256, LORA_N / 256, G, bx, LORA_K / 64);
        pg8::EpiLora E{LWAG, in[I_RW0], in[I_RA0]};
        pg8::gemm_phase(lds, g, S, E);
        if (BOTH(5) || rep + 1 < REPS(5)) GRID_BAR();
    }
    if (IN(6)) for (int rep = 0; rep < REPS(6); ++rep) {
        const float* mu = in[I_RMU]; const int hh = lane >> 4, cq = lane & 15;
        if (args.sub & 1) for (int u = gw; u < NSAMP * 6; u += NGW) {
            const int m = NPROMPT + u / 6, gi = u - (u / 6) * 6;
            const bool pr = false; const int ms = m - NPROMPT; const int b = ms >> 2, t = ms & 3;
            const bf16_t* cur = P + (size_t)m * LDP;
            if (gi < 4) {
                if (pr) continue;
                const bf16_t* lw = LWAG + (size_t)m * LORA_N;
                u32x2 cr[2][3], pv[2][3]; f32x4 wv[2], av[2];
#pragma unroll
                for (int bi = 0; bi < 2; ++bi) { const int c = (8 * gi + 4 * bi + hh) * RH + 4 * cq;
#pragma unroll
                    for (int q = 0; q < 3; ++q) { cr[bi][q] = *(const u32x2*)(cur + q * RW + c); pv[bi][q] = t > 0 ? *(const u32x2*)(cur - LDP + q * RW + c) : (u32x2){0u, 0u}; }
                    { const f32x4 lv = cvt4(*(const u32x2*)(lw + c)); wv[bi] = (f32x4){__expf(lv.x), __expf(lv.y), __expf(lv.z), __expf(lv.w)}; } av[bi] = cvt4(*(const u32x2*)(lw + RW + c)); }
#pragma unroll
                for (int bi = 0; bi < 2; ++bi) { const int h = 8 * gi + 4 * bi + hh, c = h * RH + 4 * cq; f32x4 x[3];
#pragma unroll
                    for (int q = 0; q < 3; ++q) { const f32x4 cv = (f32x4){bflo(cr[bi][q].x), bfhi(cr[bi][q].x), bflo(cr[bi][q].y), bfhi(cr[bi][q].y)};
                        f32x4 p = (f32x4){bflo(pv[bi][q].x), bfhi(pv[bi][q].x), bflo(pv[bi][q].y), bfhi(pv[bi][q].y)};
                        if (t == 0 && !pr) p = *(const f32x4*)(in[I_SSHIFT] + (size_t)b * RCOLS + q * RW + c);
                        x[q] = cv + (p - cv) * *(const f32x4*)(mu + q * RW + c); }
                    const f32x4 kr = x[1] * *(const f32x4*)(in[I_RKK] + c);
                    const float ss = row16_sum(kr.x * kr.x + kr.y * kr.y + kr.z * kr.z + kr.w * kr.w);
                    const f32x4 kk = kr * __builtin_amdgcn_rsqf(ss + 1e-6f);
                    const f32x4 a4 = av[bi]; const f32x4 kp = x[1] * ((a4 - 1.0f) * *(const f32x4*)(in[I_RKA] + c) + 1.0f);
                    const f32x4 rk = *(const f32x4*)(in[I_RRK] + c); const f32x4 rkp = x[0] * kp * rk;
                    const float bon = row16_sum(rkp.x + rkp.y + rkp.z + rkp.w);
                    if (cq == 0) BON[(size_t)m * RHEADS + h] = bon;
                    float* rec = RSCAN + ((pr ? ((size_t)(b * RHEADS + h) * TP + t) : ((size_t)BP * RHEADS * TP + (size_t)(b * RHEADS + h) * TS + t))) * RREC + 4 * cq;
                    *(f32x4*)(rec) = wv[bi]; *(f32x4*)(rec + 64) = kk; *(f32x4*)(rec + 128) = kk * a4; *(f32x4*)(rec + 192) = kp; *(f32x4*)(rec + 256) = x[0]; *(f32x4*)(rec + 320) = x[2]; }
            } else {
                const int g8 = 8 * (gi - 4);
                u32x4 raw[2][3][4];
#pragma unroll
                for (int bi = 0; bi < 2; ++bi) { const int c = (g8 + 4 * bi + hh) * GH + 8 * cq;
#pragma unroll
                    for (int q = 0; q < 3; ++q)
#pragma unroll
                        for (int j = 0; j < 4; ++j) raw[bi][q][j] = (t - j >= 0) ? *(const u32x4*)(cur - (size_t)j * LDP + PC_G + q * GW + c) : (u32x4){0u, 0u, 0u, 0u}; }
#pragma unroll
                for (int bi = 0; bi < 2; ++bi) { const int h = g8 + 4 * bi + hh, c = h * GH + 8 * cq; float y[3][8];
#pragma unroll
                    for (int q = 0; q < 3; ++q) { float a8[8];
#pragma unroll
                        for (int e = 0; e < 8; ++e) a8[e] = 0.f;
#pragma unroll
                        for (int j = 0; j < 4; ++j) { const float* cwp = in[I_CONVW] + (size_t)(3 - j) * GCONV + q * GW + c; const f32x4 c0 = *(const f32x4*)cwp, c1 = *(const f32x4*)(cwp + 4);
                            f32x4 x0 = (f32x4){bflo(raw[bi][q][j].x), bfhi(raw[bi][q][j].x), bflo(raw[bi][q][j].y), bfhi(raw[bi][q][j].y)}, x1 = (f32x4){bflo(raw[bi][q][j].z), bfhi(raw[bi][q][j].z), bflo(raw[bi][q][j].w), bfhi(raw[bi][q][j].w)};
                            if (t - j < 0 && !pr) { const float* sp = in[I_SCONV] + ((size_t)b * 3 + (3 + t - j)) * GCONV + q * GW + c; x0 = *(const f32x4*)sp; x1 = *(const f32x4*)(sp + 4); }
                            a8[0] += c0.x * x0.x; a8[1] += c0.y * x0.y; a8[2] += c0.z * x0.z; a8[3] += c0.w * x0.w; a8[4] += c1.x * x1.x; a8[5] += c1.y * x1.y; a8[6] += c1.z * x1.z; a8[7] += c1.w * x1.w; }
#pragma unroll
                        for (int e = 0; e < 8; ++e) y[q][e] = a8[e] * fsig(a8[e]); }
                    float sq = 0.f, sk = 0.f;
#pragma unroll
                    for (int e = 0; e < 8; ++e) { sq += y[0][e] * y[0][e]; sk += y[1][e] * y[1][e]; }
                    const float qn = __builtin_amdgcn_rsqf(row16_sum(sq) + 1e-6f) * 0.08838834764831845f, kn = __builtin_amdgcn_rsqf(row16_sum(sk) + 1e-6f);
                    float qk = 0.f;
#pragma unroll
                    for (int e = 0; e < 8; ++e) { y[0][e] *= qn; y[1][e] *= kn; qk += y[0][e] * y[1][e]; }
                    qk = row16_sum(qk);
                    float* rec = GSCAN + ((size_t)BP * GHEADS * TP + (size_t)(b * GHEADS + h) * TS + t) * GREC;
                    unsigned char* recb = (unsigned char*)GSCAN + ((size_t)(b * GHEADS + h) * TP + t) * GRB;
#pragma unroll
                    for (int q = 0; q < 3; ++q) {
                        if (pr) *(bf16x8*)(recb + q * 256 + 16 * cq) = pack8((f32x4){y[q][0], y[q][1], y[q][2], y[q][3]}, (f32x4){y[q][4], y[q][5], y[q][6], y[q][7]});
                        else { *(f32x4*)(rec + q * 128 + 8 * cq) = (f32x4){y[q][0], y[q][1], y[q][2], y[q][3]}; *(f32x4*)(rec + q * 128 + 8 * cq + 4) = (f32x4){y[q][4], y[q][5], y[q][6], y[q][7]}; } }
                    if (cq == 0) { const float beta = sigmoidf_(bf2f(cur[PC_BETA + h]));
                        const float la = -__expf(in[I_ALOG][h]) * softplusf_(bf2f(cur[PC_ALPHA + h]) + in[I_DTB][h]);
                        *(f32x4*)(pr ? (float*)(recb + 768) : rec + 384) = (f32x4){__expf(la), beta, qk, la}; } }
            }
        }
        if (args.sub & 2) { LAS unsigned char* wl = lds + wave * 16384; LAS float* kcw = (LAS float*)(lds + 133120 + wave * 1536);
          const RwPrepIn rin{P, LWAG, in[I_RMU], in[I_RKK], in[I_RKA], in[I_RRK], BON, (unsigned char*)RSCAN, kcw}; unsigned char* RKDb = (unsigned char*)RSCAN + 68 * MiB; int staged = -1;
          for (int ch = gw; ch < NRCHUNK; ch += NGW) { const int hd = (ch >> 6) & 31;
              if (hd != staged) { const int cbh = hd * RH + lane; asm volatile("s_waitcnt lgkmcnt(0)" ::: "memory");
                  kcw[lane] = in[I_RMU][cbh]; kcw[64 + lane] = in[I_RMU][RW + cbh]; kcw[128 + lane] = in[I_RKK][cbh]; kcw[192 + lane] = in[I_RKA][cbh]; kcw[256 + lane] = in[I_RRK][cbh];
                  asm volatile("s_waitcnt lgkmcnt(0)" ::: "memory"); staged = hd; }
              rwkv_chunk_prep(wl, rin, ch >> 6, ch & 63, RKDb + (size_t)ch * RK_BYTES, (float*)(ws + WS_BON + 3 * MiB) + (size_t)ch * 64, lane); } }
        if (args.sub & 4) { LAS unsigned char* wl = lds + wave * 16384;
          unsigned char* FRb = (unsigned char*)out; unsigned char* UBb = FRb + (size_t)NCHUNK * CK_FR; float* CDb = (float*)(ws + WS_BON + 2 * MiB);
          for (int ch = gw; ch < NCHUNK; ch += NGW) gdn_chunk_prep(wl, (const unsigned char*)GSCAN + (size_t)ch * 32 * GRB, FRb + (size_t)ch * CK_FR, UBb + (size_t)ch * CK_UB, CDb + ch, lane); }
        if (BOTH(6) || rep + 1 < REPS(6)) GRID_BAR();
    }
    if (IN(8)) for (int rep = 0; rep < REPS(8); ++rep) {
        const int xw = ((bx & 7) << 5) | (bx >> 3);
        if (wave == 0) gdn_mfma_wave((const unsigned char*)out, (const unsigned char*)out + (size_t)NCHUNK * CK_FR, (const float*)(ws + WS_BON + 2 * MiB), OB, out + O_PGDN, xw, lane);
        else if (wave == 1) rwkv_mfma_wave((const unsigned char*)RSCAN + 68 * MiB, (const float*)(ws + WS_BON + 3 * MiB), (const unsigned char*)RSCAN, OA, out + O_PWKV, xw, lane);
        else { const int sw = bx * 6 + (wave - 2), nsw = G * 6; LAS float* scr = (LAS float*)(lds + (wave - 2) * 8704);
            for (int it = sw; it < BS * RHEADS * 4; it += nsw) rwkv_sample_item(RSCAN, in[I_SWKV], OA, out + O_SWKV, it, lane);
            for (int it = sw; it < BS * GHEADS * 4; it += nsw) gdn_sample_item(scr, GSCAN, in[I_SGDN], OB, out + O_SGDN, it, lane);
            constexpr int J5 = (D / 64) * (DFF / 32), J6 = (DFF / 64) * (D / 32);
            for (int it = sw; it < J5 + J6; it += nsw) {
                if (it < J5) { const int nb = DFF / 32; transpose_item(in[I_WUP], DFF, 64 * (it / nb), 32 * (it % nb), WT_UP, 32 * (it % nb), D, 0, scr, lane); }
                else { const int q = it - J5, nb = D / 32; transpose_item(in[I_WDOWN], D, 64 * (q / nb), 32 * (q % nb), WT_DOWN, 32 * (q % nb), DFF, 0, scr, lane); } } }
        __syncthreads();
        if (BOTH(8) || rep + 1 < REPS(8)) GRID_BAR();
    }
    if (IN(9)) for (int rep = 0; rep < REPS(9); ++rep) {
        const float* mu = in[I_RMU]; const int hh = lane >> 4, cq = lane & 15;
        { struct RA { u32x2 o[2], g[2], cv[2], pv[2]; float bon[2]; }; RA ca, na;
#define P9_LOADA(R, uu) do { const int m_ = (uu) >> 2, gi_ = (uu) & 3; const bool pr_ = m_ < NPROMPT; const int t_ = pr_ ? (m_ & 2047) : ((m_ - NPROMPT) & 3); const bf16_t* cur_ = P + (size_t)m_ * LDP; \
            _Pragma("unroll") for (int bi = 0; bi < 2; ++bi) { const int h_ = 8 * gi_ + 4 * bi + hh, c_ = h_ * RH + 4 * cq; \
                R.o[bi] = *(const u32x2*)(OA + (size_t)m_ * RW + c_); R.g[bi] = *(const u32x2*)(LWAG + (size_t)m_ * LORA_N + 2 * RW + c_); \
                R.cv[bi] = *(const u32x2*)(cur_ + 2 * RW + c_); R.pv[bi] = t_ > 0 ? *(const u32x2*)(cur_ - LDP + 2 * RW + c_) : (u32x2){0u, 0u}; R.bon[bi] = BON[(size_t)m_ * RHEADS + h_]; } } while (0)
          constexpr int NA = MTOK * 4;
          f32x4 kmu[2], klw[2], klb[2];
#pragma unroll
          for (int bi = 0; bi < 2; ++bi) { const int c = (8 * (gw & 3) + 4 * bi + hh) * RH + 4 * cq; kmu[bi] = *(const f32x4*)(mu + 2 * RW + c); klw[bi] = *(const f32x4*)(in[I_LNXW] + c); klb[bi] = *(const f32x4*)(in[I_LNXB] + c); }
          if (gw < NA) P9_LOADA(ca, gw);
          for (int u = gw; u < NA; u += NGW) {
            { const int un = u + NGW < NA ? u + NGW : u; P9_LOADA(na, un); }
            const int m = u >> 2, gi = u & 3;
            const bool pr = m < NPROMPT; const int ms = m - NPROMPT; const int b = pr ? (m >> 11) : (ms >> 2), t = pr ? (m & 2047) : (ms & 3);
#pragma unroll
            for (int bi = 0; bi < 2; ++bi) { const int h = 8 * gi + 4 * bi + hh, c = h * RH + 4 * cq;
                const f32x4 o = cvt4(ca.o[bi]); const float mean = row16_sum(o.x + o.y + o.z + o.w) * (1.0f / 64.0f); const f32x4 d = o - mean;
                const float var = row16_sum(d.x * d.x + d.y * d.y + d.z * d.z + d.w * d.w) * (1.0f / 64.0f);
                const f32x4 vc = cvt4(ca.cv[bi]); f32x4 vp = cvt4(ca.pv[bi]);
                if (t == 0 && !pr) vp = *(const f32x4*)(in[I_SSHIFT] + (size_t)b * RCOLS + 2 * RW + c);
                const f32x4 v4 = vc + (vp - vc) * kmu[bi];
                f32x4 on = d * __builtin_amdgcn_rsqf(var + 64e-5f) * klw[bi] + klb[bi];
                on = (on + v4 * ca.bon[bi]) * cvt4(ca.g[bi]);
                u32x2 w; w.x = pk2(on.x, on.y); w.y = pk2(on.z, on.w); *(u32x2*)(YAB + (size_t)m * D + c) = w; }
            ca = na; }
#undef P9_LOADA
        }
        { struct RB { u32x4 ow[2], zw[2]; }; RB cb_, nb;
#define P9_LOADB(R, uu) do { const int m_ = (uu) >> 1, g8_ = 8 * ((uu) & 1); const bf16_t* cur_ = P + (size_t)m_ * LDP; \
            _Pragma("unroll") for (int bi = 0; bi < 2; ++bi) { const int c_ = (g8_ + 4 * bi + hh) * GH + 8 * cq; R.ow[bi] = *(const u32x4*)(OB + (size_t)m_ * GW + c_); R.zw[bi] = *(const u32x4*)(cur_ + PC_Z + c_); } } while (0)
          constexpr int NB = MTOK * 2;
          const f32x4 n0 = *(const f32x4*)(in[I_GNW] + 8 * cq), n1 = *(const f32x4*)(in[I_GNW] + 8 * cq + 4);
          if (gw < NB) P9_LOADB(cb_, gw);
          for (int u = gw; u < NB; u += NGW) {
            { const int un = u + NGW < NB ? u + NGW : u; P9_LOADB(nb, un); }
            const int m = u >> 1, g8 = 8 * (u & 1);
#pragma unroll
            for (int bi = 0; bi < 2; ++bi) { const int c = (g8 + 4 * bi + hh) * GH + 8 * cq;
                const f32x4 a = cvt4((u32x2){cb_.ow[bi].x, cb_.ow[bi].y}), bq = cvt4((u32x2){cb_.ow[bi].z, cb_.ow[bi].w});
                const float rs = __builtin_amdgcn_rsqf(row16_sum(a.x * a.x + a.y * a.y + a.z * a.z + a.w * a.w + bq.x * bq.x + bq.y * bq.y + bq.z * bq.z + bq.w * bq.w) * (1.0f / 128.0f) + 1e-6f);
                const u32x4 zq = cb_.zw[bi];
                const float z[8] = {bflo(zq.x), bfhi(zq.x), bflo(zq.y), bfhi(zq.y), bflo(zq.z), bfhi(zq.z), bflo(zq.w), bfhi(zq.w)};
                u32x4 w; w.x = pk2(a.x * rs * n0.x * z[0] * fsig(z[0]), a.y * rs * n0.y * z[1] * fsig(z[1])); w.y = pk2(a.z * rs * n0.z * z[2] * fsig(z[2]), a.w * rs * n0.w * z[3] * fsig(z[3]));
                w.z = pk2(bq.x * rs * n1.x * z[4] * fsig(z[4]), bq.y * rs * n1.y * z[5] * fsig(z[5])); w.w = pk2(bq.z * rs * n1.z * z[6] * fsig(z[6]), bq.w * rs * n1.w * z[7] * fsig(z[7]));
                *(u32x4*)(YAB + (size_t)m * D + RW + c) = w; }
            cb_ = nb; }
#undef P9_LOADB
        }
        if (BOTH(9) || rep + 1 < REPS(9)) GRID_BAR();
    }
    if (IN(10)) for (int rep = 0; rep < REPS(10); ++rep) {
        pg8::Gemm g{YAB, WT_OAB, D, D}; pg8::TileOrder<2> S; S.init(MTOK / 256, D / 256, G, bx, RW / 64, G == 256 ? 2 * G : 0); S.chain = true;
        pg8::EpiMergeChain E{MERGED, P};
        pg8::gemm_phase(lds, g, S, E);
        if (G == 256) { pg8::TailArgs ta{(float*)(ws + WS_H), ctl + CW_TAIL + 0 * 8192, nullptr, nullptr, nullptr, nullptr, MERGED, D, P}; pg8::gemm_tail<8, 2>(lds, g, MTOK / 256, D / 256, G, bx, 2, 8, ta); }
        if (BOTH(10) || rep + 1 < REPS(10)) GRID_BAR();
    }
    if (IN(11)) for (int rep = 0; rep < REPS(11); ++rep) {
        pg8::Gemm g{MERGED, WT_OUT, D, D}; pg8::TileOrder<1> S; S.init(MTOK / 256, D / 256, G, bx, D / 64, G == 256 ? 2 * G : 0);
        pg8::EpiResGate<false> E{in[I_XP], in[I_XS], MOD + 2 * D, X1};
        pg8::gemm_phase(lds, g, S, E);
        if (G == 256) { pg8::TailArgs ta{(float*)(ws + WS_H), ctl + CW_TAIL + 1 * 8192, in[I_XP], in[I_XS], MOD + 2 * D, nullptr, X1, D, nullptr}; pg8::gemm_tail<8, 0>(lds, g, MTOK / 256, D / 256, G, bx, 2, 8, ta); }
        if (BOTH(11) || rep + 1 < REPS(11)) GRID_BAR();
    }
    if (IN(12)) for (int rep = 0; rep < REPS(12); ++rep) {
        norm_rows_blk<true>(lds, (const float*)X1, nullptr, in[I_N2W], MOD, 3 * D, 4 * D, H, bx, G, wave, lane, tid);
        if (BOTH(12) || rep + 1 < REPS(12)) GRID_BAR();
    }
    if (IN(13)) for (int rep = 0; rep < REPS(13); ++rep) {
        pg8::Gemm g{H, WT_UP, D, D}; pg8::TileOrder<1> S; S.init(MTOK / 256, DFF / 256, G, bx, D / 64, G == 256 ? 8 * G : 0);
        pg8::EpiBf16<1> E{U, DFF};
        pg8::gemm_phase(lds, g, S, E);
        if (G == 256) { pg8::TailArgs ta{(float*)(ws + WS_P), ctl + CW_TAIL + 2 * 8192, nullptr, nullptr, nullptr, nullptr, U, DFF, nullptr}; pg8::gemm_tail<2, 1>(lds, g, MTOK / 256, DFF / 256, G, bx, 8, 32, ta); }
        if (BOTH(13) || rep + 1 < REPS(13)) GRID_BAR();
    }
    if (IN(14)) for (int rep = 0; rep < REPS(14); ++rep) {
        pg8::Gemm g{U, WT_DOWN, DFF, DFF}; pg8::TileOrder<1> S; S.init(MTOK / 256, D / 256, G, bx, DFF / 64, G == 256 ? 2 * G : 0);
        pg8::EpiResGate<true> E{(const float*)X1, nullptr, MOD + 5 * D, X2};
        pg8::gemm_phase(lds, g, S, E);
        if (G == 256) { pg8::TailArgs ta{(float*)(ws + WS_H), ctl + CW_TAIL + 3 * 8192, (const float*)X1, nullptr, MOD + 5 * D, nullptr, X2, D, nullptr}; pg8::gemm_tail<8, 3>(lds, g, MTOK / 256, D / 256, G, bx, 2, 32, ta); }
        if (BOTH(14) || rep + 1 < REPS(14)) GRID_BAR();
    }
    if (IN(15)) for (int rep = 0; rep < REPS(15); ++rep) {
        norm_rows<1, true>((const float*)X2, nullptr, in[I_FNW], nullptr, 0, 0, nullptr, out + O_Y, gw, NGW, lane);
    }
#undef IN
#undef BOTH
#undef GRID_BAR
}

extern "C" void kernel_launch(void* const* d_in, const int* in_sizes, int n_in, void* d_out, int out_size, void* d_ws, size_t ws_size, hipStream_t stream) {
    static int grid = 0;
    if (grid == 0) {
        if (n_in != 34 || (size_t)out_size != O_END || ws_size < WS_END) { fprintf(stderr, "kernel_launch: unexpected problem: n_in %d out %d ws %zu (need %zu)\n", n_in, out_size, ws_size, (size_t)WS_END); grid = -1; return; }
        int dev = 0, cus = 0, per_cu = 0;
        if (hipGetDevice(&dev) != hipSuccess || hipDeviceGetAttribute(&cus, hipDeviceAttributeMultiprocessorCount, dev) != hipSuccess) { grid = -1; return; }
        if (hipFuncSetAttribute((const void*)fwd_kernel, hipFuncAttributeMaxDynamicSharedMemorySize, LDS_BYTES) != hipSuccess) { fprintf(stderr, "kernel_launch: hipFuncSetAttribute failed\n"); grid = -1; return; }
        if (hipOccupancyMaxActiveBlocksPerMultiprocessor(&per_cu, (const void*)fwd_kernel, NTHREADS, LDS_BYTES) != hipSuccess || per_cu < 1) fprintf(stderr, "kernel_launch: occupancy query says %d\n", per_cu);
        (void)hipGetLastError();
        grid = cus;
    }
    if (grid < 0) return;
    if (hipMemsetAsync((char*)d_ws + WS_CTL, 0, CTL_ZERO_BYTES, stream) != hipSuccess) return;
    Args a{}; a.sub = 7;
    for (int i = 0; i < 34; ++i) a.in[i] = (const float*)d_in[i];
    a.out = (float*)d_out; a.ws = (unsigned char*)d_ws;
#if MK_PER_PHASE
    for (int p = 0; p < NPHASE; ++p) { a.ph_lo = p; a.ph_hi = p + 1; hipLaunchKernelGGL(fwd_kernel, dim3(grid), dim3(NTHREADS), LDS_BYTES, stream, a); }
#else
#ifdef PROBE_PHASE
    a.ph_lo = 0; a.ph_hi = PROBE_PHASE + 1; hipLaunchKernelGGL(fwd_kernel, dim3(grid), dim3(NTHREADS), LDS_BYTES, stream, a);
    if (PROBE_TWICE) { (void)hipMemsetAsync((char*)d_ws + WS_CTL, 0, CTL_ZERO_BYTES, stream); a.ph_lo = PROBE_PHASE; a.ph_hi = PROBE_PHASE + 1; a.sub = PROBE_TWICE; hipLaunchKernelGGL(fwd_kernel, dim3(grid), dim3(NTHREADS), LDS_BYTES, stream, a); a.sub = 7; }
    if (PROBE_PHASE + 1 < NPHASE) { (void)hipMemsetAsync((char*)d_ws + WS_CTL, 0, CTL_ZERO_BYTES, stream); a.ph_lo = PROBE_PHASE + 1; a.ph_hi = NPHASE; hipLaunchKernelGGL(fwd_kernel, dim3(grid), dim3(NTHREADS), LDS_BYTES, stream, a); }
#else
    a.ph_lo = 0; a.ph_hi = NPHASE; hipLaunchKernelGGL(fwd_kernel, dim3(grid), dim3(NTHREADS), LDS_BYTES, stream, a);
#endif
#endif
    const hipError_t le = hipPeekAtLastError();
    if (le != hipSuccess) fprintf(stderr, "kernel_launch: launch failed: %s\n", hipGetErrorName(le));
}
```
